# Optimizing an MI355X kernel written in HIP

```python
import math
import jax, jax.numpy as jnp
from jax import lax
import numpy as np

D_MODEL = 1024
BATCH = 8
SEQ = 2048
DEPTH = 1
DEC_BATCH = 128
DEC_SEQ = 4
PAST_LEN = 16384
PAGE_SIZE = 128

MIX_SSM = D_MODEL // 2
MIX_CONV = D_MODEL - MIX_SSM
SSM_GROUP_CH = 16
SSM_GROUPS = MIX_SSM // SSM_GROUP_CH
SSM_STATE = 64
CONV_HEADS = 8
CONV_K = 3
N_MEM = 256
XATTN_HEADS = 4
XATTN_HEAD_DIM = D_MODEL // XATTN_HEADS
D_FF = 256 * ((8 * D_MODEL // 3 + 255) // 256)
FFN_CONV_K = 3
EPS = 1e-6

kernel_name = "hymba_s5_shortconv_memxattn_step"

F32 = jnp.float32


def rms_norm(x, g):
    xf = x.astype(F32)
    y = xf * lax.rsqrt(jnp.mean(xf * xf, axis=-1, keepdims=True) + EPS)
    return (y * g.astype(F32)).astype(x.dtype)


def causal_dwconv(x, w, prev):
    k = w.shape[0]
    t = x.shape[1]
    xp = jnp.concatenate([prev.astype(x.dtype), x], axis=1)
    y = xp[:, 0:t] * w[0]
    for j in range(1, k):
        y = y + xp[:, j:j + t] * w[j]
    return y, xp[:, t:]


def _complex_affine_combine(e1, e2):
    ar1, ai1, br1, bi1 = e1
    ar2, ai2, br2, bi2 = e2
    return (ar2 * ar1 - ai2 * ai1,
            ar2 * ai1 + ai2 * ar1,
            ar2 * br1 - ai2 * bi1 + br2,
            ar2 * bi1 + ai2 * br1 + bi2)


def s5_ssm(u, A_re, A_im, log_dt, B_re, B_im, C_re, C_im, D, s0):
    b, t, _ = u.shape
    G, P, N = SSM_GROUPS, SSM_GROUP_CH, SSM_STATE
    uf = u.astype(F32).reshape(b, t, G, P)
    dt = jnp.exp(log_dt.astype(F32))[:, None]
    lr = A_re.astype(F32)
    li = A_im.astype(F32)
    mag = jnp.exp(dt * lr)
    ph = dt * li
    ar = mag * jnp.cos(ph)
    ai = mag * jnp.sin(ph)
    den = lr * lr + li * li
    cr = ((ar - 1.0) * lr + ai * li) / den
    ci = (ai * lr - (ar - 1.0) * li) / den
    Br = B_re.astype(F32)
    Bi = B_im.astype(F32)
    bbr = cr[..., None] * Br - ci[..., None] * Bi
    bbi = cr[..., None] * Bi + ci[..., None] * Br
    bu_r = jnp.einsum('gnp,btgp->tbgn', bbr, uf)
    bu_i = jnp.einsum('gnp,btgp->tbgn', bbi, uf)
    a_r = jnp.broadcast_to(ar[None, None], (t, 1, G, N))
    a_i = jnp.broadcast_to(ai[None, None], (t, 1, G, N))
    acum_r, acum_i, s_r, s_i = lax.associative_scan(
        _complex_affine_combine, (a_r, a_i, bu_r, bu_i), axis=0)
    if s0 is not None:
        s0r = s0[0].astype(F32)[None]
        s0i = s0[1].astype(F32)[None]
        s_r, s_i = (s_r + acum_r * s0r - acum_i * s0i,
                    s_i + acum_r * s0i + acum_i * s0r)
    y = (jnp.einsum('gpn,tbgn->btgp', C_re.astype(F32), s_r)
         - jnp.einsum('gpn,tbgn->btgp', C_im.astype(F32), s_i)
         + D.astype(F32) * uf)
    return (y.reshape(b, t, MIX_SSM).astype(u.dtype),
            s_r[-1].astype(u.dtype), s_i[-1].astype(u.dtype))


def memory_kv(mem, g, w_k, w_v):
    b = mem.shape[0]
    m = rms_norm(mem, g)
    k = (m @ w_k).reshape(b, N_MEM, XATTN_HEADS, XATTN_HEAD_DIM)
    v = (m @ w_v).reshape(b, N_MEM, XATTN_HEADS, XATTN_HEAD_DIM)
    return k, v


def cross_attention(h, k, v, w_q, w_xo):
    b, t, _ = h.shape
    q = (h @ w_q).reshape(b, t, XATTN_HEADS, XATTN_HEAD_DIM)
    s = jnp.einsum('bthd,bmhd->bhtm', q, k.astype(q.dtype)).astype(F32) * (XATTN_HEAD_DIM ** -0.5)
    pr = jax.nn.softmax(s, axis=-1).astype(h.dtype)
    o = jnp.einsum('bhtm,bmhd->bthd', pr, v.astype(h.dtype)).reshape(b, t, XATTN_HEADS * XATTN_HEAD_DIM)
    return o @ w_xo


def decoder_layer(x, mem_k, mem_v, prev, p):
    b = x.shape[0]
    if prev is None:
        s0 = None
        conv_prev = jnp.zeros((b, CONV_K - 1, MIX_CONV), x.dtype)
        ffn_prev = jnp.zeros((b, FFN_CONV_K - 1, D_FF), x.dtype)
    else:
        s0 = (prev[0], prev[1])
        conv_prev, ffn_prev = prev[2], prev[3]

    h = rms_norm(x, p['norm_mix'])
    z = h @ p['w_in']
    u, xin, bg, cg = jnp.split(z, [MIX_SSM, MIX_SSM + MIX_CONV, MIX_SSM + 2 * MIX_CONV], axis=-1)
    y_ssm, s_re, s_im = s5_ssm(u, p['ssm_A_re'], p['ssm_A_im'], p['ssm_log_dt'], p['ssm_B_re'],
                               p['ssm_B_im'], p['ssm_C_re'], p['ssm_C_im'], p['ssm_D'], s0)
    y_ssm = jax.nn.gelu(y_ssm)
    y_ssm = y_ssm * jax.nn.sigmoid(y_ssm @ p['w_glu'] + p['b_glu'])
    conv_y, conv_buf = causal_dwconv(cg * xin, p['conv_w'], conv_prev)
    y_conv = bg * conv_y
    mixed = jnp.concatenate([rms_norm(y_ssm, p['norm_ssm_out']),
                             rms_norm(y_conv, p['norm_conv_out'])], axis=-1)
    x = x + mixed @ p['w_out']

    x = x + cross_attention(rms_norm(x, p['norm_xattn']), mem_k, mem_v, p['w_q'], p['w_xo'])

    h = rms_norm(x, p['norm_ffn'])
    a, ffn_buf = causal_dwconv(h @ p['w_up'], p['ffn_conv_w'], ffn_prev)
    x = x + (jax.nn.gelu(a) * (h @ p['w_gate'])) @ p['w_down']
    return x, (s_re, s_im, conv_buf, ffn_buf)


def setup_inputs(seed: int = 0) -> dict:
    key = jax.random.key(seed)
    ks = iter(jax.random.split(key, 48))
    L, D = DEPTH, D_MODEL
    G, N, P = SSM_GROUPS, SSM_STATE, SSM_GROUP_CH

    def nrm(shape, scale):
        return scale * jax.random.normal(next(ks), shape, F32)

    def gain(shape):
        return 1.0 + nrm(shape, 0.02)

    n_idx = jnp.arange(N, dtype=F32)
    return {
        "x_prompt": nrm((BATCH, SEQ, D), 1.0),
        "x_sample": nrm((DEC_BATCH, DEC_SEQ, D), 1.0),
        "mem_prompt": nrm((BATCH, N_MEM, D), 1.0),
        "cache_mem_k": nrm((L, DEC_BATCH, N_MEM, XATTN_HEADS, XATTN_HEAD_DIM), 1.0),
        "cache_mem_v": nrm((L, DEC_BATCH, N_MEM, XATTN_HEADS, XATTN_HEAD_DIM), 1.0),
        "state_ssm_re": nrm((L, DEC_BATCH, G, N), 0.1),
        "state_ssm_im": nrm((L, DEC_BATCH, G, N), 0.1),
        "state_conv": nrm((L, DEC_BATCH, CONV_K - 1, MIX_CONV), 1.0),
        "state_ffn_conv": nrm((L, DEC_BATCH, FFN_CONV_K - 1, D_FF), 1.0),
        "norm_mix": gain((L, D)),
        "w_in": nrm((L, D, MIX_SSM + 3 * MIX_CONV), D ** -0.5),
        "ssm_A_re": -0.5 + nrm((L, G, N), 0.01),
        "ssm_A_im": math.pi * n_idx + nrm((L, G, N), 0.01),
        "ssm_log_dt": jax.random.uniform(next(ks), (L, G), F32, math.log(1e-3), math.log(1e-1)),
        "ssm_B_re": nrm((L, G, N, P), (2 * P) ** -0.5),
        "ssm_B_im": nrm((L, G, N, P), (2 * P) ** -0.5),
        "ssm_C_re": nrm((L, G, P, N), (2 * N) ** -0.5),
        "ssm_C_im": nrm((L, G, P, N), (2 * N) ** -0.5),
        "ssm_D": nrm((L, G, P), 1.0),
        "w_glu": nrm((L, MIX_SSM, MIX_SSM), MIX_SSM ** -0.5),
        "b_glu": nrm((L, MIX_SSM), 0.02),
        "conv_w": nrm((L, CONV_K, MIX_CONV), CONV_K ** -0.5),
        "norm_ssm_out": gain((L, MIX_SSM)),
        "norm_conv_out": gain((L, MIX_CONV)),
        "w_out": nrm((L, D, D), D ** -0.5),
        "norm_xattn": gain((L, D)),
        "norm_mem": gain((L, D)),
        "w_q": nrm((L, D, XATTN_HEADS * XATTN_HEAD_DIM), D ** -0.5),
        "w_k": nrm((L, D, XATTN_HEADS * XATTN_HEAD_DIM), D ** -0.5),
        "w_v": nrm((L, D, XATTN_HEADS * XATTN_HEAD_DIM), D ** -0.5),
        "w_xo": nrm((L, XATTN_HEADS * XATTN_HEAD_DIM, D), D ** -0.5),
        "norm_ffn": gain((L, D)),
        "w_up": nrm((L, D, D_FF), D ** -0.5),
        "w_gate": nrm((L, D, D_FF), D ** -0.5),
        "ffn_conv_w": nrm((L, FFN_CONV_K, D_FF), FFN_CONV_K ** -0.5),
        "w_down": nrm((L, D_FF, D), D_FF ** -0.5),
        "norm_final": gain((D,)),
    }


def reference(x_prompt, x_sample, mem_prompt, cache_mem_k, cache_mem_v, state_ssm_re, state_ssm_im,
              state_conv, state_ffn_conv, norm_mix, w_in, ssm_A_re, ssm_A_im, ssm_log_dt, ssm_B_re,
              ssm_B_im, ssm_C_re, ssm_C_im, ssm_D, w_glu, b_glu, conv_w, norm_ssm_out, norm_conv_out,
              w_out, norm_xattn, norm_mem, w_q, w_k, w_v, w_xo, norm_ffn, w_up, w_gate, ffn_conv_w,
              w_down, norm_final):
    yp, ys = x_prompt, x_sample
    mk_p, mv_p, sre_p, sim_p, cb_p, fb_p = [], [], [], [], [], []
    sre_s, sim_s, cb_s, fb_s = [], [], [], []
    for l in range(DEPTH):
        p = dict(norm_mix=norm_mix[l], w_in=w_in[l], ssm_A_re=ssm_A_re[l], ssm_A_im=ssm_A_im[l],
                 ssm_log_dt=ssm_log_dt[l], ssm_B_re=ssm_B_re[l], ssm_B_im=ssm_B_im[l],
                 ssm_C_re=ssm_C_re[l], ssm_C_im=ssm_C_im[l], ssm_D=ssm_D[l], w_glu=w_glu[l],
                 b_glu=b_glu[l], conv_w=conv_w[l], norm_ssm_out=norm_ssm_out[l],
                 norm_conv_out=norm_conv_out[l], w_out=w_out[l], norm_xattn=norm_xattn[l],
                 w_q=w_q[l], w_xo=w_xo[l], norm_ffn=norm_ffn[l], w_up=w_up[l], w_gate=w_gate[l],
                 ffn_conv_w=ffn_conv_w[l], w_down=w_down[l])
        mk, mv = memory_kv(mem_prompt, norm_mem[l], w_k[l], w_v[l])
        yp, (a0, a1, a2, a3) = decoder_layer(yp, mk, mv, None, p)
        mk_p.append(mk); mv_p.append(mv)
        sre_p.append(a0); sim_p.append(a1); cb_p.append(a2); fb_p.append(a3)
        ys, (c0, c1, c2, c3) = decoder_layer(
            ys, cache_mem_k[l], cache_mem_v[l],
            (state_ssm_re[l], state_ssm_im[l], state_conv[l], state_ffn_conv[l]), p)
        sre_s.append(c0); sim_s.append(c1); cb_s.append(c2); fb_s.append(c3)
    yp = rms_norm(yp, norm_final)
    ys = rms_norm(ys, norm_final)
    return (yp, ys,
            jnp.stack(mk_p), jnp.stack(mv_p), jnp.stack(sre_p), jnp.stack(sim_p),
            jnp.stack(cb_p), jnp.stack(fb_p),
            jnp.stack(sre_s), jnp.stack(sim_s), jnp.stack(cb_s), jnp.stack(fb_s))
```

```cpp
#include <hip/hip_runtime.h>
#include <hip/hip_cooperative_groups.h>
#include <cstdio>
#include <cstdint>
namespace cg = cooperative_groups;

#define LAS __attribute__((address_space(3)))
typedef unsigned short bf16_t;
typedef short bf16x8 __attribute__((ext_vector_type(8)));
typedef float f32x4 __attribute__((ext_vector_type(4)));
typedef float f32x2 __attribute__((ext_vector_type(2)));
typedef unsigned u32x4 __attribute__((ext_vector_type(4)));
typedef unsigned u32x2 __attribute__((ext_vector_type(2)));

constexpr int D = 1024, NP = 16384, NS = 512, MT = NP + NS;
constexpr int TP = 2048, TS = 4, BP = 8, BS = 128;
constexpr int NZ = 2048, MIX = 512, DFF = 2816, NUG = 2 * DFF;
constexpr int SG = 32, SP = 16, SN = 64, LCH = 64, NCH = TP / LCH;
constexpr int NMEM = 256, NH = 4, HD = 256;
constexpr float EPS = 1e-6f;
constexpr int NWAVES = 8, NTHREADS = 512;

constexpr size_t MiB = 1u << 20;
constexpr size_t WS_WIN = 0;
constexpr size_t WS_WKV = WS_WIN + 4 * MiB;
constexpr size_t WS_WGLU = WS_WKV + 4 * MiB;
constexpr size_t WS_WOUT = WS_WGLU + 1 * MiB;
constexpr size_t WS_WQ = WS_WOUT + 2 * MiB;
constexpr size_t WS_WXO = WS_WQ + 2 * MiB;
constexpr size_t WS_WUG = WS_WXO + 2 * MiB;
constexpr size_t WS_WDN = WS_WUG + 11 * MiB;
constexpr size_t WS_H = WS_WDN + 6 * MiB;
constexpr size_t WS_X = WS_H + 33 * MiB;
constexpr size_t WS_OV = WS_X + 66 * MiB;
constexpr size_t WS_Z = WS_OV;
constexpr size_t WS_YG = WS_Z + 66 * MiB;
constexpr size_t WS_YS = WS_YG + 17 * MiB;
constexpr size_t WS_MIXN = WS_YS + 33 * MiB;
constexpr size_t WS_Q = WS_MIXN + 33 * MiB;
constexpr size_t WS_PR = WS_Q + 33 * MiB;
constexpr size_t WS_O = WS_PR + 32 * MiB;
constexpr size_t WS_MN = WS_O + 33 * MiB;
constexpr size_t WS_KB = WS_MN + 4 * MiB;
constexpr size_t WS_VT = WS_KB + 4 * MiB;
constexpr size_t WS_SE = WS_VT + 4 * MiB;
constexpr size_t WS_SI = WS_SE + 4 * MiB;
constexpr size_t WS_BB = WS_SI + 4 * MiB;
constexpr size_t WS_AT = WS_BB + 1 * MiB;
constexpr size_t WS_OV_END1 = WS_AT + 1 * MiB;
constexpr size_t WS_UG = WS_OV;
constexpr size_t WS_ACT = WS_UG + 182 * MiB;
constexpr size_t WS_END = WS_ACT + 91 * MiB;
static_assert(WS_OV_END1 <= WS_END, "overlay");
static_assert(WS_END <= 512 * MiB, "workspace");

constexpr size_t O_YP = 0;
constexpr size_t O_YS = O_YP + (size_t)NP * D;
constexpr size_t O_MK = O_YS + (size_t)NS * D;
constexpr size_t O_MV = O_MK + (size_t)BP * NMEM * D;
constexpr size_t O_SRP = O_MV + (size_t)BP * NMEM * D;
constexpr size_t O_SIP = O_SRP + (size_t)BP * SG * SN;
constexpr size_t O_CP = O_SIP + (size_t)BP * SG * SN;
constexpr size_t O_FP = O_CP + (size_t)BP * 2 * MIX;
constexpr size_t O_SRS = O_FP + (size_t)BP * 2 * DFF;
constexpr size_t O_SIS = O_SRS + (size_t)BS * SG * SN;
constexpr size_t O_CS = O_SIS + (size_t)BS * SG * SN;
constexpr size_t O_FS = O_CS + (size_t)BS * 2 * MIX;
constexpr size_t O_END = O_FS + (size_t)BS * 2 * DFF;

constexpr int RING_BYTES = 131072, XCH_OFF = RING_BYTES, LDS_BYTES = 147456;

__device__ __forceinline__ unsigned cvt_pk_bf16(float lo, float hi) { unsigned r; asm volatile("v_cvt_pk_bf16_f32 %0, %1, %2" : "=v"(r) : "v"(lo), "v"(hi)); return r; }
__device__ __forceinline__ float bf_lo(unsigned w) { return __uint_as_float(w << 16); }
__device__ __forceinline__ float bf_hi(unsigned w) { return __uint_as_float(w & 0xffff0000u); }
__device__ __forceinline__ float wave_sum(float v) {
#pragma unroll
    for (int o = 1; o < 64; o <<= 1) v += __shfl_xor(v, o);
    return v;
}
__device__ __forceinline__ float fast_exp(float x) { return __builtin_amdgcn_exp2f(x * 1.4426950408889634f); }
__device__ __forceinline__ float gelu_tanh(float x) {
    const float z = 0.7978845608028654f * (x + 0.044715f * x * x * x);
    return x * __builtin_amdgcn_rcpf(1.0f + fast_exp(-2.0f * z));
}
__device__ __forceinline__ float sigmoidf(float a) { return __builtin_amdgcn_rcpf(1.0f + fast_exp(-a)); }

namespace pg8 {
constexpr int BM = 256, BK = 64, HALF = 128, HTB = HALF * BK * 2;
__host__ __device__ __forceinline__ int lds_byte(int r, int c) { const int st = (r >> 4) * 2 + (c >> 5), rr = r & 15, cc = c & 31, ob = rr * 64 + cc * 2; return st * 1024 + (ob ^ (((ob >> 9) & 1) << 5)); }
__host__ __device__ __forceinline__ void stage_rc(int b, int& R, int& C) { const int st = b / 1024, sb = b % 1024, swz = sb ^ (((sb >> 9) & 1) << 5); R = (st >> 1) * 16 + swz / 64; C = (st & 1) * 32 + (swz % 64) / 2; }
__host__ __device__ __forceinline__ int perm32(int rho) { const int n = rho >> 4, i = rho & 15; return 8 * (i >> 2) + 4 * n + (i & 3); }

struct Unit { int pm, pn, kind; const char* A; const char* B; };

__device__ __forceinline__ void order_map(int L, int nM, int nN, int& pm, int& pn) {
    const int nwg = nM * nN; int wgid = L;
    { const int q = nwg / 8, r = nwg % 8, xcd = wgid % 8, off = wgid / 8; wgid = (xcd < r ? xcd * (q + 1) : r * (q + 1) + (xcd - r) * q) + off; }
    const int nig = 8 * nN, gid = wgid / nig, fm = gid * 8, gsz = (nM - fm) < 8 ? (nM - fm) : 8;
    pm = fm + ((wgid % nig) % gsz); pn = (wgid % nig) / gsz;
}

template <class Epi, class Sched>
__device__ __forceinline__ void gemm_phase(LAS unsigned char* lds, const int K, const int lda, const int ldb, const Sched& S, Epi& E) {
    int tid_l = threadIdx.x; asm volatile("" : "+v"(tid_l));
    const int tid = tid_l, wid = __builtin_amdgcn_readfirstlane(tid >> 6), lane = tid & 63, wr = wid >> 2, wc = wid & 3, fr = lane & 15, fq = lane >> 4;
    const int nt = K / BK;
    unsigned voffA[2], voffB[2];
#pragma unroll
    for (int i = 0; i < 2; ++i) { int R, C; stage_rc(tid * 16 + i * 8192, R, C); const int Rb = (R & ~31) + perm32(R & 31);
        voffA[i] = (unsigned)(R * lda + C) * 2u; voffB[i] = (unsigned)(Rb * ldb + C) * 2u; }
    const size_t kstep = (size_t)(BK * 2);
    const size_t hstepA = (size_t)HALF * lda * 2, hstepB = (size_t)HALF * ldb * 2;
    const unsigned ldsw = (unsigned)wid * 1024u;
    const int aoff = lds_byte(wr * 64 + fr, fq * 8), boff = lds_byte(wc * 32 + fr, fq * 8);
#define PG8_SA(b, h) (((b) * 2 + (h)) * HTB)
#define PG8_SB(b, h) ((4 + (b) * 2 + (h)) * HTB)
#define PG8_STAGE(bufoff, gbase, voff) do { _Pragma("unroll") for (int _i = 0; _i < 2; ++_i) \
        __builtin_amdgcn_global_load_lds((const unsigned*)((const char*)(gbase) + (voff)[_i]), (LAS unsigned*)(lds + (bufoff) + ldsw + _i * 8192), 16, 0, 0); } while (0)
#define PG8_LDA(dst, b, h) do { _Pragma("unroll") for (int m = 0; m < 4; ++m) _Pragma("unroll") for (int k = 0; k < 2; ++k) dst[m][k] = *(const LAS bf16x8*)(lds + PG8_SA(b, h) + aoff + m * 2048 + k * 1024); } while (0)
#define PG8_LDB(dst, b, h) do { _Pragma("unroll") for (int n = 0; n < 2; ++n) _Pragma("unroll") for (int k = 0; k < 2; ++k) dst[n][k] = *(const LAS bf16x8*)(lds + PG8_SB(b, h) + boff + n * 2048 + k * 1024); } while (0)
#define PG8_MMA(ai, bj, At, Bt) do { __builtin_amdgcn_s_setprio(1); _Pragma("unroll") for (int m = 0; m < 4; ++m) _Pragma("unroll") for (int n = 0; n < 2; ++n) _Pragma("unroll") for (int k = 0; k < 2; ++k) \
        acc[ai][bj][m][n] = __builtin_amdgcn_mfma_f32_16x16x32_bf16(Bt[n][k], At[m][k], acc[ai][bj][m][n], 0, 0, 0); __builtin_amdgcn_s_setprio(0); } while (0)
#define PG8_WAIT_V(n) asm volatile("s_waitcnt vmcnt(" #n ")" ::: "memory")
#define PG8_WAIT_L(n) asm volatile("s_waitcnt lgkmcnt(" #n ")" ::: "memory")
#define PG8_BAR __builtin_amdgcn_s_barrier()
#define PG8_SCHED __builtin_amdgcn_sched_barrier(0)
    Unit cur, nxt; int ui = 0;
    if (!S.next(0, cur)) return;
    f32x4 acc[2][2][4][2];
#pragma unroll
    for (int a = 0; a < 2; ++a)
#pragma unroll
        for (int b = 0; b < 2; ++b)
#pragma unroll
            for (int m = 0; m < 4; ++m)
#pragma unroll
                for (int n = 0; n < 2; ++n) acc[a][b][m][n] = (f32x4){0.f, 0.f, 0.f, 0.f};
    bf16x8 At[4][2], B0[2][2], B1[2][2];
    const char* cA = cur.A; const char* cB = cur.B;
    PG8_STAGE(PG8_SB(0, 0), cB, voffB); PG8_STAGE(PG8_SB(0, 1), cB + hstepB, voffB); PG8_STAGE(PG8_SA(0, 0), cA, voffA); PG8_STAGE(PG8_SA(0, 1), cA + hstepA, voffA);
    if (wr == 1) PG8_BAR;
    PG8_WAIT_V(2); PG8_BAR;
    PG8_STAGE(PG8_SB(1, 0), cB + kstep, voffB); PG8_STAGE(PG8_SA(1, 0), cA + kstep, voffA); PG8_STAGE(PG8_SB(1, 1), cB + hstepB + kstep, voffB);
    PG8_WAIT_V(6); PG8_BAR;
    for (;;) {
        const bool has_next = S.next(ui + 1, nxt);
        const char* nA = has_next ? nxt.A : cA; const char* nB = has_next ? nxt.B : cB;
#pragma unroll 1
        for (int t = 0; t < nt; t += 2) {
            const bool last = (t == nt - 2);
            const char* a1 = cA + (size_t)(t + 1) * kstep;
            const char* a2 = last ? nA : cA + (size_t)(t + 2) * kstep; const char* b2 = last ? nB : cB + (size_t)(t + 2) * kstep;
            const char* a3 = a2 + kstep; const char* b3 = b2 + kstep;
            PG8_LDB(B0, 0, 0); PG8_LDB(B1, 0, 1); PG8_SCHED; PG8_LDA(At, 0, 0); PG8_STAGE(PG8_SA(1, 1), a1 + hstepA, voffA);
            PG8_WAIT_V(8); PG8_WAIT_L(0); PG8_BAR; PG8_MMA(0, 0, At, B0); PG8_MMA(0, 1, At, B1); PG8_BAR; PG8_SCHED;
            PG8_LDA(At, 0, 1); PG8_STAGE(PG8_SB(0, 0), b2, voffB); PG8_STAGE(PG8_SB(0, 1), b2 + hstepB, voffB); PG8_STAGE(PG8_SA(0, 0), a2, voffA);
            PG8_WAIT_V(8); PG8_WAIT_L(0); PG8_BAR; PG8_MMA(1, 0, At, B0); PG8_MMA(1, 1, At, B1); PG8_BAR; PG8_SCHED;
            PG8_LDB(B0, 1, 0); PG8_LDB(B1, 1, 1); PG8_SCHED; PG8_LDA(At, 1, 0); PG8_STAGE(PG8_SA(0, 1), a2 + hstepA, voffA);
            PG8_WAIT_V(8); PG8_WAIT_L(0); PG8_BAR; PG8_MMA(0, 0, At, B0); PG8_MMA(0, 1, At, B1); PG8_BAR; PG8_SCHED;
            PG8_LDA(At, 1, 1); PG8_STAGE(PG8_SB(1, 0), b3, voffB); PG8_STAGE(PG8_SB(1, 1), b3 + hstepB, voffB); PG8_STAGE(PG8_SA(1, 0), a3, voffA);
            PG8_WAIT_V(8); PG8_WAIT_L(0); PG8_BAR; PG8_MMA(1, 0, At, B0); PG8_MMA(1, 1, At, B1); PG8_BAR; PG8_SCHED;
        }
        if (wr == 0) PG8_BAR;
        E(acc, cur, wr, wc, fr, fq);
        if (!has_next) break;
#pragma unroll
        for (int a = 0; a < 2; ++a)
#pragma unroll
            for (int b = 0; b < 2; ++b)
#pragma unroll
                for (int m = 0; m < 4; ++m)
#pragma unroll
                    for (int n = 0; n < 2; ++n) acc[a][b][m][n] = (f32x4){0.f, 0.f, 0.f, 0.f};
        cur = nxt; cA = nA; cB = nB; ++ui;
        if (wr == 1) PG8_BAR;
    }
    PG8_WAIT_V(0);
    PG8_BAR;
#undef PG8_SA
#undef PG8_SB
#undef PG8_STAGE
#undef PG8_LDA
#undef PG8_LDB
#undef PG8_MMA
#undef PG8_WAIT_V
#undef PG8_WAIT_L
#undef PG8_BAR
#undef PG8_SCHED
}
}
using pg8::Unit;
typedef f32x4 Acc[2][2][4][2];

struct Sched2 {
    int G, c; int nM0, nN0, nM1, nN1;
    const char* A0; const char* B0; const char* A1; const char* B1; size_t a_pm, b_pn;
    __device__ __forceinline__ bool next(int i, Unit& u) const {
        const int L = i * G + c, n0 = nM0 * nN0, n1 = nM1 * nN1;
        if (L >= n0 + n1) return false;
        if (L < n0) { pg8::order_map(L, nM0, nN0, u.pm, u.pn); u.kind = 0; u.A = A0 + (size_t)u.pm * a_pm; u.B = B0 + (size_t)u.pn * b_pn; }
        else { pg8::order_map(L - n0, nM1, nN1, u.pm, u.pn); u.kind = 1; u.A = A1 + (size_t)u.pm * a_pm; u.B = B1 + (size_t)u.pn * b_pn; }
        return true;
    }
};

#define EPI_ROWS(...) _Pragma("unroll") for (int ai = 0; ai < 2; ++ai) _Pragma("unroll") for (int m = 0; m < 4; ++m) { const int row = u.pm * 256 + ai * 128 + wr * 64 + m * 16 + fr; \
    _Pragma("unroll") for (int bj = 0; bj < 2; ++bj) { const int col = u.pn * 256 + bj * 128 + wc * 32 + fq * 8; const f32x4 v0 = acc[ai][bj][m][0], v1 = acc[ai][bj][m][1]; __VA_ARGS__ } }

__device__ __forceinline__ u32x4 pack8(f32x4 v0, f32x4 v1) { u32x4 w; w.x = cvt_pk_bf16(v0[0], v0[1]); w.y = cvt_pk_bf16(v0[2], v0[3]); w.z = cvt_pk_bf16(v1[0], v1[1]); w.w = cvt_pk_bf16(v1[2], v1[3]); return w; }

struct EpiP1 {
    bf16_t* Z; float* outK; float* outV; bf16_t* KB; bf16_t* VT;
    __device__ __forceinline__ void operator()(Acc& acc, const Unit& u, int wr, int wc, int fr, int fq) const {
        if (u.kind == 0) {
            EPI_ROWS( *(u32x4*)(Z + (size_t)row * NZ + col) = pack8(v0, v1); )
        } else if (u.pn < 4) {
            EPI_ROWS( float* o = outK + (size_t)row * D + col; *(f32x4*)o = v0; *(f32x4*)(o + 4) = v1; *(u32x4*)(KB + (size_t)row * D + col) = pack8(v0, v1); )
        } else {
            EPI_ROWS( const int vc = col - 1024; float* o = outV + (size_t)row * D + vc; *(f32x4*)o = v0; *(f32x4*)(o + 4) = v1;
                      const int h = vc >> 8, d0 = vc & 255, key = row & 255; bf16_t* vt = VT + ((size_t)(u.pm * NH + h) * HD + d0) * NMEM + key;
                      const u32x4 w = pack8(v0, v1);
                      vt[0 * NMEM] = (bf16_t)(w.x & 0xffff); vt[1 * NMEM] = (bf16_t)(w.x >> 16); vt[2 * NMEM] = (bf16_t)(w.y & 0xffff); vt[3 * NMEM] = (bf16_t)(w.y >> 16);
                      vt[4 * NMEM] = (bf16_t)(w.z & 0xffff); vt[5 * NMEM] = (bf16_t)(w.z >> 16); vt[6 * NMEM] = (bf16_t)(w.w & 0xffff); vt[7 * NMEM] = (bf16_t)(w.w >> 16); )
        }
    }
};
struct EpiGlu {
    const bf16_t* YG; const float* bias; float* YS;
    __device__ __forceinline__ void operator()(Acc& acc, const Unit& u, int wr, int wc, int fr, int fq) const {
        EPI_ROWS( const u32x4 yw = *(const u32x4*)(YG + (size_t)row * MIX + col); const f32x4 b0 = *(const f32x4*)(bias + col), b1 = *(const f32x4*)(bias + col + 4);
                  f32x4 o0, o1;
                  o0[0] = bf_lo(yw.x) * sigmoidf(v0[0] + b0[0]); o0[1] = bf_hi(yw.x) * sigmoidf(v0[1] + b0[1]); o0[2] = bf_lo(yw.y) * sigmoidf(v0[2] + b0[2]); o0[3] = bf_hi(yw.y) * sigmoidf(v0[3] + b0[3]);
                  o1[0] = bf_lo(yw.z) * sigmoidf(v1[0] + b1[0]); o1[1] = bf_hi(yw.z) * sigmoidf(v1[1] + b1[1]); o1[2] = bf_lo(yw.w) * sigmoidf(v1[2] + b1[2]); o1[3] = bf_hi(yw.w) * sigmoidf(v1[3] + b1[3]);
                  float* o = YS + (size_t)row * MIX + col; *(f32x4*)o = o0; *(f32x4*)(o + 4) = o1; )
    }
};
struct EpiRes {
    const float* xp; const float* xs; float* X; int first;
    __device__ __forceinline__ void operator()(Acc& acc, const Unit& u, int wr, int wc, int fr, int fq) const {
        EPI_ROWS( const float* b = first ? (row < NP ? xp + (size_t)row * D : xs + (size_t)(row - NP) * D) : (const float*)(X + (size_t)row * D);
                  const f32x4 r0 = *(const f32x4*)(b + col), r1 = *(const f32x4*)(b + col + 4);
                  float* o = X + (size_t)row * D + col; *(f32x4*)o = r0 + v0; *(f32x4*)(o + 4) = r1 + v1; )
    }
};
struct EpiBf {
    bf16_t* O; int ld; float scale;
    __device__ __forceinline__ void operator()(Acc& acc, const Unit& u, int wr, int wc, int fr, int fq) const {
        EPI_ROWS( *(u32x4*)(O + (size_t)row * ld + col) = pack8(v0 * scale, v1 * scale); )
    }
};
struct EpiSoftmax {
    bf16_t* PR; LAS unsigned char* lds;
    __device__ __forceinline__ void operator()(Acc& acc, const Unit& u, int wr, int wc, int fr, int fq) const {
        LAS f32x2* X = (LAS f32x2*)(lds + XCH_OFF);
#pragma unroll
        for (int ai = 0; ai < 2; ++ai)
#pragma unroll
            for (int m = 0; m < 4; ++m) {
                float mx = -3.0e38f;
#pragma unroll
                for (int bj = 0; bj < 2; ++bj)
#pragma unroll
                    for (int n = 0; n < 2; ++n) { const f32x4 x = acc[ai][bj][m][n]; mx = fmaxf(mx, fmaxf(fmaxf(x[0], x[1]), fmaxf(x[2], x[3]))); }
                mx = fmaxf(mx, __shfl_xor(mx, 16)); mx = fmaxf(mx, __shfl_xor(mx, 32));
                float s = 0.f;
#pragma unroll
                for (int bj = 0; bj < 2; ++bj)
#pragma unroll
                    for (int n = 0; n < 2; ++n) { f32x4 x = acc[ai][bj][m][n];
                        x[0] = fast_exp(x[0] - mx); x[1] = fast_exp(x[1] - mx); x[2] = fast_exp(x[2] - mx); x[3] = fast_exp(x[3] - mx);
                        s += (x[0] + x[1]) + (x[2] + x[3]); acc[ai][bj][m][n] = x; }
                s += __shfl_xor(s, 16); s += __shfl_xor(s, 32);
                if (fq == 0) X[(ai * 128 + wr * 64 + m * 16 + fr) * 4 + wc] = (f32x2){mx, s};
            }
        asm volatile("s_waitcnt lgkmcnt(0)" ::: "memory"); __builtin_amdgcn_s_barrier(); asm volatile("" ::: "memory");
#pragma unroll
        for (int ai = 0; ai < 2; ++ai)
#pragma unroll
            for (int m = 0; m < 4; ++m) {
                const int rl = ai * 128 + wr * 64 + m * 16 + fr;
                const f32x2 a = X[rl * 4 + 0], b = X[rl * 4 + 1], c = X[rl * 4 + 2], d = X[rl * 4 + 3];
                const float M = fmaxf(fmaxf(a.x, b.x), fmaxf(c.x, d.x));
                const float tot = a.y * fast_exp(a.x - M) + b.y * fast_exp(b.x - M) + c.y * fast_exp(c.x - M) + d.y * fast_exp(d.x - M);
                const float own = wc == 0 ? a.x : (wc == 1 ? b.x : (wc == 2 ? c.x : d.x));
                const float f = fast_exp(own - M) / tot;
                bf16_t* prow = PR + ((size_t)(u.pm * NH + u.pn) * 256 + rl) * 256;
#pragma unroll
                for (int bj = 0; bj < 2; ++bj) { const int col = bj * 128 + wc * 32 + fq * 8; *(u32x4*)(prow + col) = pack8(acc[ai][bj][m][0] * f, acc[ai][bj][m][1] * f); }
                asm volatile("" ::: "memory");
            }
    }
};

#ifndef ONLY
#define ONLY -1
#endif
#define PH(k) (ONLY < 0 || ONLY == (k))
struct Args { const float* in[37]; float* out; unsigned char* ws; };

__device__ __forceinline__ void transpose_item(const float* W, int K, int N, bf16_t* WT, int row_off, LAS float* scr, int item, int lane) {
    const int nblk = N / 32, kb = item / nblk, nb = item % nblk, k0 = 64 * kb, n0 = 32 * nb;
#pragma unroll 8
    for (int i = 0; i < 32; ++i) { const int kk = 2 * i + (lane >> 5); scr[kk * 33 + (lane & 31)] = W[(size_t)(k0 + kk) * N + n0 + (lane & 31)]; }
    asm volatile("s_waitcnt lgkmcnt(0)" ::: "memory");
    const int c = lane & 7;
#pragma unroll
    for (int j = 0; j < 4; ++j) { const int n = (lane >> 3) + 8 * j; const LAS float* s = scr + (8 * c) * 33 + n;
        u32x4 o; o.x = cvt_pk_bf16(s[0 * 33], s[1 * 33]); o.y = cvt_pk_bf16(s[2 * 33], s[3 * 33]); o.z = cvt_pk_bf16(s[4 * 33], s[5 * 33]); o.w = cvt_pk_bf16(s[6 * 33], s[7 * 33]);
        *(u32x4*)(WT + (size_t)(row_off + n0 + n) * K + k0 + 8 * c) = o; }
    asm volatile("s_waitcnt lgkmcnt(0)" ::: "memory");
}

__device__ __forceinline__ void rms_row_bf16(const float* xrow, const float* g, bf16_t* orow, int lane) {
    const f32x4* xr = (const f32x4*)xrow + lane; f32x4 v[4]; float s = 0.f;
#pragma unroll
    for (int j = 0; j < 4; ++j) { v[j] = xr[64 * j]; s += (v[j][0] * v[j][0] + v[j][1] * v[j][1]) + (v[j][2] * v[j][2] + v[j][3] * v[j][3]); }
    const float rstd = 1.0f / sqrtf(wave_sum(s) * (1.0f / D) + EPS);
    u32x2* o8 = (u32x2*)orow + lane;
#pragma unroll
    for (int j = 0; j < 4; ++j) { const f32x4 gg = ((const f32x4*)g)[lane + 64 * j]; u32x2 w; w.x = cvt_pk_bf16(v[j][0] * rstd * gg[0], v[j][1] * rstd * gg[1]); w.y = cvt_pk_bf16(v[j][2] * rstd * gg[2], v[j][3] * rstd * gg[3]); o8[64 * j] = w; }
}
__device__ __forceinline__ void rms_row_f32(const float* xrow, const float* g, float* orow, int lane) {
    const f32x4* xr = (const f32x4*)xrow + lane; f32x4 v[4]; float s = 0.f;
#pragma unroll
    for (int j = 0; j < 4; ++j) { v[j] = xr[64 * j]; s += (v[j][0] * v[j][0] + v[j][1] * v[j][1]) + (v[j][2] * v[j][2] + v[j][3] * v[j][3]); }
    const float rstd = 1.0f / sqrtf(wave_sum(s) * (1.0f / D) + EPS);
#pragma unroll
    for (int j = 0; j < 4; ++j) { const f32x4 gg = ((const f32x4*)g)[lane + 64 * j]; ((f32x4*)orow)[lane + 64 * j] = v[j] * rstd * gg; }
}

__device__ __forceinline__ float treduce16(float (&v)[16], int lane) {
    { const bool hi = lane & 32;
#pragma unroll
      for (int i = 0; i < 8; ++i) { const float send = hi ? v[i] : v[i + 8], keep = hi ? v[i + 8] : v[i]; v[i] = keep + __shfl_xor(send, 32); } }
    { const bool hi = lane & 16;
#pragma unroll
      for (int i = 0; i < 4; ++i) { const float send = hi ? v[i] : v[i + 4], keep = hi ? v[i + 4] : v[i]; v[i] = keep + __shfl_xor(send, 16); } }
    { const bool hi = lane & 8;
#pragma unroll
      for (int i = 0; i < 2; ++i) { const float send = hi ? v[i] : v[i + 2], keep = hi ? v[i + 2] : v[i]; v[i] = keep + __shfl_xor(send, 8); } }
    { const bool hi = lane & 4; const float send = hi ? v[0] : v[1], keep = hi ? v[1] : v[0]; v[0] = keep + __shfl_xor(send, 4); }
    v[0] += __shfl_xor(v[0], 2); v[0] += __shfl_xor(v[0], 1);
    return v[0];
}
template <int W> __device__ __forceinline__ void tr_step(float (&v)[64], int lane) {
    const bool hi = lane & W;
#pragma unroll
    for (int i = 0; i < W; ++i) { const float send = hi ? v[i] : v[i + W], keep = hi ? v[i + W] : v[i]; v[i] = keep + __shfl_xor(send, W); }
}
__device__ __forceinline__ float treduce64(float (&v)[64], int lane) {
    tr_step<32>(v, lane); tr_step<16>(v, lane); tr_step<8>(v, lane); tr_step<4>(v, lane); tr_step<2>(v, lane); tr_step<1>(v, lane);
    return v[0];
}

template <bool WITH_Y>
__device__ __forceinline__ void ssm_tile(const bf16_t* zu, int nsteps, float& sr, float& si, const float* BB, const float* AT, const float* Cre, const float* Cim, const float* Dv,
                                         int g, bf16_t* yg, int lane) {
    float Br[16], Bi[16];
    { const f32x4* bp = (const f32x4*)(BB + (size_t)(g * SN + lane) * 32);
#pragma unroll
      for (int j = 0; j < 4; ++j) { const f32x4 a = bp[j], b = bp[4 + j]; Br[4 * j] = a[0]; Br[4 * j + 1] = a[1]; Br[4 * j + 2] = a[2]; Br[4 * j + 3] = a[3]; Bi[4 * j] = b[0]; Bi[4 * j + 1] = b[1]; Bi[4 * j + 2] = b[2]; Bi[4 * j + 3] = b[3]; } }
    const f32x4 at = *(const f32x4*)(AT + (size_t)(g * SN + lane) * 4); const float ar = at[0], ai = at[1];
    float Cr[16], Ci[16], Dm[16];
    if (WITH_Y) {
#pragma unroll
        for (int p = 0; p < 16; ++p) { Cr[p] = Cre[(size_t)(g * SP + p) * SN + lane]; Ci[p] = Cim[(size_t)(g * SP + p) * SN + lane]; Dm[p] = (lane == 0) ? Dv[g * SP + p] : 0.f; }
    }
    u32x4 u0 = (u32x4){0, 0, 0, 0}, u1 = (u32x4){0, 0, 0, 0};
    if (lane < nsteps) { const u32x4* up = (const u32x4*)(zu + (size_t)lane * NZ); u0 = up[0]; u1 = up[1]; }
    const int p_own = ((lane >> 5) & 1) * 8 + ((lane >> 4) & 1) * 4 + ((lane >> 3) & 1) * 2 + ((lane >> 2) & 1);
    for (int t = 0; t < nsteps; ++t) {
        float uu[16];
        { unsigned w;
          w = __builtin_amdgcn_readlane(u0.x, t); uu[0] = bf_lo(w); uu[1] = bf_hi(w);
          w = __builtin_amdgcn_readlane(u0.y, t); uu[2] = bf_lo(w); uu[3] = bf_hi(w);
          w = __builtin_amdgcn_readlane(u0.z, t); uu[4] = bf_lo(w); uu[5] = bf_hi(w);
          w = __builtin_amdgcn_readlane(u0.w, t); uu[6] = bf_lo(w); uu[7] = bf_hi(w);
          w = __builtin_amdgcn_readlane(u1.x, t); uu[8] = bf_lo(w); uu[9] = bf_hi(w);
          w = __builtin_amdgcn_readlane(u1.y, t); uu[10] = bf_lo(w); uu[11] = bf_hi(w);
          w = __builtin_amdgcn_readlane(u1.z, t); uu[12] = bf_lo(w); uu[13] = bf_hi(w);
          w = __builtin_amdgcn_readlane(u1.w, t); uu[14] = bf_lo(w); uu[15] = bf_hi(w); }
        float br = 0.f, bi = 0.f;
#pragma unroll
        for (int p = 0; p < 16; ++p) { br = fmaf(Br[p], uu[p], br); bi = fmaf(Bi[p], uu[p], bi); }
        const float nr = ar * sr - ai * si + br, ni = ar * si + ai * sr + bi;
        sr = nr; si = ni;
        if (WITH_Y) {
            float v[16];
#pragma unroll
            for (int p = 0; p < 16; ++p) v[p] = fmaf(Dm[p], uu[p], Cr[p] * sr - Ci[p] * si);
            const float y = treduce16(v, lane);
            const float gy = gelu_tanh(y);
            if ((lane & 3) == 0) yg[(size_t)t * MIX + g * SP + p_own] = (bf16_t)(cvt_pk_bf16(gy, 0.f) & 0xffff);
        }
    }
}

__device__ __forceinline__ const float* ld_in(int k) {
    const __attribute__((address_space(4))) unsigned long long* t = (const __attribute__((address_space(4))) unsigned long long*)__builtin_amdgcn_kernarg_segment_ptr();
    asm volatile("" : "+s"(t));
    return (const float*)t[k];
}
__global__ void __launch_bounds__(NTHREADS, 2) hymba_fwd(Args args) {
    extern __shared__ __attribute__((aligned(16))) unsigned char lds_raw[];
    LAS unsigned char* lds = (LAS unsigned char*)lds_raw;
    cg::grid_group grid = cg::this_grid();
    const int tid = threadIdx.x, lane = tid & 63, wave = __builtin_amdgcn_readfirstlane(tid >> 6);
    const int G = gridDim.x, bx = blockIdx.x;
    const int gw = bx * NWAVES + wave, NGW = G * NWAVES;
#define IN(k) ld_in(k)
    unsigned char* ws = (unsigned char*)ld_in(38); float* out = (float*)ld_in(37);
    bf16_t* WIN = (bf16_t*)(ws + WS_WIN); bf16_t* WKV = (bf16_t*)(ws + WS_WKV); bf16_t* WGLU = (bf16_t*)(ws + WS_WGLU); bf16_t* WOUT = (bf16_t*)(ws + WS_WOUT);
    bf16_t* WQ = (bf16_t*)(ws + WS_WQ); bf16_t* WXO = (bf16_t*)(ws + WS_WXO); bf16_t* WUG = (bf16_t*)(ws + WS_WUG); bf16_t* WDN = (bf16_t*)(ws + WS_WDN);
    bf16_t* H = (bf16_t*)(ws + WS_H); float* X = (float*)(ws + WS_X);
    bf16_t* Z = (bf16_t*)(ws + WS_Z); bf16_t* YG = (bf16_t*)(ws + WS_YG); float* YS = (float*)(ws + WS_YS); bf16_t* MIXN = (bf16_t*)(ws + WS_MIXN);
    bf16_t* Q = (bf16_t*)(ws + WS_Q); bf16_t* PR = (bf16_t*)(ws + WS_PR); bf16_t* O = (bf16_t*)(ws + WS_O);
    bf16_t* MN = (bf16_t*)(ws + WS_MN); bf16_t* KB = (bf16_t*)(ws + WS_KB); bf16_t* VT = (bf16_t*)(ws + WS_VT);
    float* SE = (float*)(ws + WS_SE); float* SI = (float*)(ws + WS_SI); float* BB = (float*)(ws + WS_BB); float* AT = (float*)(ws + WS_AT);
    bf16_t* UG = (bf16_t*)(ws + WS_UG); bf16_t* ACT = (bf16_t*)(ws + WS_ACT);

    if (PH(0)) {
        const float* x_prompt = IN(0); const float* x_sample = IN(1); const float* mem_prompt = IN(2); const float* norm_mix = IN(9); const float* w_in = IN(10);
        const float* A_re = IN(11); const float* A_im = IN(12); const float* log_dt = IN(13); const float* B_re = IN(14); const float* B_im = IN(15);
        const float* w_glu = IN(19); const float* w_out = IN(24); const float* norm_mem = IN(26); const float* w_q = IN(27); const float* w_k = IN(28); const float* w_v = IN(29); const float* w_xo = IN(30);
        const float* w_up = IN(32); const float* w_gate = IN(33); const float* w_down = IN(35);
        LAS float* scr = (LAS float*)(lds + wave * 16384);
        constexpr int I_IN = 16 * 64, I_D = 16 * 32, I_GLU = 8 * 16, I_UP = 16 * 88, I_DN = 44 * 32;
        constexpr int NITEMS = I_IN + 5 * I_D + I_GLU + 2 * I_UP + I_DN;
        for (int it = gw; it < NITEMS; it += NGW) {
            int r = it;
            if (r < I_IN) { transpose_item(w_in, D, NZ, WIN, 0, scr, r, lane); continue; } r -= I_IN;
            if (r < I_D) { transpose_item(w_k, D, D, WKV, 0, scr, r, lane); continue; } r -= I_D;
            if (r < I_D) { transpose_item(w_v, D, D, WKV, D, scr, r, lane); continue; } r -= I_D;
            if (r < I_D) { transpose_item(w_out, D, D, WOUT, 0, scr, r, lane); continue; } r -= I_D;
            if (r < I_D) { transpose_item(w_q, D, D, WQ, 0, scr, r, lane); continue; } r -= I_D;
            if (r < I_D) { transpose_item(w_xo, D, D, WXO, 0, scr, r, lane); continue; } r -= I_D;
            if (r < I_GLU) { transpose_item(w_glu, MIX, MIX, WGLU, 0, scr, r, lane); continue; } r -= I_GLU;
            if (r < I_UP) { transpose_item(w_up, D, DFF, WUG, 0, scr, r, lane); continue; } r -= I_UP;
            if (r < I_UP) { transpose_item(w_gate, D, DFF, WUG, DFF, scr, r, lane); continue; } r -= I_UP;
            transpose_item(w_down, DFF, D, WDN, 0, scr, r, lane);
        }
        for (int m = gw; m < MT; m += NGW) rms_row_bf16(m < NP ? x_prompt + (size_t)m * D : x_sample + (size_t)(m - NP) * D, norm_mix, H + (size_t)m * D, lane);
        for (int m = gw; m < BP * NMEM; m += NGW) rms_row_bf16(mem_prompt + (size_t)m * D, norm_mem, MN + (size_t)m * D, lane);
        const int gt = bx * NTHREADS + tid;
        if (gt < SG * SN) {
            const int g = gt / SN;
            const float dt = expf(log_dt[g]), lr = A_re[gt], li = A_im[gt];
            const float mag = expf(dt * lr), ph = dt * li;
            double th = (double)ph * (1.0 / 1024.0), t2 = th * th;
            double c = 1.0 - t2 * (0.5 - t2 * (1.0 / 24.0 - t2 * (1.0 / 720.0)));
            double s = th * (1.0 - t2 * (1.0 / 6.0 - t2 * (1.0 / 120.0 - t2 * (1.0 / 5040.0))));
#pragma unroll 1
            for (int k = 0; k < 10; ++k) { const double c2 = c * c - s * s, s2 = 2.0 * c * s; c = c2; s = s2; }
            const float ar = mag * (float)c, ai = mag * (float)s;
            const float den = lr * lr + li * li;
            const float cr = ((ar - 1.0f) * lr + ai * li) / den, ci = (ai * lr - (ar - 1.0f) * li) / den;
#pragma unroll
            for (int p = 0; p < 16; ++p) { const float br = B_re[(size_t)gt * SP + p], bi = B_im[(size_t)gt * SP + p];
                BB[(size_t)gt * 32 + p] = cr * br - ci * bi; BB[(size_t)gt * 32 + 16 + p] = cr * bi + ci * br; }
            float pr = ar, pi = ai;
#pragma unroll 1
            for (int k = 0; k < 6; ++k) { const float r2 = pr * pr - pi * pi, i2 = 2.0f * pr * pi; pr = r2; pi = i2; }
            *(f32x4*)(AT + (size_t)gt * 4) = (f32x4){ar, ai, pr, pi};
        }
    }
    grid.sync();

    if (PH(1)) {
        Sched2 S{G, bx, MT / 256, NZ / 256, BP, 8, (const char*)H, (const char*)WIN, (const char*)MN, (const char*)WKV, (size_t)256 * D * 2, (size_t)256 * D * 2};
        EpiP1 E{Z, out + O_MK, out + O_MV, KB, VT};
        pg8::gemm_phase(lds, D, D, D, S, E);
    }
    grid.sync();

    if (PH(2)) {
        const float* st_re = IN(5); const float* st_im = IN(6); const float* st_conv = IN(7); const float* C_re = IN(16); const float* C_im = IN(17); const float* Dssm = IN(18); const float* conv_w = IN(21); const float* norm_conv = IN(23);
        for (int task = gw; task < BP * SG * NCH; task += NGW) {
            const int c = task % NCH, g = (task / NCH) % SG, b = task / (NCH * SG);
            float sr = 0.f, si = 0.f;
            ssm_tile<false>(Z + (size_t)(b * TP + c * LCH) * NZ + g * SP, LCH, sr, si, BB, AT, C_re, C_im, Dssm, g, nullptr, lane);
            float* e = SE + ((size_t)(b * SG + g) * NCH + c) * 128; e[lane] = sr; e[64 + lane] = si;
        }
        for (int task = gw; task < BS * SG; task += NGW) {
            const int b = task % BS, g = task / BS;
            float sr = st_re[(size_t)(b * SG + g) * SN + lane], si = st_im[(size_t)(b * SG + g) * SN + lane];
            ssm_tile<true>(Z + (size_t)(NP + b * TS) * NZ + g * SP, TS, sr, si, BB, AT, C_re, C_im, Dssm, g, YG + (size_t)(NP + b * TS) * MIX, lane);
            out[O_SRS + (size_t)(b * SG + g) * SN + lane] = sr; out[O_SIS + (size_t)(b * SG + g) * SN + lane] = si;
        }
        for (int r = gw; r < MT; r += NGW) {
            int b, t; const float* prev; float* cout; int T;
            if (r < NP) { b = r / TP; t = r % TP; prev = nullptr; cout = out + O_CP + (size_t)b * 2 * MIX; T = TP; }
            else { const int rs = r - NP; b = rs / TS; t = rs % TS; prev = st_conv + (size_t)b * 2 * MIX; cout = out + O_CS + (size_t)b * 2 * MIX; T = TS; }
            const int c0 = lane * 8;
            float p[3][8];
#pragma unroll
            for (int k = 0; k < 3; ++k) {
                const int tt = t - k;
                if (tt >= 0) { const bf16_t* zr = Z + (size_t)(r - k) * NZ; const u32x4 xi = *(const u32x4*)(zr + MIX + c0), cgv = *(const u32x4*)(zr + 3 * MIX + c0);
                    p[k][0] = bf_lo(xi.x) * bf_lo(cgv.x); p[k][1] = bf_hi(xi.x) * bf_hi(cgv.x); p[k][2] = bf_lo(xi.y) * bf_lo(cgv.y); p[k][3] = bf_hi(xi.y) * bf_hi(cgv.y);
                    p[k][4] = bf_lo(xi.z) * bf_lo(cgv.z); p[k][5] = bf_hi(xi.z) * bf_hi(cgv.z); p[k][6] = bf_lo(xi.w) * bf_lo(cgv.w); p[k][7] = bf_hi(xi.w) * bf_hi(cgv.w); }
                else if (prev) { const float* pp = prev + (size_t)(2 + tt) * MIX + c0; const f32x4 a = *(const f32x4*)pp, bq = *(const f32x4*)(pp + 4);
                    p[k][0] = a[0]; p[k][1] = a[1]; p[k][2] = a[2]; p[k][3] = a[3]; p[k][4] = bq[0]; p[k][5] = bq[1]; p[k][6] = bq[2]; p[k][7] = bq[3]; }
                else {
#pragma unroll
                    for (int j = 0; j < 8; ++j) p[k][j] = 0.f; }
            }
            const u32x4 bgv = *(const u32x4*)(Z + (size_t)r * NZ + 2 * MIX + c0);
            float bg[8] = {bf_lo(bgv.x), bf_hi(bgv.x), bf_lo(bgv.y), bf_hi(bgv.y), bf_lo(bgv.z), bf_hi(bgv.z), bf_lo(bgv.w), bf_hi(bgv.w)};
            float y[8]; float ss = 0.f;
#pragma unroll
            for (int j = 0; j < 8; ++j) { const float w0 = conv_w[c0 + j], w1 = conv_w[MIX + c0 + j], w2 = conv_w[2 * MIX + c0 + j];
                y[j] = bg[j] * (w0 * p[2][j] + w1 * p[1][j] + w2 * p[0][j]); ss += y[j] * y[j]; }
            const float rstd = 1.0f / sqrtf(wave_sum(ss) * (1.0f / MIX) + EPS);
            const f32x4 g0 = *(const f32x4*)(norm_conv + c0), g1 = *(const f32x4*)(norm_conv + c0 + 4);
            u32x4 w; w.x = cvt_pk_bf16(y[0] * rstd * g0[0], y[1] * rstd * g0[1]); w.y = cvt_pk_bf16(y[2] * rstd * g0[2], y[3] * rstd * g0[3]);
            w.z = cvt_pk_bf16(y[4] * rstd * g1[0], y[5] * rstd * g1[1]); w.w = cvt_pk_bf16(y[6] * rstd * g1[2], y[7] * rstd * g1[3]);
            *(u32x4*)(MIXN + (size_t)r * D + MIX + c0) = w;
            if (t >= T - 2) { float* co = cout + (size_t)(t - (T - 2)) * MIX + c0; *(f32x4*)co = (f32x4){p[0][0], p[0][1], p[0][2], p[0][3]}; *(f32x4*)(co + 4) = (f32x4){p[0][4], p[0][5], p[0][6], p[0][7]}; }
        }
    }
    grid.sync();

    if (PH(3)) {
        for (int task = gw; task < BP * SG; task += NGW) {
            const int g = task % SG, b = task / SG;
            const f32x4 at = *(const f32x4*)(AT + (size_t)(g * SN + lane) * 4); const float aLr = at[2], aLi = at[3];
            float sr = 0.f, si = 0.f;
            for (int c = 0; c < NCH; ++c) {
                float* sip = SI + ((size_t)(b * SG + g) * NCH + c) * 128; sip[lane] = sr; sip[64 + lane] = si;
                const float* e = SE + ((size_t)(b * SG + g) * NCH + c) * 128; const float er = e[lane], ei = e[64 + lane];
                const float nr = aLr * sr - aLi * si + er, ni = aLr * si + aLi * sr + ei; sr = nr; si = ni;
            }
            out[O_SRP + (size_t)(b * SG + g) * SN + lane] = sr; out[O_SIP + (size_t)(b * SG + g) * SN + lane] = si;
        }
    }
    grid.sync();

    if (PH(4)) {
        const float* C_re = IN(16); const float* C_im = IN(17); const float* Dssm = IN(18);
        for (int task = gw; task < BP * SG * NCH; task += NGW) {
            const int c = task % NCH, g = (task / NCH) % SG, b = task / (NCH * SG);
            const float* sip = SI + ((size_t)(b * SG + g) * NCH + c) * 128; float sr = sip[lane], si = sip[64 + lane];
            ssm_tile<true>(Z + (size_t)(b * TP + c * LCH) * NZ + g * SP, LCH, sr, si, BB, AT, C_re, C_im, Dssm, g, YG + (size_t)(b * TP + c * LCH) * MIX, lane);
        }
    }
    grid.sync();

    if (PH(5)) {
        const float* b_glu = IN(20);
        Sched2 S{G, bx, MT / 256, MIX / 256, 0, 0, (const char*)YG, (const char*)WGLU, nullptr, nullptr, (size_t)256 * MIX * 2, (size_t)256 * MIX * 2};
        EpiGlu E{YG, b_glu, YS};
        pg8::gemm_phase(lds, MIX, MIX, MIX, S, E);
    }
    grid.sync();

    if (PH(6)) {
        const float* norm_ssm = IN(22);
        for (int r = gw; r < MT; r += NGW) {
            const f32x4* yr = (const f32x4*)(YS + (size_t)r * MIX) + lane; const f32x4 a = yr[0], b = yr[64];
            const float ss = (a[0] * a[0] + a[1] * a[1]) + (a[2] * a[2] + a[3] * a[3]) + (b[0] * b[0] + b[1] * b[1]) + (b[2] * b[2] + b[3] * b[3]);
            const float rstd = 1.0f / sqrtf(wave_sum(ss) * (1.0f / MIX) + EPS);
            const f32x4 ga = ((const f32x4*)norm_ssm)[lane], gb = ((const f32x4*)norm_ssm)[lane + 64];
            u32x2 w0, w1; w0.x = cvt_pk_bf16(a[0] * rstd * ga[0], a[1] * rstd * ga[1]); w0.y = cvt_pk_bf16(a[2] * rstd * ga[2], a[3] * rstd * ga[3]);
            w1.x = cvt_pk_bf16(b[0] * rstd * gb[0], b[1] * rstd * gb[1]); w1.y = cvt_pk_bf16(b[2] * rstd * gb[2], b[3] * rstd * gb[3]);
            u32x2* o8 = (u32x2*)(MIXN + (size_t)r * D) + lane; o8[0] = w0; o8[64] = w1;
        }
    }
    grid.sync();

    if (PH(7)) {
        const float* x_prompt = IN(0); const float* x_sample = IN(1);
        Sched2 S{G, bx, MT / 256, D / 256, 0, 0, (const char*)MIXN, (const char*)WOUT, nullptr, nullptr, (size_t)256 * D * 2, (size_t)256 * D * 2};
        EpiRes E{x_prompt, x_sample, X, 1};
        pg8::gemm_phase(lds, D, D, D, S, E);
    }
    grid.sync();

    if (PH(8)) for (int m = gw; m < MT; m += NGW) rms_row_bf16(X + (size_t)m * D, IN(25), H + (size_t)m * D, lane);
    grid.sync();

    if (PH(9)) {
        Sched2 S{G, bx, MT / 256, D / 256, 0, 0, (const char*)H, (const char*)WQ, nullptr, nullptr, (size_t)256 * D * 2, (size_t)256 * D * 2};
        EpiBf E{Q, D, 0.0625f};
        pg8::gemm_phase(lds, D, D, D, S, E);
    }
    grid.sync();

    if (PH(10)) {
        const float* cache_k = IN(3); const float* cache_v = IN(4);
        struct SchedQK { int G, c; const char* Q; const char* KB;
            __device__ __forceinline__ bool next(int i, Unit& u) const { const int L = i * G + c; if (L >= 64 * NH) return false; pg8::order_map(L, 64, NH, u.pm, u.pn); u.kind = 0;
                u.A = Q + ((size_t)u.pm * 256 * D + (size_t)u.pn * HD) * 2; u.B = KB + ((size_t)(u.pm >> 3) * NMEM * D + (size_t)u.pn * HD) * 2; return true; } };
        SchedQK S{G, bx, (const char*)Q, (const char*)KB};
        EpiSoftmax E{PR, lds};
#ifndef NO_QK
        pg8::gemm_phase(lds, HD, D, D, S, E);
#endif

#ifndef NO_SATT
        LAS float* sc = (LAS float*)lds;
        LAS float* pr = (LAS float*)(lds + 4096);
        LAS float* po = (LAS float*)(lds + 8192);
        for (int unit = bx; unit < BS * NH; unit += G) {
            const int b = unit / NH, h = unit % NH;
            float q[4][4];
#pragma unroll
            for (int qi = 0; qi < 4; ++qi) { const u32x2 w = *(const u32x2*)(Q + (size_t)(NP + b * TS + qi) * D + h * HD + 4 * lane); q[qi][0] = bf_lo(w.x); q[qi][1] = bf_hi(w.x); q[qi][2] = bf_lo(w.y); q[qi][3] = bf_hi(w.y); }
            const float* kbase = cache_k + ((size_t)(b * NMEM) * NH + h) * HD + 4 * lane;
            const float* vbase = cache_v + ((size_t)(b * NMEM) * NH + h) * HD + 4 * lane;
#pragma unroll 1
            for (int blk = 0; blk < 2; ++blk) {
                const int key0 = wave * 32 + blk * 16;
                float v[64];
#pragma unroll
                for (int k = 0; k < 16; ++k) { const f32x4 kv = *(const f32x4*)(kbase + (size_t)(key0 + k) * NH * HD);
#pragma unroll
                    for (int qi = 0; qi < 4; ++qi) v[k * 4 + qi] = (kv[0] * q[qi][0] + kv[1] * q[qi][1]) + (kv[2] * q[qi][2] + kv[3] * q[qi][3]); }
                const float s = treduce64(v, lane);
                sc[(lane & 3) * 256 + key0 + (lane >> 2)] = s;
            }
            __syncthreads();
            {
                const int qi = lane & 3, kb = lane >> 2; float sv[16]; float mx = -3.0e38f;
#pragma unroll
                for (int j = 0; j < 16; ++j) { sv[j] = sc[qi * 256 + kb + 16 * j]; mx = fmaxf(mx, sv[j]); }
                mx = fmaxf(mx, __shfl_xor(mx, 4)); mx = fmaxf(mx, __shfl_xor(mx, 8)); mx = fmaxf(mx, __shfl_xor(mx, 16)); mx = fmaxf(mx, __shfl_xor(mx, 32));
                float sum = 0.f;
#pragma unroll
                for (int j = 0; j < 16; ++j) { sv[j] = fast_exp(sv[j] - mx); sum += sv[j]; }
                sum += __shfl_xor(sum, 4); sum += __shfl_xor(sum, 8); sum += __shfl_xor(sum, 16); sum += __shfl_xor(sum, 32);
                const float inv = 1.0f / sum;
                if (wave == 0) {
#pragma unroll
                    for (int j = 0; j < 16; ++j) pr[qi * 256 + kb + 16 * j] = sv[j] * inv; }
            }
            __syncthreads();
            {
                float o[4][4];
#pragma unroll
                for (int qi = 0; qi < 4; ++qi) { o[qi][0] = 0.f; o[qi][1] = 0.f; o[qi][2] = 0.f; o[qi][3] = 0.f; }
#pragma unroll 8
                for (int k = 0; k < 32; ++k) { const int key = wave * 32 + k; const f32x4 vv = *(const f32x4*)(vbase + (size_t)key * NH * HD);
#pragma unroll
                    for (int qi = 0; qi < 4; ++qi) { const float pp = pr[qi * 256 + key]; o[qi][0] = fmaf(pp, vv[0], o[qi][0]); o[qi][1] = fmaf(pp, vv[1], o[qi][1]); o[qi][2] = fmaf(pp, vv[2], o[qi][2]); o[qi][3] = fmaf(pp, vv[3], o[qi][3]); } }
#pragma unroll
                for (int qi = 0; qi < 4; ++qi) *(LAS f32x4*)(po + (wave * 4 + qi) * 256 + 4 * lane) = (f32x4){o[qi][0], o[qi][1], o[qi][2], o[qi][3]};
            }
            __syncthreads();
            {
                const int idx = tid * 2, qi = idx >> 8, d = idx & 255; float a0 = 0.f, a1 = 0.f;
#pragma unroll
                for (int w = 0; w < 8; ++w) { const f32x2 t2 = *(LAS f32x2*)(po + (w * 4 + qi) * 256 + d); a0 += t2[0]; a1 += t2[1]; }
                *(unsigned*)(O + (size_t)(NP + b * TS + qi) * D + h * HD + d) = cvt_pk_bf16(a0, a1);
            }
        }
#endif
    }
    grid.sync();

    if (PH(11)) {
        struct SchedPV { int G, c; const char* PR; const char* VT;
            __device__ __forceinline__ bool next(int i, Unit& u) const { const int L = i * G + c; if (L >= 64 * NH) return false; pg8::order_map(L, 64, NH, u.pm, u.pn); u.kind = 0;
                u.A = PR + (size_t)(u.pm * NH + u.pn) * 256 * 256 * 2; u.B = VT + (size_t)((u.pm >> 3) * NH + u.pn) * HD * NMEM * 2; return true; } };
        SchedPV S{G, bx, (const char*)PR, (const char*)VT};
        EpiBf E{O, D, 1.0f};
        pg8::gemm_phase(lds, NMEM, NMEM, NMEM, S, E);
    }
    grid.sync();

    if (PH(12)) {
        const float* x_prompt = nullptr; const float* x_sample = nullptr;
        Sched2 S{G, bx, MT / 256, D / 256, 0, 0, (const char*)O, (const char*)WXO, nullptr, nullptr, (size_t)256 * D * 2, (size_t)256 * D * 2};
        EpiRes E{x_prompt, x_sample, X, 0};
        pg8::gemm_phase(lds, D, D, D, S, E);
    }
    grid.sync();

    if (PH(13)) for (int m = gw; m < MT; m += NGW) rms_row_bf16(X + (size_t)m * D, IN(31), H + (size_t)m * D, lane);
    grid.sync();

    if (PH(14)) {
        Sched2 S{G, bx, MT / 256, NUG / 256, 0, 0, (const char*)H, (const char*)WUG, nullptr, nullptr, (size_t)256 * D * 2, (size_t)256 * D * 2};
        EpiBf E{UG, NUG, 1.0f};
        pg8::gemm_phase(lds, D, D, D, S, E);
    }
    grid.sync();

    if (PH(15)) {
        const float* st_ffn = IN(8); const float* ffn_conv_w = IN(34);
        constexpr int NV = DFF / 8;
        const size_t total = (size_t)MT * NV;
        for (size_t idx = (size_t)bx * NTHREADS + tid; idx < total; idx += (size_t)G * NTHREADS) {
            const int r = (int)(idx / NV), c0 = (int)(idx % NV) * 8;
            int b, t, T; const float* prev; float* fout;
            if (r < NP) { b = r / TP; t = r % TP; prev = nullptr; fout = out + O_FP + (size_t)b * 2 * DFF; T = TP; }
            else { const int rs = r - NP; b = rs / TS; t = rs % TS; prev = st_ffn + (size_t)b * 2 * DFF; fout = out + O_FS + (size_t)b * 2 * DFF; T = TS; }
            float p[3][8];
#pragma unroll
            for (int k = 0; k < 3; ++k) {
                const int tt = t - k;
                if (tt >= 0) { const u32x4 uw = *(const u32x4*)(UG + (size_t)(r - k) * NUG + c0);
                    p[k][0] = bf_lo(uw.x); p[k][1] = bf_hi(uw.x); p[k][2] = bf_lo(uw.y); p[k][3] = bf_hi(uw.y); p[k][4] = bf_lo(uw.z); p[k][5] = bf_hi(uw.z); p[k][6] = bf_lo(uw.w); p[k][7] = bf_hi(uw.w); }
                else if (prev) { const float* pp = prev + (size_t)(2 + tt) * DFF + c0; const f32x4 a = *(const f32x4*)pp, bq = *(const f32x4*)(pp + 4);
                    p[k][0] = a[0]; p[k][1] = a[1]; p[k][2] = a[2]; p[k][3] = a[3]; p[k][4] = bq[0]; p[k][5] = bq[1]; p[k][6] = bq[2]; p[k][7] = bq[3]; }
                else {
#pragma unroll
                    for (int j = 0; j < 8; ++j) p[k][j] = 0.f; }
            }
            const u32x4 gw4 = *(const u32x4*)(UG + (size_t)r * NUG + DFF + c0);
            const float gt8[8] = {bf_lo(gw4.x), bf_hi(gw4.x), bf_lo(gw4.y), bf_hi(gw4.y), bf_lo(gw4.z), bf_hi(gw4.z), bf_lo(gw4.w), bf_hi(gw4.w)};
            float a8[8];
#pragma unroll
            for (int j = 0; j < 8; ++j) { const float w0 = ffn_conv_w[c0 + j], w1 = ffn_conv_w[DFF + c0 + j], w2 = ffn_conv_w[2 * DFF + c0 + j];
                a8[j] = gelu_tanh(w0 * p[2][j] + w1 * p[1][j] + w2 * p[0][j]) * gt8[j]; }
            u32x4 w; w.x = cvt_pk_bf16(a8[0], a8[1]); w.y = cvt_pk_bf16(a8[2], a8[3]); w.z = cvt_pk_bf16(a8[4], a8[5]); w.w = cvt_pk_bf16(a8[6], a8[7]);
            *(u32x4*)(ACT + (size_t)r * DFF + c0) = w;
            if (t >= T - 2) { float* fo = fout + (size_t)(t - (T - 2)) * DFF + c0; *(f32x4*)fo = (f32x4){p[0][0], p[0][1], p[0][2], p[0][3]}; *(f32x4*)(fo + 4) = (f32x4){p[0][4], p[0][5], p[0][6], p[0][7]}; }
        }
    }
    grid.sync();

    if (PH(16)) {
        const float* x_prompt = nullptr; const float* x_sample = nullptr;
        Sched2 S{G, bx, MT / 256, D / 256, 0, 0, (const char*)ACT, (const char*)WDN, nullptr, nullptr, (size_t)256 * DFF * 2, (size_t)256 * DFF * 2};
        EpiRes E{x_prompt, x_sample, X, 0};
        pg8::gemm_phase(lds, DFF, DFF, DFF, S, E);
    }
    grid.sync();

    if (PH(17)) for (int m = gw; m < MT; m += NGW) rms_row_f32(X + (size_t)m * D, IN(36), out + (size_t)m * D, lane);
}

extern "C" void kernel_launch(void* const* d_in, const int* in_sizes, int n_in, void* d_out, int out_size, void* d_ws, size_t ws_size, hipStream_t stream) {
    static int grid = 0;
    if (grid == 0) {
        if (n_in != 37 || (size_t)out_size != O_END || ws_size < WS_END) { fprintf(stderr, "kernel_launch: unexpected sizes n_in %d out %d ws %zu\n", n_in, out_size, ws_size); grid = -1; return; }
        int dev = 0, cus = 0, per_cu = 0;
        (void)hipGetDevice(&dev); (void)hipDeviceGetAttribute(&cus, hipDeviceAttributeMultiprocessorCount, dev);
        (void)hipFuncSetAttribute((const void*)hymba_fwd, hipFuncAttributeMaxDynamicSharedMemorySize, LDS_BYTES);
        (void)hipOccupancyMaxActiveBlocksPerMultiprocessor(&per_cu, (const void*)hymba_fwd, NTHREADS, LDS_BYTES);
        if (per_cu < 1) { fprintf(stderr, "kernel_launch: occupancy query reports %d blocks per CU\n", per_cu); per_cu = 1; }
        (void)hipGetLastError();
        grid = cus;
        if (grid % 8) grid -= grid % 8;
    }
    if (grid < 0) return;
    Args a{};
    for (int i = 0; i < 37; ++i) a.in[i] = (const float*)d_in[i];
    a.out = (float*)d_out; a.ws = (unsigned char*)d_ws;
    void* kargs[] = {&a};
    hipError_t e = hipLaunchCooperativeKernel((const void*)hymba_fwd, dim3(grid), dim3(NTHREADS), kargs, LDS_BYTES, stream);
    if (e != hipSuccess) fprintf(stderr, "cooperative launch failed: %s (grid %d)\n", hipGetErrorString(e), grid);
}
```

```cpp
#include <hip/hip_runtime.h>
#include <hip/hip_cooperative_groups.h>
#include <cstdio>
#include <cstdint>
namespace cg = cooperative_groups;

#define LAS __attribute__((address_space(3)))
typedef unsigned short bf16_t;
typedef short bf16x8 __attribute__((ext_vector_type(8)));
typedef float f32x4 __attribute__((ext_vector_type(4)));
typedef float f32x2 __attribute__((ext_vector_type(2)));
typedef unsigned u32x4 __attribute__((ext_vector_type(4)));
typedef unsigned u32x2 __attribute__((ext_vector_type(2)));

constexpr int D = 1024, NP = 16384, NS = 512, MT = NP + NS;
constexpr int TP = 2048, TS = 4, BP = 8, BS = 128;
constexpr int NZ = 2048, MIX = 512, DFF = 2816, NUG = 2 * DFF;
constexpr int SG = 32, SP = 16, SN = 64, LCH = 64, NCH = TP / LCH;
constexpr int NMEM = 256, NH = 4, HD = 256;
constexpr float EPS = 1e-6f;
constexpr int NWAVES = 8, NTHREADS = 512;

constexpr size_t MiB = 1u << 20;
constexpr size_t WS_WIN = 0;
constexpr size_t WS_WKV = WS_WIN + 4 * MiB;
constexpr size_t WS_WGLU = WS_WKV + 4 * MiB;
constexpr size_t WS_WOUT = WS_WGLU + 1 * MiB;
constexpr size_t WS_WQ = WS_WOUT + 2 * MiB;
constexpr size_t WS_WXO = WS_WQ + 2 * MiB;
constexpr size_t WS_WUG = WS_WXO + 2 * MiB;
constexpr size_t WS_WDN = WS_WUG + 11 * MiB;
constexpr size_t WS_H = WS_WDN + 6 * MiB;
constexpr size_t WS_X = WS_H + 33 * MiB;
constexpr size_t WS_OV = WS_X + 66 * MiB;
constexpr size_t WS_Z = WS_OV;
constexpr size_t WS_YG = WS_Z + 66 * MiB;
constexpr size_t WS_YS = WS_YG + 17 * MiB;
constexpr size_t WS_MIXN = WS_YS + 33 * MiB;
constexpr size_t WS_Q = WS_MIXN + 33 * MiB;
constexpr size_t WS_PR = WS_Q + 33 * MiB;
constexpr size_t WS_O = WS_PR + 32 * MiB;
constexpr size_t WS_MN = WS_O + 33 * MiB;
constexpr size_t WS_KB = WS_MN + 4 * MiB;
constexpr size_t WS_VT = WS_KB + 4 * MiB;
constexpr size_t WS_SE = WS_VT + 4 * MiB;
constexpr size_t WS_SI = WS_SE + 4 * MiB;
constexpr size_t WS_BB = WS_SI + 4 * MiB;
constexpr size_t WS_AT = WS_BB + 1 * MiB;
constexpr size_t WS_OV_END1 = WS_AT + 1 * MiB;
constexpr size_t WS_UG = WS_OV;
constexpr size_t WS_ACT = WS_UG + 182 * MiB;
constexpr size_t WS_CTL = WS_ACT + 91 * MiB;
constexpr size_t WS_END = WS_CTL + 1 * MiB;
static_assert(WS_OV_END1 <= WS_END, "overlay");
static_assert(WS_END <= 512 * MiB, "workspace");

constexpr size_t O_YP = 0;
constexpr size_t O_YS = O_YP + (size_t)NP * D;
constexpr size_t O_MK = O_YS + (size_t)NS * D;
constexpr size_t O_MV = O_MK + (size_t)BP * NMEM * D;
constexpr size_t O_SRP = O_MV + (size_t)BP * NMEM * D;
constexpr size_t O_SIP = O_SRP + (size_t)BP * SG * SN;
constexpr size_t O_CP = O_SIP + (size_t)BP * SG * SN;
constexpr size_t O_FP = O_CP + (size_t)BP * 2 * MIX;
constexpr size_t O_SRS = O_FP + (size_t)BP * 2 * DFF;
constexpr size_t O_SIS = O_SRS + (size_t)BS * SG * SN;
constexpr size_t O_CS = O_SIS + (size_t)BS * SG * SN;
constexpr size_t O_FS = O_CS + (size_t)BS * 2 * MIX;
constexpr size_t O_END = O_FS + (size_t)BS * 2 * DFF;

constexpr int RING_BYTES = 131072, XCH_OFF = RING_BYTES, LDS_BYTES = 147456;

__device__ __forceinline__ unsigned cvt_pk_bf16(float lo, float hi) { unsigned r; asm volatile("v_cvt_pk_bf16_f32 %0, %1, %2" : "=v"(r) : "v"(lo), "v"(hi)); return r; }
__device__ __forceinline__ float bf_lo(unsigned w) { return __uint_as_float(w << 16); }
__device__ __forceinline__ float bf_hi(unsigned w) { return __uint_as_float(w & 0xffff0000u); }
__device__ __forceinline__ float wave_sum(float v) {
#pragma unroll
    for (int o = 1; o < 64; o <<= 1) v += __shfl_xor(v, o);
    return v;
}
__device__ __forceinline__ float fast_exp(float x) { return __builtin_amdgcn_exp2f(x * 1.4426950408889634f); }
__device__ __forceinline__ float gelu_tanh(float x) {
    const float z = 0.7978845608028654f * (x + 0.044715f * x * x * x);
    return x * __builtin_amdgcn_rcpf(1.0f + fast_exp(-2.0f * z));
}
__device__ __forceinline__ float sigmoidf(float a) { return __builtin_amdgcn_rcpf(1.0f + fast_exp(-a)); }

namespace pg8 {
constexpr int BM = 256, BK = 64, HALF = 128, HTB = HALF * BK * 2;
__host__ __device__ __forceinline__ int lds_byte(int r, int c) { const int st = (r >> 4) * 2 + (c >> 5), rr = r & 15, cc = c & 31, ob = rr * 64 + cc * 2; return st * 1024 + (ob ^ (((ob >> 9) & 1) << 5)); }
__host__ __device__ __forceinline__ void stage_rc(int b, int& R, int& C) { const int st = b / 1024, sb = b % 1024, swz = sb ^ (((sb >> 9) & 1) << 5); R = (st >> 1) * 16 + swz / 64; C = (st & 1) * 32 + (swz % 64) / 2; }
__host__ __device__ __forceinline__ int perm32(int rho) { const int n = rho >> 4, i = rho & 15; return 8 * (i >> 2) + 4 * n + (i & 3); }

struct Unit { int pm, pn, kind; const char* A; const char* B; };

__device__ __forceinline__ void order_map(int L, int nM, int nN, int& pm, int& pn) {
    const int nwg = nM * nN; int wgid = L;
    { const int q = nwg / 8, r = nwg % 8, xcd = wgid % 8, off = wgid / 8; wgid = (xcd < r ? xcd * (q + 1) : r * (q + 1) + (xcd - r) * q) + off; }
    const int nig = 8 * nN, gid = wgid / nig, fm = gid * 8, gsz = (nM - fm) < 8 ? (nM - fm) : 8;
    pm = fm + ((wgid % nig) % gsz); pn = (wgid % nig) / gsz;
}

template <class Epi, class Sched>
__device__ __forceinline__ void gemm_phase(LAS unsigned char* lds, const int K, const int lda, const int ldb, const Sched& S, Epi& E) {
    int tid_l = threadIdx.x; asm volatile("" : "+v"(tid_l));
    const int tid = tid_l, wid = __builtin_amdgcn_readfirstlane(tid >> 6), lane = tid & 63, wr = wid >> 2, wc = wid & 3, fr = lane & 15, fq = lane >> 4;
    const int nt = K / BK;
    unsigned voffA[2], voffB[2];
#pragma unroll
    for (int i = 0; i < 2; ++i) { int R, C; stage_rc(tid * 16 + i * 8192, R, C); const int Rb = (R & ~31) + perm32(R & 31);
        voffA[i] = (unsigned)(R * lda + C) * 2u; voffB[i] = (unsigned)(Rb * ldb + C) * 2u; }
    const size_t kstep = (size_t)(BK * 2);
    const size_t hstepA = (size_t)HALF * lda * 2, hstepB = (size_t)HALF * ldb * 2;
    const unsigned ldsw = (unsigned)wid * 1024u;
    const int aoff = lds_byte(wr * 64 + fr, fq * 8), boff = lds_byte(wc * 32 + fr, fq * 8);
#define PG8_SA(b, h) (((b) * 2 + (h)) * HTB)
#define PG8_SB(b, h) ((4 + (b) * 2 + (h)) * HTB)
#define PG8_STAGE(bufoff, gbase, voff) do { _Pragma("unroll") for (int _i = 0; _i < 2; ++_i) \
        __builtin_amdgcn_global_load_lds((const unsigned*)((const char*)(gbase) + (voff)[_i]), (LAS unsigned*)(lds + (bufoff) + ldsw + _i * 8192), 16, 0, 0); } while (0)
#define PG8_LDA(dst, b, h) do { _Pragma("unroll") for (int m = 0; m < 4; ++m) _Pragma("unroll") for (int k = 0; k < 2; ++k) dst[m][k] = *(const LAS bf16x8*)(lds + PG8_SA(b, h) + aoff + m * 2048 + k * 1024); } while (0)
#define PG8_LDB(dst, b, h) do { _Pragma("unroll") for (int n = 0; n < 2; ++n) _Pragma("unroll") for (int k = 0; k < 2; ++k) dst[n][k] = *(const LAS bf16x8*)(lds + PG8_SB(b, h) + boff + n * 2048 + k * 1024); } while (0)
#define PG8_MMA(ai, bj, At, Bt) do { __builtin_amdgcn_s_setprio(1); _Pragma("unroll") for (int m = 0; m < 4; ++m) _Pragma("unroll") for (int n = 0; n < 2; ++n) _Pragma("unroll") for (int k = 0; k < 2; ++k) \
        acc[ai][bj][m][n] = __builtin_amdgcn_mfma_f32_16x16x32_bf16(Bt[n][k], At[m][k], acc[ai][bj][m][n], 0, 0, 0); __builtin_amdgcn_s_setprio(0); } while (0)
#define PG8_WAIT_V(n) asm volatile("s_waitcnt vmcnt(" #n ")" ::: "memory")
#define PG8_WAIT_L(n) asm volatile("s_waitcnt lgkmcnt(" #n ")" ::: "memory")
#define PG8_BAR __builtin_amdgcn_s_barrier()
#define PG8_SCHED __builtin_amdgcn_sched_barrier(0)
    Unit cur, nxt; int ui = 0;
    if (!S.next(0, cur)) return;
    f32x4 acc[2][2][4][2];
#pragma unroll
    for (int a = 0; a < 2; ++a)
#pragma unroll
        for (int b = 0; b < 2; ++b)
#pragma unroll
            for (int m = 0; m < 4; ++m)
#pragma unroll
                for (int n = 0; n < 2; ++n) acc[a][b][m][n] = (f32x4){0.f, 0.f, 0.f, 0.f};
    bf16x8 At[4][2], B0[2][2], B1[2][2];
    const char* cA = cur.A; const char* cB = cur.B;
    PG8_STAGE(PG8_SB(0, 0), cB, voffB); PG8_STAGE(PG8_SB(0, 1), cB + hstepB, voffB); PG8_STAGE(PG8_SA(0, 0), cA, voffA); PG8_STAGE(PG8_SA(0, 1), cA + hstepA, voffA);
    if (wr == 1) PG8_BAR;
    PG8_WAIT_V(2); PG8_BAR;
    PG8_STAGE(PG8_SB(1, 0), cB + kstep, voffB); PG8_STAGE(PG8_SA(1, 0), cA + kstep, voffA); PG8_STAGE(PG8_SB(1, 1), cB + hstepB + kstep, voffB);
    PG8_WAIT_V(6); PG8_BAR;
    for (;;) {
        const bool has_next = S.next(ui + 1, nxt);
        const char* nA = has_next ? nxt.A : cA; const char* nB = has_next ? nxt.B : cB;
#pragma unroll 1
        for (int t = 0; t < nt; t += 2) {
            const bool last = (t == nt - 2);
            const char* a1 = cA + (size_t)(t + 1) * kstep;
            const char* a2 = last ? nA : cA + (size_t)(t + 2) * kstep; const char* b2 = last ? nB : cB + (size_t)(t + 2) * kstep;
            const char* a3 = a2 + kstep; const char* b3 = b2 + kstep;
            PG8_LDB(B0, 0, 0); PG8_LDB(B1, 0, 1); PG8_SCHED; PG8_LDA(At, 0, 0); PG8_STAGE(PG8_SA(1, 1), a1 + hstepA, voffA);
            PG8_WAIT_V(8); PG8_WAIT_L(0); PG8_BAR; PG8_MMA(0, 0, At, B0); PG8_MMA(0, 1, At, B1); PG8_BAR; PG8_SCHED;
            PG8_LDA(At, 0, 1); PG8_STAGE(PG8_SB(0, 0), b2, voffB); PG8_STAGE(PG8_SB(0, 1), b2 + hstepB, voffB); PG8_STAGE(PG8_SA(0, 0), a2, voffA);
            PG8_WAIT_V(8); PG8_WAIT_L(0); PG8_BAR; PG8_MMA(1, 0, At, B0); PG8_MMA(1, 1, At, B1); PG8_BAR; PG8_SCHED;
            PG8_LDB(B0, 1, 0); PG8_LDB(B1, 1, 1); PG8_SCHED; PG8_LDA(At, 1, 0); PG8_STAGE(PG8_SA(0, 1), a2 + hstepA, voffA);
            PG8_WAIT_V(8); PG8_WAIT_L(0); PG8_BAR; PG8_MMA(0, 0, At, B0); PG8_MMA(0, 1, At, B1); PG8_BAR; PG8_SCHED;
            PG8_LDA(At, 1, 1); PG8_STAGE(PG8_SB(1, 0), b3, voffB); PG8_STAGE(PG8_SB(1, 1), b3 + hstepB, voffB); PG8_STAGE(PG8_SA(1, 0), a3, voffA);
            PG8_WAIT_V(8); PG8_WAIT_L(0); PG8_BAR; PG8_MMA(1, 0, At, B0); PG8_MMA(1, 1, At, B1); PG8_BAR; PG8_SCHED;
        }
        if (wr == 0) PG8_BAR;
        E(acc, cur, wr, wc, fr, fq);
        if (!has_next) break;
#pragma unroll
        for (int a = 0; a < 2; ++a)
#pragma unroll
            for (int b = 0; b < 2; ++b)
#pragma unroll
                for (int m = 0; m < 4; ++m)
#pragma unroll
                    for (int n = 0; n < 2; ++n) acc[a][b][m][n] = (f32x4){0.f, 0.f, 0.f, 0.f};
        cur = nxt; cA = nA; cB = nB; ++ui;
        if (wr == 1) PG8_BAR;
    }
    PG8_WAIT_V(0);
    PG8_BAR;
#undef PG8_SA
#undef PG8_SB
#undef PG8_STAGE
#undef PG8_LDA
#undef PG8_LDB
#undef PG8_MMA
#undef PG8_WAIT_V
#undef PG8_WAIT_L
#undef PG8_BAR
#undef PG8_SCHED
}
}
using pg8::Unit;
typedef f32x4 Acc[2][2][4][2];

struct Sched2 {
    int G, c; int nM0, nN0, nM1, nN1;
    const char* A0; const char* B0; const char* A1; const char* B1; size_t a_pm, b_pn;
    __device__ __forceinline__ bool next(int i, Unit& u) const {
        const int L = i * G + c, n0 = nM0 * nN0, n1 = nM1 * nN1;
        if (L >= n0 + n1) return false;
        if (L < n0) { pg8::order_map(L, nM0, nN0, u.pm, u.pn); u.kind = 0; u.A = A0 + (size_t)u.pm * a_pm; u.B = B0 + (size_t)u.pn * b_pn; }
        else { pg8::order_map(L - n0, nM1, nN1, u.pm, u.pn); u.kind = 1; u.A = A1 + (size_t)u.pm * a_pm; u.B = B1 + (size_t)u.pn * b_pn; }
        return true;
    }
};

#define EPI_ROWS(...) _Pragma("unroll") for (int ai = 0; ai < 2; ++ai) _Pragma("unroll") for (int m = 0; m < 4; ++m) { const int row = u.pm * 256 + ai * 128 + wr * 64 + m * 16 + fr; \
    _Pragma("unroll") for (int bj = 0; bj < 2; ++bj) { const int col = u.pn * 256 + bj * 128 + wc * 32 + fq * 8; const f32x4 v0 = acc[ai][bj][m][0], v1 = acc[ai][bj][m][1]; __VA_ARGS__ } }

__device__ __forceinline__ u32x4 pack8(f32x4 v0, f32x4 v1) { u32x4 w; w.x = cvt_pk_bf16(v0[0], v0[1]); w.y = cvt_pk_bf16(v0[2], v0[3]); w.z = cvt_pk_bf16(v1[0], v1[1]); w.w = cvt_pk_bf16(v1[2], v1[3]); return w; }

struct EpiP1 {
    bf16_t* Z; float* outK; float* outV; bf16_t* KB; bf16_t* VT;
    __device__ __forceinline__ void operator()(Acc& acc, const Unit& u, int wr, int wc, int fr, int fq) const {
        if (u.kind == 0) {
            EPI_ROWS( *(u32x4*)(Z + (size_t)row * NZ + col) = pack8(v0, v1); )
        } else if (u.pn < 4) {
            EPI_ROWS( float* o = outK + (size_t)row * D + col; *(f32x4*)o = v0; *(f32x4*)(o + 4) = v1; *(u32x4*)(KB + (size_t)row * D + col) = pack8(v0, v1); )
        } else {
            EPI_ROWS( const int vc = col - 1024; float* o = outV + (size_t)row * D + vc; *(f32x4*)o = v0; *(f32x4*)(o + 4) = v1;
                      const int h = vc >> 8, d0 = vc & 255, key = row & 255; bf16_t* vt = VT + ((size_t)(u.pm * NH + h) * HD + d0) * NMEM + key;
                      const u32x4 w = pack8(v0, v1);
                      vt[0 * NMEM] = (bf16_t)(w.x & 0xffff); vt[1 * NMEM] = (bf16_t)(w.x >> 16); vt[2 * NMEM] = (bf16_t)(w.y & 0xffff); vt[3 * NMEM] = (bf16_t)(w.y >> 16);
                      vt[4 * NMEM] = (bf16_t)(w.z & 0xffff); vt[5 * NMEM] = (bf16_t)(w.z >> 16); vt[6 * NMEM] = (bf16_t)(w.w & 0xffff); vt[7 * NMEM] = (bf16_t)(w.w >> 16); )
        }
    }
};
struct EpiGlu {
    const bf16_t* YG; const float* bias; float* YS;
    __device__ __forceinline__ void operator()(Acc& acc, const Unit& u, int wr, int wc, int fr, int fq) const {
        EPI_ROWS( const u32x4 yw = *(const u32x4*)(YG + (size_t)row * MIX + col); const f32x4 b0 = *(const f32x4*)(bias + col), b1 = *(const f32x4*)(bias + col + 4);
                  f32x4 o0, o1;
                  o0[0] = bf_lo(yw.x) * sigmoidf(v0[0] + b0[0]); o0[1] = bf_hi(yw.x) * sigmoidf(v0[1] + b0[1]); o0[2] = bf_lo(yw.y) * sigmoidf(v0[2] + b0[2]); o0[3] = bf_hi(yw.y) * sigmoidf(v0[3] + b0[3]);
                  o1[0] = bf_lo(yw.z) * sigmoidf(v1[0] + b1[0]); o1[1] = bf_hi(yw.z) * sigmoidf(v1[1] + b1[1]); o1[2] = bf_lo(yw.w) * sigmoidf(v1[2] + b1[2]); o1[3] = bf_hi(yw.w) * sigmoidf(v1[3] + b1[3]);
                  float* o = YS + (size_t)row * MIX + col; *(f32x4*)o = o0; *(f32x4*)(o + 4) = o1; )
    }
};
struct EpiRes {
    const float* xp; const float* xs; float* X; int first;
    __device__ __forceinline__ void operator()(Acc& acc, const Unit& u, int wr, int wc, int fr, int fq) const {
        EPI_ROWS( const float* b = first ? (row < NP ? xp + (size_t)row * D : xs + (size_t)(row - NP) * D) : (const float*)(X + (size_t)row * D);
                  const f32x4 r0 = *(const f32x4*)(b + col), r1 = *(const f32x4*)(b + col + 4);
                  float* o = X + (size_t)row * D + col; *(f32x4*)o = r0 + v0; *(f32x4*)(o + 4) = r1 + v1; )
    }
};
struct EpiBf {
    bf16_t* O; int ld; float scale;
    __device__ __forceinline__ void operator()(Acc& acc, const Unit& u, int wr, int wc, int fr, int fq) const {
        EPI_ROWS( *(u32x4*)(O + (size_t)row * ld + col) = pack8(v0 * scale, v1 * scale); )
    }
};
struct EpiSoftmax {
    bf16_t* PR; LAS unsigned char* lds;
    __device__ __forceinline__ void operator()(Acc& acc, const Unit& u, int wr, int wc, int fr, int fq) const {
        LAS f32x2* X = (LAS f32x2*)(lds + XCH_OFF);
#pragma unroll
        for (int ai = 0; ai < 2; ++ai)
#pragma unroll
            for (int m = 0; m < 4; ++m) {
                float mx = -3.0e38f;
#pragma unroll
                for (int bj = 0; bj < 2; ++bj)
#pragma unroll
                    for (int n = 0; n < 2; ++n) { const f32x4 x = acc[ai][bj][m][n]; mx = fmaxf(mx, fmaxf(fmaxf(x[0], x[1]), fmaxf(x[2], x[3]))); }
                mx = fmaxf(mx, __shfl_xor(mx, 16)); mx = fmaxf(mx, __shfl_xor(mx, 32));
                float s = 0.f;
#pragma unroll
                for (int bj = 0; bj < 2; ++bj)
#pragma unroll
                    for (int n = 0; n < 2; ++n) { f32x4 x = acc[ai][bj][m][n];
                        x[0] = fast_exp(x[0] - mx); x[1] = fast_exp(x[1] - mx); x[2] = fast_exp(x[2] - mx); x[3] = fast_exp(x[3] - mx);
                        s += (x[0] + x[1]) + (x[2] + x[3]); acc[ai][bj][m][n] = x; }
                s += __shfl_xor(s, 16); s += __shfl_xor(s, 32);
                if (fq == 0) X[(ai * 128 + wr * 64 + m * 16 + fr) * 4 + wc] = (f32x2){mx, s};
            }
        asm volatile("s_waitcnt lgkmcnt(0)" ::: "memory"); __builtin_amdgcn_s_barrier(); asm volatile("" ::: "memory");
#pragma unroll
        for (int ai = 0; ai < 2; ++ai)
#pragma unroll
            for (int m = 0; m < 4; ++m) {
                const int rl = ai * 128 + wr * 64 + m * 16 + fr;
                const f32x2 a = X[rl * 4 + 0], b = X[rl * 4 + 1], c = X[rl * 4 + 2], d = X[rl * 4 + 3];
                const float M = fmaxf(fmaxf(a.x, b.x), fmaxf(c.x, d.x));
                const float tot = a.y * fast_exp(a.x - M) + b.y * fast_exp(b.x - M) + c.y * fast_exp(c.x - M) + d.y * fast_exp(d.x - M);
                const float own = wc == 0 ? a.x : (wc == 1 ? b.x : (wc == 2 ? c.x : d.x));
                const float f = fast_exp(own - M) / tot;
                bf16_t* prow = PR + ((size_t)(u.pm * NH + u.pn) * 256 + rl) * 256;
#pragma unroll
                for (int bj = 0; bj < 2; ++bj) { const int col = bj * 128 + wc * 32 + fq * 8; *(u32x4*)(prow + col) = pack8(acc[ai][bj][m][0] * f, acc[ai][bj][m][1] * f); }
                asm volatile("" ::: "memory");
            }
    }
};

#ifndef ONLY
#define ONLY -1
#endif
#define PH(k) (ONLY < 0 || ONLY == (k))
#define GSYNC() xcd_barrier(xb)
struct Args { const float* in[37]; float* out; unsigned char* ws; };

__device__ __forceinline__ void transpose_item(const float* W, int K, int N, bf16_t* WT, int row_off, LAS float* scr, int item, int lane) {
    const int nblk = N / 32, kb = item / nblk, nb = item % nblk, k0 = 64 * kb, n0 = 32 * nb;
#pragma unroll 8
    for (int i = 0; i < 32; ++i) { const int kk = 2 * i + (lane >> 5); scr[kk * 33 + (lane & 31)] = W[(size_t)(k0 + kk) * N + n0 + (lane & 31)]; }
    asm volatile("s_waitcnt lgkmcnt(0)" ::: "memory");
    const int c = lane & 7;
#pragma unroll
    for (int j = 0; j < 4; ++j) { const int n = (lane >> 3) + 8 * j; const LAS float* s = scr + (8 * c) * 33 + n;
        u32x4 o; o.x = cvt_pk_bf16(s[0 * 33], s[1 * 33]); o.y = cvt_pk_bf16(s[2 * 33], s[3 * 33]); o.z = cvt_pk_bf16(s[4 * 33], s[5 * 33]); o.w = cvt_pk_bf16(s[6 * 33], s[7 * 33]);
        *(u32x4*)(WT + (size_t)(row_off + n0 + n) * K + k0 + 8 * c) = o; }
    asm volatile("s_waitcnt lgkmcnt(0)" ::: "memory");
}

__device__ __forceinline__ void rms_row_bf16(const float* xrow, const float* g, bf16_t* orow, int lane) {
    const f32x4* xr = (const f32x4*)xrow + lane; f32x4 v[4]; float s = 0.f;
#pragma unroll
    for (int j = 0; j < 4; ++j) { v[j] = xr[64 * j]; s += (v[j][0] * v[j][0] + v[j][1] * v[j][1]) + (v[j][2] * v[j][2] + v[j][3] * v[j][3]); }
    const float rstd = 1.0f / sqrtf(wave_sum(s) * (1.0f / D) + EPS);
    u32x2* o8 = (u32x2*)orow + lane;
#pragma unroll
    for (int j = 0; j < 4; ++j) { const f32x4 gg = ((const f32x4*)g)[lane + 64 * j]; u32x2 w; w.x = cvt_pk_bf16(v[j][0] * rstd * gg[0], v[j][1] * rstd * gg[1]); w.y = cvt_pk_bf16(v[j][2] * rstd * gg[2], v[j][3] * rstd * gg[3]); o8[64 * j] = w; }
}
__device__ __forceinline__ void rms_row_f32(const float* xrow, const float* g, float* orow, int lane) {
    const f32x4* xr = (const f32x4*)xrow + lane; f32x4 v[4]; float s = 0.f;
#pragma unroll
    for (int j = 0; j < 4; ++j) { v[j] = xr[64 * j]; s += (v[j][0] * v[j][0] + v[j][1] * v[j][1]) + (v[j][2] * v[j][2] + v[j][3] * v[j][3]); }
    const float rstd = 1.0f / sqrtf(wave_sum(s) * (1.0f / D) + EPS);
#pragma unroll
    for (int j = 0; j < 4; ++j) { const f32x4 gg = ((const f32x4*)g)[lane + 64 * j]; ((f32x4*)orow)[lane + 64 * j] = v[j] * rstd * gg; }
}

__device__ __forceinline__ float treduce16(float (&v)[16], int lane) {
    { const bool hi = lane & 32;
#pragma unroll
      for (int i = 0; i < 8; ++i) { const float send = hi ? v[i] : v[i + 8], keep = hi ? v[i + 8] : v[i]; v[i] = keep + __shfl_xor(send, 32); } }
    { const bool hi = lane & 16;
#pragma unroll
      for (int i = 0; i < 4; ++i) { const float send = hi ? v[i] : v[i + 4], keep = hi ? v[i + 4] : v[i]; v[i] = keep + __shfl_xor(send, 16); } }
    { const bool hi = lane & 8;
#pragma unroll
      for (int i = 0; i < 2; ++i) { const float send = hi ? v[i] : v[i + 2], keep = hi ? v[i + 2] : v[i]; v[i] = keep + __shfl_xor(send, 8); } }
    { const bool hi = lane & 4; const float send = hi ? v[0] : v[1], keep = hi ? v[1] : v[0]; v[0] = keep + __shfl_xor(send, 4); }
    v[0] += __shfl_xor(v[0], 2); v[0] += __shfl_xor(v[0], 1);
    return v[0];
}
template <int W> __device__ __forceinline__ void tr_step(float (&v)[64], int lane) {
    const bool hi = lane & W;
#pragma unroll
    for (int i = 0; i < W; ++i) { const float send = hi ? v[i] : v[i + W], keep = hi ? v[i + W] : v[i]; v[i] = keep + __shfl_xor(send, W); }
}
__device__ __forceinline__ float treduce64(float (&v)[64], int lane) {
    tr_step<32>(v, lane); tr_step<16>(v, lane); tr_step<8>(v, lane); tr_step<4>(v, lane); tr_step<2>(v, lane); tr_step<1>(v, lane);
    return v[0];
}

template <bool WITH_Y>
__device__ __forceinline__ void ssm_tile(const bf16_t* zu, int nsteps, float& sr, float& si, const float* BB, const float* AT, const float* Cre, const float* Cim, const float* Dv,
                                         int g, bf16_t* yg, int lane) {
    float Br[16], Bi[16];
    { const f32x4* bp = (const f32x4*)(BB + (size_t)(g * SN + lane) * 32);
#pragma unroll
      for (int j = 0; j < 4; ++j) { const f32x4 a = bp[j], b = bp[4 + j]; Br[4 * j] = a[0]; Br[4 * j + 1] = a[1]; Br[4 * j + 2] = a[2]; Br[4 * j + 3] = a[3]; Bi[4 * j] = b[0]; Bi[4 * j + 1] = b[1]; Bi[4 * j + 2] = b[2]; Bi[4 * j + 3] = b[3]; } }
    const f32x4 at = *(const f32x4*)(AT + (size_t)(g * SN + lane) * 4); const float ar = at[0], ai = at[1];
    float Cr[16], Ci[16], Dm[16];
    if (WITH_Y) {
#pragma unroll
        for (int p = 0; p < 16; ++p) { Cr[p] = Cre[(size_t)(g * SP + p) * SN + lane]; Ci[p] = Cim[(size_t)(g * SP + p) * SN + lane]; Dm[p] = (lane == 0) ? Dv[g * SP + p] : 0.f; }
    }
    u32x4 u0 = (u32x4){0, 0, 0, 0}, u1 = (u32x4){0, 0, 0, 0};
    if (lane < nsteps) { const u32x4* up = (const u32x4*)(zu + (size_t)lane * NZ); u0 = up[0]; u1 = up[1]; }
    const int p_own = ((lane >> 5) & 1) * 8 + ((lane >> 4) & 1) * 4 + ((lane >> 3) & 1) * 2 + ((lane >> 2) & 1);
    for (int t = 0; t < nsteps; ++t) {
        float uu[16];
        { unsigned w;
          w = __builtin_amdgcn_readlane(u0.x, t); uu[0] = bf_lo(w); uu[1] = bf_hi(w);
          w = __builtin_amdgcn_readlane(u0.y, t); uu[2] = bf_lo(w); uu[3] = bf_hi(w);
          w = __builtin_amdgcn_readlane(u0.z, t); uu[4] = bf_lo(w); uu[5] = bf_hi(w);
          w = __builtin_amdgcn_readlane(u0.w, t); uu[6] = bf_lo(w); uu[7] = bf_hi(w);
          w = __builtin_amdgcn_readlane(u1.x, t); uu[8] = bf_lo(w); uu[9] = bf_hi(w);
          w = __builtin_amdgcn_readlane(u1.y, t); uu[10] = bf_lo(w); uu[11] = bf_hi(w);
          w = __builtin_amdgcn_readlane(u1.z, t); uu[12] = bf_lo(w); uu[13] = bf_hi(w);
          w = __builtin_amdgcn_readlane(u1.w, t); uu[14] = bf_lo(w); uu[15] = bf_hi(w); }
        float br = 0.f, bi = 0.f;
#pragma unroll
        for (int p = 0; p < 16; ++p) { br = fmaf(Br[p], uu[p], br); bi = fmaf(Bi[p], uu[p], bi); }
        const float nr = ar * sr - ai * si + br, ni = ar * si + ai * sr + bi;
        sr = nr; si = ni;
        if (WITH_Y) {
            float v[16];
#pragma unroll
            for (int p = 0; p < 16; ++p) v[p] = fmaf(Dm[p], uu[p], Cr[p] * sr - Ci[p] * si);
            const float y = treduce16(v, lane);
            const float gy = gelu_tanh(y);
            if ((lane & 3) == 0) yg[(size_t)t * MIX + g * SP + p_own] = (bf16_t)(cvt_pk_bf16(gy, 0.f) & 0xffff);
        }
    }
}


#define XB_TMO      128
#define XB_XCNT(j)  (256  + 64 * (j))
#define XB_XSUB(j)  (1280 + 64 * (j))
#define XB_XGEN(j)  (2304 + 64 * (j))
#define XB_TOP      3328
#define XB_TOPGEN   3392
#define XCD_BAR_WORDS 3456
#define XB_SPIN_CAP (1u << 18)
__device__ __forceinline__ unsigned xb_ld(unsigned* p)              { return __hip_atomic_load(p, __ATOMIC_RELAXED, __HIP_MEMORY_SCOPE_AGENT); }
__device__ __forceinline__ unsigned xb_add(unsigned* p, unsigned v) { return __hip_atomic_fetch_add(p, v, __ATOMIC_RELAXED, __HIP_MEMORY_SCOPE_AGENT); }
__device__ __forceinline__ unsigned xb_xcc_id() { return (unsigned)__builtin_amdgcn_s_getreg((3 << 11) | 20) & 0xFu; }
#define XB_SPIN(cond, bar) do { unsigned _sp = 0; while (cond) { __builtin_amdgcn_s_sleep(1); \
    if ((++_sp & 255u) == 0u) { if (xb_ld(&(bar)[XB_TMO])) break; if (_sp > XB_SPIN_CAP) { atomicAdd(&(bar)[XB_TMO], 1u); break; } } } } while (0)
struct XcdBarrier { unsigned* bar; unsigned x; volatile LAS unsigned* st; };
__device__ __forceinline__ XcdBarrier xcd_barrier_post(unsigned* bar, volatile LAS unsigned* st) {
    XcdBarrier b; b.bar = bar; b.x = xb_xcc_id(); b.st = st;
    if (threadIdx.x == 0) (void)xb_add(&bar[XB_XCNT(b.x)], 1u);
    return b;
}
__device__ __forceinline__ void xcd_barrier_complete(unsigned* bar, unsigned x, unsigned& nloc, unsigned& nx) {
    const unsigned G = gridDim.x * gridDim.y * gridDim.z;
    unsigned sum, cnt, mine, sp = 0u;
    for (;;) {
        sum = 0u; cnt = 0u; mine = 0u;
#pragma unroll
        for (unsigned j = 0; j < 16; ++j) { const unsigned c = xb_ld(&bar[XB_XCNT(j)]); sum += c; cnt += (c > 0u) ? 1u : 0u; mine = (j == x) ? c : mine; }
        if (sum == G) break;
        __builtin_amdgcn_s_sleep(1);
        if ((++sp & 255u) == 0u) { if (xb_ld(&bar[XB_TMO])) break; if (sp > XB_SPIN_CAP) { atomicAdd(&bar[XB_TMO], 1u); break; } }
    }
    nloc = mine > 0u ? mine : 1u; nx = cnt > 0u ? cnt : 1u;
}
__device__ __forceinline__ void xcd_barrier(const XcdBarrier& b) {
    asm volatile("s_waitcnt vmcnt(0)" ::: "memory");
    __syncthreads();
    if (threadIdx.x == 0) {
        unsigned* bar = b.bar;
        __builtin_amdgcn_s_waitcnt(0);
        unsigned nloc = b.st[0], nx = b.st[1];
        if (nloc == 0u) { xcd_barrier_complete(bar, b.x, nloc, nx); b.st[0] = nloc; b.st[1] = nx; }
        const unsigned old = xb_add(&bar[XB_XSUB(b.x)], 1u);
        const unsigned gen = old / nloc;
        if (old + 1u == (gen + 1u) * nloc) {
            __builtin_amdgcn_fence(__ATOMIC_RELEASE, "agent");
            asm volatile("s_waitcnt vmcnt(0)" ::: "memory");
            const unsigned og = xb_add(&bar[XB_TOP], 1u);
            const unsigned tg = og / nx;
            if (og + 1u == (tg + 1u) * nx) xb_add(&bar[XB_TOPGEN], 1u);
            else XB_SPIN(xb_ld(&bar[XB_TOPGEN]) == tg, bar);
            __builtin_amdgcn_fence(__ATOMIC_ACQUIRE, "agent");
            xb_add(&bar[XB_XGEN(b.x)], 1u);
            asm volatile("s_waitcnt vmcnt(0)" ::: "memory");
        } else {
            XB_SPIN(xb_ld(&bar[XB_XGEN(b.x)]) == gen, bar);
            __builtin_amdgcn_fence(__ATOMIC_ACQUIRE, "agent");
            asm volatile("s_waitcnt vmcnt(0)" ::: "memory");
        }
    }
    __syncthreads();
}

__device__ __forceinline__ const float* ld_in(int k) {
    const __attribute__((address_space(4))) unsigned long long* t = (const __attribute__((address_space(4))) unsigned long long*)__builtin_amdgcn_kernarg_segment_ptr();
    asm volatile("" : "+s"(t));
    return (const float*)t[k];
}
__global__ void __launch_bounds__(NTHREADS, 2) hymba_fwd(Args args) {
    extern __shared__ __attribute__((aligned(16))) unsigned char lds_raw[];
    LAS unsigned char* lds = (LAS unsigned char*)lds_raw;
    cg::grid_group grid = cg::this_grid();
    const int tid = threadIdx.x, lane = tid & 63, wave = __builtin_amdgcn_readfirstlane(tid >> 6);
    const int G = gridDim.x, bx = blockIdx.x;
    const int gw = bx * NWAVES + wave, NGW = G * NWAVES;
#define IN(k) ld_in(k)
    unsigned char* ws = (unsigned char*)ld_in(38); float* out = (float*)ld_in(37);
    unsigned* barw = (unsigned*)(ws + WS_CTL);
    volatile LAS unsigned* bst = (volatile LAS unsigned*)(lds + XCH_OFF + 8192);
    if (bx == 0) for (int i = tid; i < XCD_BAR_WORDS; i += NTHREADS) barw[i] = 0u;
    if (tid < 2) bst[tid] = 0u;
    bf16_t* WIN = (bf16_t*)(ws + WS_WIN); bf16_t* WKV = (bf16_t*)(ws + WS_WKV); bf16_t* WGLU = (bf16_t*)(ws + WS_WGLU); bf16_t* WOUT = (bf16_t*)(ws + WS_WOUT);
    bf16_t* WQ = (bf16_t*)(ws + WS_WQ); bf16_t* WXO = (bf16_t*)(ws + WS_WXO); bf16_t* WUG = (bf16_t*)(ws + WS_WUG); bf16_t* WDN = (bf16_t*)(ws + WS_WDN);
    bf16_t* H = (bf16_t*)(ws + WS_H); float* X = (float*)(ws + WS_X);
    bf16_t* Z = (bf16_t*)(ws + WS_Z); bf16_t* YG = (bf16_t*)(ws + WS_YG); float* YS = (float*)(ws + WS_YS); bf16_t* MIXN = (bf16_t*)(ws + WS_MIXN);
    bf16_t* Q = (bf16_t*)(ws + WS_Q); bf16_t* PR = (bf16_t*)(ws + WS_PR); bf16_t* O = (bf16_t*)(ws + WS_O);
    bf16_t* MN = (bf16_t*)(ws + WS_MN); bf16_t* KB = (bf16_t*)(ws + WS_KB); bf16_t* VT = (bf16_t*)(ws + WS_VT);
    float* SE = (float*)(ws + WS_SE); float* SI = (float*)(ws + WS_SI); float* BB = (float*)(ws + WS_BB); float* AT = (float*)(ws + WS_AT);
    bf16_t* UG = (bf16_t*)(ws + WS_UG); bf16_t* ACT = (bf16_t*)(ws + WS_ACT);

    if (PH(0)) {
        const float* x_prompt = IN(0); const float* x_sample = IN(1); const float* mem_prompt = IN(2); const float* norm_mix = IN(9); const float* w_in = IN(10);
        const float* A_re = IN(11); const float* A_im = IN(12); const float* log_dt = IN(13); const float* B_re = IN(14); const float* B_im = IN(15);
        const float* w_glu = IN(19); const float* w_out = IN(24); const float* norm_mem = IN(26); const float* w_q = IN(27); const float* w_k = IN(28); const float* w_v = IN(29); const float* w_xo = IN(30);
        const float* w_up = IN(32); const float* w_gate = IN(33); const float* w_down = IN(35);
        LAS float* scr = (LAS float*)(lds + wave * 16384);
        constexpr int I_IN = 16 * 64, I_D = 16 * 32, I_GLU = 8 * 16, I_UP = 16 * 88, I_DN = 44 * 32;
        constexpr int NITEMS = I_IN + 5 * I_D + I_GLU + 2 * I_UP + I_DN;
        for (int it = gw; it < NITEMS; it += NGW) {
            int r = it;
            if (r < I_IN) { transpose_item(w_in, D, NZ, WIN, 0, scr, r, lane); continue; } r -= I_IN;
            if (r < I_D) { transpose_item(w_k, D, D, WKV, 0, scr, r, lane); continue; } r -= I_D;
            if (r < I_D) { transpose_item(w_v, D, D, WKV, D, scr, r, lane); continue; } r -= I_D;
            if (r < I_D) { transpose_item(w_out, D, D, WOUT, 0, scr, r, lane); continue; } r -= I_D;
            if (r < I_D) { transpose_item(w_q, D, D, WQ, 0, scr, r, lane); continue; } r -= I_D;
            if (r < I_D) { transpose_item(w_xo, D, D, WXO, 0, scr, r, lane); continue; } r -= I_D;
            if (r < I_GLU) { transpose_item(w_glu, MIX, MIX, WGLU, 0, scr, r, lane); continue; } r -= I_GLU;
            if (r < I_UP) { transpose_item(w_up, D, DFF, WUG, 0, scr, r, lane); continue; } r -= I_UP;
            if (r < I_UP) { transpose_item(w_gate, D, DFF, WUG, DFF, scr, r, lane); continue; } r -= I_UP;
            transpose_item(w_down, DFF, D, WDN, 0, scr, r, lane);
        }
        for (int m = gw; m < MT; m += NGW) rms_row_bf16(m < NP ? x_prompt + (size_t)m * D : x_sample + (size_t)(m - NP) * D, norm_mix, H + (size_t)m * D, lane);
        for (int m = gw; m < BP * NMEM; m += NGW) rms_row_bf16(mem_prompt + (size_t)m * D, norm_mem, MN + (size_t)m * D, lane);
        const int gt = bx * NTHREADS + tid;
        if (gt < SG * SN) {
            const int g = gt / SN;
            const float dt = expf(log_dt[g]), lr = A_re[gt], li = A_im[gt];
            const float mag = expf(dt * lr), ph = dt * li;
            double th = (double)ph * (1.0 / 1024.0), t2 = th * th;
            double c = 1.0 - t2 * (0.5 - t2 * (1.0 / 24.0 - t2 * (1.0 / 720.0)));
            double s = th * (1.0 - t2 * (1.0 / 6.0 - t2 * (1.0 / 120.0 - t2 * (1.0 / 5040.0))));
#pragma unroll 1
            for (int k = 0; k < 10; ++k) { const double c2 = c * c - s * s, s2 = 2.0 * c * s; c = c2; s = s2; }
            const float ar = mag * (float)c, ai = mag * (float)s;
            const float den = lr * lr + li * li;
            const float cr = ((ar - 1.0f) * lr + ai * li) / den, ci = (ai * lr - (ar - 1.0f) * li) / den;
#pragma unroll
            for (int p = 0; p < 16; ++p) { const float br = B_re[(size_t)gt * SP + p], bi = B_im[(size_t)gt * SP + p];
                BB[(size_t)gt * 32 + p] = cr * br - ci * bi; BB[(size_t)gt * 32 + 16 + p] = cr * bi + ci * br; }
            float pr = ar, pi = ai;
#pragma unroll 1
            for (int k = 0; k < 6; ++k) { const float r2 = pr * pr - pi * pi, i2 = 2.0f * pr * pi; pr = r2; pi = i2; }
            *(f32x4*)(AT + (size_t)gt * 4) = (f32x4){ar, ai, pr, pi};
        }
    }
    grid.sync();
    const XcdBarrier xb = xcd_barrier_post(barw, bst);

    if (PH(1)) {
        Sched2 S{G, bx, MT / 256, NZ / 256, BP, 8, (const char*)H, (const char*)WIN, (const char*)MN, (const char*)WKV, (size_t)256 * D * 2, (size_t)256 * D * 2};
        EpiP1 E{Z, out + O_MK, out + O_MV, KB, VT};
        pg8::gemm_phase(lds, D, D, D, S, E);
    }
    GSYNC();

    if (PH(2)) {
        const float* st_re = IN(5); const float* st_im = IN(6); const float* st_conv = IN(7); const float* C_re = IN(16); const float* C_im = IN(17); const float* Dssm = IN(18); const float* conv_w = IN(21); const float* norm_conv = IN(23);
        for (int task = gw; task < BP * SG * NCH; task += NGW) {
            const int c = task % NCH, g = (task / NCH) % SG, b = task / (NCH * SG);
            float sr = 0.f, si = 0.f;
            ssm_tile<false>(Z + (size_t)(b * TP + c * LCH) * NZ + g * SP, LCH, sr, si, BB, AT, C_re, C_im, Dssm, g, nullptr, lane);
            float* e = SE + ((size_t)(b * SG + g) * NCH + c) * 128; e[lane] = sr; e[64 + lane] = si;
        }
        for (int task = gw; task < BS * SG; task += NGW) {
            const int b = task % BS, g = task / BS;
            float sr = st_re[(size_t)(b * SG + g) * SN + lane], si = st_im[(size_t)(b * SG + g) * SN + lane];
            ssm_tile<true>(Z + (size_t)(NP + b * TS) * NZ + g * SP, TS, sr, si, BB, AT, C_re, C_im, Dssm, g, YG + (size_t)(NP + b * TS) * MIX, lane);
            out[O_SRS + (size_t)(b * SG + g) * SN + lane] = sr; out[O_SIS + (size_t)(b * SG + g) * SN + lane] = si;
        }
        for (int r = gw; r < MT; r += NGW) {
            int b, t; const float* prev; float* cout; int T;
            if (r < NP) { b = r / TP; t = r % TP; prev = nullptr; cout = out + O_CP + (size_t)b * 2 * MIX; T = TP; }
            else { const int rs = r - NP; b = rs / TS; t = rs % TS; prev = st_conv + (size_t)b * 2 * MIX; cout = out + O_CS + (size_t)b * 2 * MIX; T = TS; }
            const int c0 = lane * 8;
            float p[3][8];
#pragma unroll
            for (int k = 0; k < 3; ++k) {
                const int tt = t - k;
                if (tt >= 0) { const bf16_t* zr = Z + (size_t)(r - k) * NZ; const u32x4 xi = *(const u32x4*)(zr + MIX + c0), cgv = *(const u32x4*)(zr + 3 * MIX + c0);
                    p[k][0] = bf_lo(xi.x) * bf_lo(cgv.x); p[k][1] = bf_hi(xi.x) * bf_hi(cgv.x); p[k][2] = bf_lo(xi.y) * bf_lo(cgv.y); p[k][3] = bf_hi(xi.y) * bf_hi(cgv.y);
                    p[k][4] = bf_lo(xi.z) * bf_lo(cgv.z); p[k][5] = bf_hi(xi.z) * bf_hi(cgv.z); p[k][6] = bf_lo(xi.w) * bf_lo(cgv.w); p[k][7] = bf_hi(xi.w) * bf_hi(cgv.w); }
                else if (prev) { const float* pp = prev + (size_t)(2 + tt) * MIX + c0; const f32x4 a = *(const f32x4*)pp, bq = *(const f32x4*)(pp + 4);
                    p[k][0] = a[0]; p[k][1] = a[1]; p[k][2] = a[2]; p[k][3] = a[3]; p[k][4] = bq[0]; p[k][5] = bq[1]; p[k][6] = bq[2]; p[k][7] = bq[3]; }
                else {
#pragma unroll
                    for (int j = 0; j < 8; ++j) p[k][j] = 0.f; }
            }
            const u32x4 bgv = *(const u32x4*)(Z + (size_t)r * NZ + 2 * MIX + c0);
            float bg[8] = {bf_lo(bgv.x), bf_hi(bgv.x), bf_lo(bgv.y), bf_hi(bgv.y), bf_lo(bgv.z), bf_hi(bgv.z), bf_lo(bgv.w), bf_hi(bgv.w)};
            float y[8]; float ss = 0.f;
#pragma unroll
            for (int j = 0; j < 8; ++j) { const float w0 = conv_w[c0 + j], w1 = conv_w[MIX + c0 + j], w2 = conv_w[2 * MIX + c0 + j];
                y[j] = bg[j] * (w0 * p[2][j] + w1 * p[1][j] + w2 * p[0][j]); ss += y[j] * y[j]; }
            const float rstd = 1.0f / sqrtf(wave_sum(ss) * (1.0f / MIX) + EPS);
            const f32x4 g0 = *(const f32x4*)(norm_conv + c0), g1 = *(const f32x4*)(norm_conv + c0 + 4);
            u32x4 w; w.x = cvt_pk_bf16(y[0] * rstd * g0[0], y[1] * rstd * g0[1]); w.y = cvt_pk_bf16(y[2] * rstd * g0[2], y[3] * rstd * g0[3]);
            w.z = cvt_pk_bf16(y[4] * rstd * g1[0], y[5] * rstd * g1[1]); w.w = cvt_pk_bf16(y[6] * rstd * g1[2], y[7] * rstd * g1[3]);
            *(u32x4*)(MIXN + (size_t)r * D + MIX + c0) = w;
            if (t >= T - 2) { float* co = cout + (size_t)(t - (T - 2)) * MIX + c0; *(f32x4*)co = (f32x4){p[0][0], p[0][1], p[0][2], p[0][3]}; *(f32x4*)(co + 4) = (f32x4){p[0][4], p[0][5], p[0][6], p[0][7]}; }
        }
    }
    GSYNC();

    if (PH(3)) {
        for (int task = gw; task < BP * SG; task += NGW) {
            const int g = task % SG, b = task / SG;
            const f32x4 at = *(const f32x4*)(AT + (size_t)(g * SN + lane) * 4); const float aLr = at[2], aLi = at[3];
            float sr = 0.f, si = 0.f;
            for (int c = 0; c < NCH; ++c) {
                float* sip = SI + ((size_t)(b * SG + g) * NCH + c) * 128; sip[lane] = sr; sip[64 + lane] = si;
                const float* e = SE + ((size_t)(b * SG + g) * NCH + c) * 128; const float er = e[lane], ei = e[64 + lane];
                const float nr = aLr * sr - aLi * si + er, ni = aLr * si + aLi * sr + ei; sr = nr; si = ni;
            }
            out[O_SRP + (size_t)(b * SG + g) * SN + lane] = sr; out[O_SIP + (size_t)(b * SG + g) * SN + lane] = si;
        }
    }
    GSYNC();

    if (PH(4)) {
        const float* C_re = IN(16); const float* C_im = IN(17); const float* Dssm = IN(18);
        for (int task = gw; task < BP * SG * NCH; task += NGW) {
            const int c = task % NCH, g = (task / NCH) % SG, b = task / (NCH * SG);
            const float* sip = SI + ((size_t)(b * SG + g) * NCH + c) * 128; float sr = sip[lane], si = sip[64 + lane];
            ssm_tile<true>(Z + (size_t)(b * TP + c * LCH) * NZ + g * SP, LCH, sr, si, BB, AT, C_re, C_im, Dssm, g, YG + (size_t)(b * TP + c * LCH) * MIX, lane);
        }
    }
    GSYNC();

    if (PH(5)) {
        const float* b_glu = IN(20);
        Sched2 S{G, bx, MT / 256, MIX / 256, 0, 0, (const char*)YG, (const char*)WGLU, nullptr, nullptr, (size_t)256 * MIX * 2, (size_t)256 * MIX * 2};
        EpiGlu E{YG, b_glu, YS};
        pg8::gemm_phase(lds, MIX, MIX, MIX, S, E);
    }
    GSYNC();

    if (PH(6)) {
        const float* norm_ssm = IN(22);
        for (int r = gw; r < MT; r += NGW) {
            const f32x4* yr = (const f32x4*)(YS + (size_t)r * MIX) + lane; const f32x4 a = yr[0], b = yr[64];
            const float ss = (a[0] * a[0] + a[1] * a[1]) + (a[2] * a[2] + a[3] * a[3]) + (b[0] * b[0] + b[1] * b[1]) + (b[2] * b[2] + b[3] * b[3]);
            const float rstd = 1.0f / sqrtf(wave_sum(ss) * (1.0f / MIX) + EPS);
            const f32x4 ga = ((const f32x4*)norm_ssm)[lane], gb = ((const f32x4*)norm_ssm)[lane + 64];
            u32x2 w0, w1; w0.x = cvt_pk_bf16(a[0] * rstd * ga[0], a[1] * rstd * ga[1]); w0.y = cvt_pk_bf16(a[2] * rstd * ga[2], a[3] * rstd * ga[3]);
            w1.x = cvt_pk_bf16(b[0] * rstd * gb[0], b[1] * rstd * gb[1]); w1.y = cvt_pk_bf16(b[2] * rstd * gb[2], b[3] * rstd * gb[3]);
            u32x2* o8 = (u32x2*)(MIXN + (size_t)r * D) + lane; o8[0] = w0; o8[64] = w1;
        }
    }
    GSYNC();

    if (PH(7)) {
        const float* x_prompt = IN(0); const float* x_sample = IN(1);
        Sched2 S{G, bx, MT / 256, D / 256, 0, 0, (const char*)MIXN, (const char*)WOUT, nullptr, nullptr, (size_t)256 * D * 2, (size_t)256 * D * 2};
        EpiRes E{x_prompt, x_sample, X, 1};
        pg8::gemm_phase(lds, D, D, D, S, E);
    }
    GSYNC();

    if (PH(8)) for (int m = gw; m < MT; m += NGW) rms_row_bf16(X + (size_t)m * D, IN(25), H + (size_t)m * D, lane);
    GSYNC();

    if (PH(9)) {
        Sched2 S{G, bx, MT / 256, D / 256, 0, 0, (const char*)H, (const char*)WQ, nullptr, nullptr, (size_t)256 * D * 2, (size_t)256 * D * 2};
        EpiBf E{Q, D, 0.0625f};
        pg8::gemm_phase(lds, D, D, D, S, E);
    }
    GSYNC();

    if (PH(10)) {
        const float* cache_k = IN(3); const float* cache_v = IN(4);
        struct SchedQK { int G, c; const char* Q; const char* KB;
            __device__ __forceinline__ bool next(int i, Unit& u) const { const int L = i * G + c; if (L >= 64 * NH) return false; pg8::order_map(L, 64, NH, u.pm, u.pn); u.kind = 0;
                u.A = Q + ((size_t)u.pm * 256 * D + (size_t)u.pn * HD) * 2; u.B = KB + ((size_t)(u.pm >> 3) * NMEM * D + (size_t)u.pn * HD) * 2; return true; } };
        SchedQK S{G, bx, (const char*)Q, (const char*)KB};
        EpiSoftmax E{PR, lds};
#ifndef NO_QK
        pg8::gemm_phase(lds, HD, D, D, S, E);
#endif

#ifndef NO_SATT
        LAS float* sc = (LAS float*)lds;
        LAS float* pr = (LAS float*)(lds + 4096);
        LAS float* po = (LAS float*)(lds + 8192);
        for (int unit = bx; unit < BS * NH; unit += G) {
            const int b = unit / NH, h = unit % NH;
            float q[4][4];
#pragma unroll
            for (int qi = 0; qi < 4; ++qi) { const u32x2 w = *(const u32x2*)(Q + (size_t)(NP + b * TS + qi) * D + h * HD + 4 * lane); q[qi][0] = bf_lo(w.x); q[qi][1] = bf_hi(w.x); q[qi][2] = bf_lo(w.y); q[qi][3] = bf_hi(w.y); }
            const float* kbase = cache_k + ((size_t)(b * NMEM) * NH + h) * HD + 4 * lane;
            const float* vbase = cache_v + ((size_t)(b * NMEM) * NH + h) * HD + 4 * lane;
#pragma unroll 1
            for (int blk = 0; blk < 2; ++blk) {
                const int key0 = wave * 32 + blk * 16;
                float v[64];
#pragma unroll
                for (int k = 0; k < 16; ++k) { const f32x4 kv = *(const f32x4*)(kbase + (size_t)(key0 + k) * NH * HD);
#pragma unroll
                    for (int qi = 0; qi < 4; ++qi) v[k * 4 + qi] = (kv[0] * q[qi][0] + kv[1] * q[qi][1]) + (kv[2] * q[qi][2] + kv[3] * q[qi][3]); }
                const float s = treduce64(v, lane);
                sc[(lane & 3) * 256 + key0 + (lane >> 2)] = s;
            }
            __syncthreads();
            {
                const int qi = lane & 3, kb = lane >> 2; float sv[16]; float mx = -3.0e38f;
#pragma unroll
                for (int j = 0; j < 16; ++j) { sv[j] = sc[qi * 256 + kb + 16 * j]; mx = fmaxf(mx, sv[j]); }
                mx = fmaxf(mx, __shfl_xor(mx, 4)); mx = fmaxf(mx, __shfl_xor(mx, 8)); mx = fmaxf(mx, __shfl_xor(mx, 16)); mx = fmaxf(mx, __shfl_xor(mx, 32));
                float sum = 0.f;
#pragma unroll
                for (int j = 0; j < 16; ++j) { sv[j] = fast_exp(sv[j] - mx); sum += sv[j]; }
                sum += __shfl_xor(sum, 4); sum += __shfl_xor(sum, 8); sum += __shfl_xor(sum, 16); sum += __shfl_xor(sum, 32);
                const float inv = 1.0f / sum;
                if (wave == 0) {
#pragma unroll
                    for (int j = 0; j < 16; ++j) pr[qi * 256 + kb + 16 * j] = sv[j] * inv; }
            }
            __syncthreads();
            {
                float o[4][4];
#pragma unroll
                for (int qi = 0; qi < 4; ++qi) { o[qi][0] = 0.f; o[qi][1] = 0.f; o[qi][2] = 0.f; o[qi][3] = 0.f; }
#pragma unroll 8
                for (int k = 0; k < 32; ++k) { const int key = wave * 32 + k; const f32x4 vv = *(const f32x4*)(vbase + (size_t)key * NH * HD);
#pragma unroll
                    for (int qi = 0; qi < 4; ++qi) { const float pp = pr[qi * 256 + key]; o[qi][0] = fmaf(pp, vv[0], o[qi][0]); o[qi][1] = fmaf(pp, vv[1], o[qi][1]); o[qi][2] = fmaf(pp, vv[2], o[qi][2]); o[qi][3] = fmaf(pp, vv[3], o[qi][3]); } }
#pragma unroll
                for (int qi = 0; qi < 4; ++qi) *(LAS f32x4*)(po + (wave * 4 + qi) * 256 + 4 * lane) = (f32x4){o[qi][0], o[qi][1], o[qi][2], o[qi][3]};
            }
            __syncthreads();
            {
                const int idx = tid * 2, qi = idx >> 8, d = idx & 255; float a0 = 0.f, a1 = 0.f;
#pragma unroll
                for (int w = 0; w < 8; ++w) { const f32x2 t2 = *(LAS f32x2*)(po + (w * 4 + qi) * 256 + d); a0 += t2[0]; a1 += t2[1]; }
                *(unsigned*)(O + (size_t)(NP + b * TS + qi) * D + h * HD + d) = cvt_pk_bf16(a0, a1);
            }
        }
#endif
    }
    GSYNC();

    if (PH(11)) {
        struct SchedPV { int G, c; const char* PR; const char* VT;
            __device__ __forceinline__ bool next(int i, Unit& u) const { const int L = i * G + c; if (L >= 64 * NH) return false; pg8::order_map(L, 64, NH, u.pm, u.pn); u.kind = 0;
                u.A = PR + (size_t)(u.pm * NH + u.pn) * 256 * 256 * 2; u.B = VT + (size_t)((u.pm >> 3) * NH + u.pn) * HD * NMEM * 2; return true; } };
        SchedPV S{G, bx, (const char*)PR, (const char*)VT};
        EpiBf E{O, D, 1.0f};
        pg8::gemm_phase(lds, NMEM, NMEM, NMEM, S, E);
    }
    GSYNC();

    if (PH(12)) {
        const float* x_prompt = nullptr; const float* x_sample = nullptr;
        Sched2 S{G, bx, MT / 256, D / 256, 0, 0, (const char*)O, (const char*)WXO, nullptr, nullptr, (size_t)256 * D * 2, (size_t)256 * D * 2};
        EpiRes E{x_prompt, x_sample, X, 0};
        pg8::gemm_phase(lds, D, D, D, S, E);
    }
    GSYNC();

    if (PH(13)) for (int m = gw; m < MT; m += NGW) rms_row_bf16(X + (size_t)m * D, IN(31), H + (size_t)m * D, lane);
    GSYNC();

    if (PH(14)) {
        Sched2 S{G, bx, MT / 256, NUG / 256, 0, 0, (const char*)H, (const char*)WUG, nullptr, nullptr, (size_t)256 * D * 2, (size_t)256 * D * 2};
        EpiBf E{UG, NUG, 1.0f};
        pg8::gemm_phase(lds, D, D, D, S, E);
    }
    GSYNC();

    if (PH(15)) {
        const float* st_ffn = IN(8); const float* ffn_conv_w = IN(34);
        constexpr int NV = DFF / 8;
        const size_t total = (size_t)MT * NV;
        for (size_t idx = (size_t)bx * NTHREADS + tid; idx < total; idx += (size_t)G * NTHREADS) {
            const int r = (int)(idx / NV), c0 = (int)(idx % NV) * 8;
            int b, t, T; const float* prev; float* fout;
            if (r < NP) { b = r / TP; t = r % TP; prev = nullptr; fout = out + O_FP + (size_t)b * 2 * DFF; T = TP; }
            else { const int rs = r - NP; b = rs / TS; t = rs % TS; prev = st_ffn + (size_t)b * 2 * DFF; fout = out + O_FS + (size_t)b * 2 * DFF; T = TS; }
            float p[3][8];
#pragma unroll
            for (int k = 0; k < 3; ++k) {
                const int tt = t - k;
                if (tt >= 0) { const u32x4 uw = *(const u32x4*)(UG + (size_t)(r - k) * NUG + c0);
                    p[k][0] = bf_lo(uw.x); p[k][1] = bf_hi(uw.x); p[k][2] = bf_lo(uw.y); p[k][3] = bf_hi(uw.y); p[k][4] = bf_lo(uw.z); p[k][5] = bf_hi(uw.z); p[k][6] = bf_lo(uw.w); p[k][7] = bf_hi(uw.w); }
                else if (prev) { const float* pp = prev + (size_t)(2 + tt) * DFF + c0; const f32x4 a = *(const f32x4*)pp, bq = *(const f32x4*)(pp + 4);
                    p[k][0] = a[0]; p[k][1] = a[1]; p[k][2] = a[2]; p[k][3] = a[3]; p[k][4] = bq[0]; p[k][5] = bq[1]; p[k][6] = bq[2]; p[k][7] = bq[3]; }
                else {
#pragma unroll
                    for (int j = 0; j < 8; ++j) p[k][j] = 0.f; }
            }
            const u32x4 gw4 = *(const u32x4*)(UG + (size_t)r * NUG + DFF + c0);
            const float gt8[8] = {bf_lo(gw4.x), bf_hi(gw4.x), bf_lo(gw4.y), bf_hi(gw4.y), bf_lo(gw4.z), bf_hi(gw4.z), bf_lo(gw4.w), bf_hi(gw4.w)};
            float a8[8];
#pragma unroll
            for (int j = 0; j < 8; ++j) { const float w0 = ffn_conv_w[c0 + j], w1 = ffn_conv_w[DFF + c0 + j], w2 = ffn_conv_w[2 * DFF + c0 + j];
                a8[j] = gelu_tanh(w0 * p[2][j] + w1 * p[1][j] + w2 * p[0][j]) * gt8[j]; }
            u32x4 w; w.x = cvt_pk_bf16(a8[0], a8[1]); w.y = cvt_pk_bf16(a8[2], a8[3]); w.z = cvt_pk_bf16(a8[4], a8[5]); w.w = cvt_pk_bf16(a8[6], a8[7]);
            *(u32x4*)(ACT + (size_t)r * DFF + c0) = w;
            if (t >= T - 2) { float* fo = fout + (size_t)(t - (T - 2)) * DFF + c0; *(f32x4*)fo = (f32x4){p[0][0], p[0][1], p[0][2], p[0][3]}; *(f32x4*)(fo + 4) = (f32x4){p[0][4], p[0][5], p[0][6], p[0][7]}; }
        }
    }
    GSYNC();

    if (PH(16)) {
        const float* x_prompt = nullptr; const float* x_sample = nullptr;
        Sched2 S{G, bx, MT / 256, D / 256, 0, 0, (const char*)ACT, (const char*)WDN, nullptr, nullptr, (size_t)256 * DFF * 2, (size_t)256 * DFF * 2};
        EpiRes E{x_prompt, x_sample, X, 0};
        pg8::gemm_phase(lds, DFF, DFF, DFF, S, E);
    }
    GSYNC();

    if (PH(17)) for (int m = gw; m < MT; m += NGW) rms_row_f32(X + (size_t)m * D, IN(36), out + (size_t)m * D, lane);
}

extern "C" void kernel_launch(void* const* d_in, const int* in_sizes, int n_in, void* d_out, int out_size, void* d_ws, size_t ws_size, hipStream_t stream) {
    static int grid = 0;
    if (grid == 0) {
        if (n_in != 37 || (size_t)out_size != O_END || ws_size < WS_END) { fprintf(stderr, "kernel_launch: unexpected sizes n_in %d out %d ws %zu\n", n_in, out_size, ws_size); grid = -1; return; }
        int dev = 0, cus = 0, per_cu = 0;
        (void)hipGetDevice(&dev); (void)hipDeviceGetAttribute(&cus, hipDeviceAttributeMultiprocessorCount, dev);
        (void)hipFuncSetAttribute((const void*)hymba_fwd, hipFuncAttributeMaxDynamicSharedMemorySize, LDS_BYTES);
        (void)hipOccupancyMaxActiveBlocksPerMultiprocessor(&per_cu, (const void*)hymba_fwd, NTHREADS, LDS_BYTES);
        if (per_cu < 1) { fprintf(stderr, "kernel_launch: occupancy query reports %d blocks per CU\n", per_cu); per_cu = 1; }
        (void)hipGetLastError();
        grid = cus;
        if (grid % 8) grid -= grid % 8;
    }
    if (grid < 0) return;
    Args a{};
    for (int i = 0; i < 37; ++i) a.in[i] = (const float*)d_in[i];
    a.out = (float*)d_out; a.ws = (unsigned char*)d_ws;
    void* kargs[] = {&a};
    hipError_t e = hipLaunchCooperativeKernel((const void*)hymba_fwd, dim3(grid), dim3(NTHREADS), kargs, LDS_BYTES, stream);
    if (e != hipSuccess) fprintf(stderr, "cooperative launch failed: %s (grid %d)\n", hipGetErrorString(e), grid);
}
```

```cpp
#include <hip/hip_runtime.h>
#include <hip/hip_cooperative_groups.h>
#include <cstdio>
#include <cstdint>
namespace cg = cooperative_groups;

#define LAS __attribute__((address_space(3)))
typedef unsigned short bf16_t;
typedef short bf16x8 __attribute__((ext_vector_type(8)));
typedef float f32x4 __attribute__((ext_vector_type(4)));
typedef float f32x2 __attribute__((ext_vector_type(2)));
typedef unsigned u32x4 __attribute__((ext_vector_type(4)));
typedef unsigned u32x2 __attribute__((ext_vector_type(2)));

constexpr int D = 1024, NP = 16384, NS = 512, MT = NP + NS;
constexpr int TP = 2048, TS = 4, BP = 8, BS = 128;
constexpr int NZ = 2048, MIX = 512, DFF = 2816, NUG = 2 * DFF;
constexpr int SG = 32, SP = 16, SN = 64, LCH = 64, NCH = TP / LCH;
constexpr int NMEM = 256, NH = 4, HD = 256;
constexpr float EPS = 1e-6f;
constexpr int NWAVES = 8, NTHREADS = 512;

constexpr size_t MiB = 1u << 20;
constexpr size_t WS_WIN = 0;
constexpr size_t WS_WKV = WS_WIN + 4 * MiB;
constexpr size_t WS_WGLU = WS_WKV + 4 * MiB;
constexpr size_t WS_WOUT = WS_WGLU + 1 * MiB;
constexpr size_t WS_WQ = WS_WOUT + 2 * MiB;
constexpr size_t WS_WXO = WS_WQ + 2 * MiB;
constexpr size_t WS_WUG = WS_WXO + 2 * MiB;
constexpr size_t WS_WDN = WS_WUG + 11 * MiB;
constexpr size_t WS_H = WS_WDN + 6 * MiB;
constexpr size_t WS_X = WS_H + 33 * MiB;
constexpr size_t WS_OV = WS_X + 66 * MiB;
constexpr size_t WS_Z = WS_OV;
constexpr size_t WS_YG = WS_Z + 66 * MiB;
constexpr size_t WS_YS = WS_YG + 17 * MiB;
constexpr size_t WS_MIXN = WS_YS + 33 * MiB;
constexpr size_t WS_Q = WS_MIXN + 33 * MiB;
constexpr size_t WS_PR = WS_Q + 33 * MiB;
constexpr size_t WS_O = WS_PR + 32 * MiB;
constexpr size_t WS_MN = WS_O + 33 * MiB;
constexpr size_t WS_KB = WS_MN + 4 * MiB;
constexpr size_t WS_VT = WS_KB + 4 * MiB;
constexpr size_t WS_SE = WS_VT + 4 * MiB;
constexpr size_t WS_SI = WS_SE + 4 * MiB;
constexpr size_t WS_BB = WS_SI + 4 * MiB;
constexpr size_t WS_AT = WS_BB + 1 * MiB;
constexpr size_t WS_OV_END1 = WS_AT + 1 * MiB;
constexpr size_t WS_UG = WS_OV;
constexpr size_t WS_ACT = WS_UG + 182 * MiB;
constexpr size_t WS_CTL = WS_ACT + 91 * MiB;
constexpr size_t WS_PART = WS_CTL + 1 * MiB;
constexpr size_t WS_END = WS_PART + 22 * MiB;
static_assert(WS_OV_END1 <= WS_CTL, "overlay");
static_assert(WS_END <= 512 * MiB, "workspace");

constexpr size_t O_YP = 0;
constexpr size_t O_YS = O_YP + (size_t)NP * D;
constexpr size_t O_MK = O_YS + (size_t)NS * D;
constexpr size_t O_MV = O_MK + (size_t)BP * NMEM * D;
constexpr size_t O_SRP = O_MV + (size_t)BP * NMEM * D;
constexpr size_t O_SIP = O_SRP + (size_t)BP * SG * SN;
constexpr size_t O_CP = O_SIP + (size_t)BP * SG * SN;
constexpr size_t O_FP = O_CP + (size_t)BP * 2 * MIX;
constexpr size_t O_SRS = O_FP + (size_t)BP * 2 * DFF;
constexpr size_t O_SIS = O_SRS + (size_t)BS * SG * SN;
constexpr size_t O_CS = O_SIS + (size_t)BS * SG * SN;
constexpr size_t O_FS = O_CS + (size_t)BS * 2 * MIX;
constexpr size_t O_END = O_FS + (size_t)BS * 2 * DFF;

constexpr int RING_BYTES = 131072, XCH_OFF = RING_BYTES, LDS_BYTES = 147456;

__device__ __forceinline__ unsigned cvt_pk_bf16(float lo, float hi) { unsigned r; asm volatile("v_cvt_pk_bf16_f32 %0, %1, %2" : "=v"(r) : "v"(lo), "v"(hi)); return r; }
__device__ __forceinline__ float bf_lo(unsigned w) { return __uint_as_float(w << 16); }
__device__ __forceinline__ float bf_hi(unsigned w) { return __uint_as_float(w & 0xffff0000u); }
__device__ __forceinline__ float wave_sum(float v) {
#pragma unroll
    for (int o = 1; o < 64; o <<= 1) v += __shfl_xor(v, o);
    return v;
}
__device__ __forceinline__ float fast_exp(float x) { return __builtin_amdgcn_exp2f(x * 1.4426950408889634f); }
__device__ __forceinline__ float gelu_tanh(float x) {
    const float z = 0.7978845608028654f * (x + 0.044715f * x * x * x);
    return x * __builtin_amdgcn_rcpf(1.0f + fast_exp(-2.0f * z));
}
__device__ __forceinline__ float sigmoidf(float a) { return __builtin_amdgcn_rcpf(1.0f + fast_exp(-a)); }

namespace pg8 {
constexpr int BM = 256, BK = 64, HALF = 128, HTB = HALF * BK * 2;
__host__ __device__ __forceinline__ int lds_byte(int r, int c) { const int st = (r >> 4) * 2 + (c >> 5), rr = r & 15, cc = c & 31, ob = rr * 64 + cc * 2; return st * 1024 + (ob ^ (((ob >> 9) & 1) << 5)); }
__host__ __device__ __forceinline__ void stage_rc(int b, int& R, int& C) { const int st = b / 1024, sb = b % 1024, swz = sb ^ (((sb >> 9) & 1) << 5); R = (st >> 1) * 16 + swz / 64; C = (st & 1) * 32 + (swz % 64) / 2; }
__host__ __device__ __forceinline__ int perm32(int rho) { const int n = rho >> 4, i = rho & 15; return 8 * (i >> 2) + 4 * n + (i & 3); }

struct Unit { int pm, pn, kind, nt, ks; const char* A; const char* B; };

__device__ __forceinline__ void order_map(int L, int nM, int nN, int& pm, int& pn) {
    const int nwg = nM * nN; int wgid = L;
    { const int q = nwg / 8, r = nwg % 8, xcd = wgid % 8, off = wgid / 8; wgid = (xcd < r ? xcd * (q + 1) : r * (q + 1) + (xcd - r) * q) + off; }
    const int nig = 8 * nN, gid = wgid / nig, fm = gid * 8, gsz = (nM - fm) < 8 ? (nM - fm) : 8;
    pm = fm + ((wgid % nig) % gsz); pn = (wgid % nig) / gsz;
}

template <class Epi, class Sched>
__device__ __forceinline__ void gemm_phase(LAS unsigned char* lds, const int lda, const int ldb, const Sched& S, Epi& E) {
    int tid_l = threadIdx.x; asm volatile("" : "+v"(tid_l));
    const int tid = tid_l, wid = __builtin_amdgcn_readfirstlane(tid >> 6), lane = tid & 63, wr = wid >> 2, wc = wid & 3, fr = lane & 15, fq = lane >> 4;
    unsigned voffA[2], voffB[2];
#pragma unroll
    for (int i = 0; i < 2; ++i) { int R, C; stage_rc(tid * 16 + i * 8192, R, C); const int Rb = (R & ~31) + perm32(R & 31);
        voffA[i] = (unsigned)(R * lda + C) * 2u; voffB[i] = (unsigned)(Rb * ldb + C) * 2u; }
    const size_t kstep = (size_t)(BK * 2);
    const size_t hstepA = (size_t)HALF * lda * 2, hstepB = (size_t)HALF * ldb * 2;
    const unsigned ldsw = (unsigned)wid * 1024u;
    const int aoff = lds_byte(wr * 64 + fr, fq * 8), boff = lds_byte(wc * 32 + fr, fq * 8);
#define PG8_SA(b, h) (((b) * 2 + (h)) * HTB)
#define PG8_SB(b, h) ((4 + (b) * 2 + (h)) * HTB)
#define PG8_STAGE(bufoff, gbase, voff) do { _Pragma("unroll") for (int _i = 0; _i < 2; ++_i) \
        __builtin_amdgcn_global_load_lds((const unsigned*)((const char*)(gbase) + (voff)[_i]), (LAS unsigned*)(lds + (bufoff) + ldsw + _i * 8192), 16, 0, 0); } while (0)
#define PG8_LDA(dst, b, h) do { _Pragma("unroll") for (int m = 0; m < 4; ++m) _Pragma("unroll") for (int k = 0; k < 2; ++k) dst[m][k] = *(const LAS bf16x8*)(lds + PG8_SA(b, h) + aoff + m * 2048 + k * 1024); } while (0)
#define PG8_LDB(dst, b, h) do { _Pragma("unroll") for (int n = 0; n < 2; ++n) _Pragma("unroll") for (int k = 0; k < 2; ++k) dst[n][k] = *(const LAS bf16x8*)(lds + PG8_SB(b, h) + boff + n * 2048 + k * 1024); } while (0)
#define PG8_MMA(ai, bj, At, Bt) do { __builtin_amdgcn_s_setprio(1); _Pragma("unroll") for (int m = 0; m < 4; ++m) _Pragma("unroll") for (int n = 0; n < 2; ++n) _Pragma("unroll") for (int k = 0; k < 2; ++k) \
        acc[ai][bj][m][n] = __builtin_amdgcn_mfma_f32_16x16x32_bf16(Bt[n][k], At[m][k], acc[ai][bj][m][n], 0, 0, 0); __builtin_amdgcn_s_setprio(0); } while (0)
#define PG8_WAIT_V(n) asm volatile("s_waitcnt vmcnt(" #n ")" ::: "memory")
#define PG8_WAIT_L(n) asm volatile("s_waitcnt lgkmcnt(" #n ")" ::: "memory")
#define PG8_BAR __builtin_amdgcn_s_barrier()
#define PG8_SCHED __builtin_amdgcn_sched_barrier(0)
    Unit cur, nxt; int ui = 0;
    if (!S.next(0, cur)) return;
    f32x4 acc[2][2][4][2];
#pragma unroll
    for (int a = 0; a < 2; ++a)
#pragma unroll
        for (int b = 0; b < 2; ++b)
#pragma unroll
            for (int m = 0; m < 4; ++m)
#pragma unroll
                for (int n = 0; n < 2; ++n) acc[a][b][m][n] = (f32x4){0.f, 0.f, 0.f, 0.f};
    bf16x8 At[4][2], B0[2][2], B1[2][2];
    const char* cA = cur.A; const char* cB = cur.B;
    PG8_STAGE(PG8_SB(0, 0), cB, voffB); PG8_STAGE(PG8_SB(0, 1), cB + hstepB, voffB); PG8_STAGE(PG8_SA(0, 0), cA, voffA); PG8_STAGE(PG8_SA(0, 1), cA + hstepA, voffA);
    if (wr == 1) PG8_BAR;
    PG8_WAIT_V(2); PG8_BAR;
    PG8_STAGE(PG8_SB(1, 0), cB + kstep, voffB); PG8_STAGE(PG8_SA(1, 0), cA + kstep, voffA); PG8_STAGE(PG8_SB(1, 1), cB + hstepB + kstep, voffB);
    PG8_WAIT_V(6); PG8_BAR;
    for (;;) {
        const bool has_next = S.next(ui + 1, nxt);
        const char* nA = has_next ? nxt.A : cA; const char* nB = has_next ? nxt.B : cB;
        const int nt = cur.nt;
#pragma unroll 1
        for (int t = 0; t < nt; t += 2) {
            const bool last = (t == nt - 2);
            const char* a1 = cA + (size_t)(t + 1) * kstep;
            const char* a2 = last ? nA : cA + (size_t)(t + 2) * kstep; const char* b2 = last ? nB : cB + (size_t)(t + 2) * kstep;
            const char* a3 = a2 + kstep; const char* b3 = b2 + kstep;
            PG8_LDB(B0, 0, 0); PG8_LDB(B1, 0, 1); PG8_SCHED; PG8_LDA(At, 0, 0); PG8_STAGE(PG8_SA(1, 1), a1 + hstepA, voffA);
            PG8_WAIT_V(8); PG8_WAIT_L(0); PG8_BAR; PG8_MMA(0, 0, At, B0); PG8_MMA(0, 1, At, B1); PG8_BAR; PG8_SCHED;
            PG8_LDA(At, 0, 1); PG8_STAGE(PG8_SB(0, 0), b2, voffB); PG8_STAGE(PG8_SB(0, 1), b2 + hstepB, voffB); PG8_STAGE(PG8_SA(0, 0), a2, voffA);
            PG8_WAIT_V(8); PG8_WAIT_L(0); PG8_BAR; PG8_MMA(1, 0, At, B0); PG8_MMA(1, 1, At, B1); PG8_BAR; PG8_SCHED;
            PG8_LDB(B0, 1, 0); PG8_LDB(B1, 1, 1); PG8_SCHED; PG8_LDA(At, 1, 0); PG8_STAGE(PG8_SA(0, 1), a2 + hstepA, voffA);
            PG8_WAIT_V(8); PG8_WAIT_L(0); PG8_BAR; PG8_MMA(0, 0, At, B0); PG8_MMA(0, 1, At, B1); PG8_BAR; PG8_SCHED;
            PG8_LDA(At, 1, 1); PG8_STAGE(PG8_SB(1, 0), b3, voffB); PG8_STAGE(PG8_SB(1, 1), b3 + hstepB, voffB); PG8_STAGE(PG8_SA(1, 0), a3, voffA);
            PG8_WAIT_V(8); PG8_WAIT_L(0); PG8_BAR; PG8_MMA(1, 0, At, B0); PG8_MMA(1, 1, At, B1); PG8_BAR; PG8_SCHED;
        }
        if (wr == 0) PG8_BAR;
        E(acc, cur, wr, wc, fr, fq);
        if (!has_next) break;
#pragma unroll
        for (int a = 0; a < 2; ++a)
#pragma unroll
            for (int b = 0; b < 2; ++b)
#pragma unroll
                for (int m = 0; m < 4; ++m)
#pragma unroll
                    for (int n = 0; n < 2; ++n) acc[a][b][m][n] = (f32x4){0.f, 0.f, 0.f, 0.f};
        cur = nxt; cA = nA; cB = nB; ++ui;
        if (wr == 1) PG8_BAR;
    }
    PG8_WAIT_V(0);
    PG8_BAR;
#undef PG8_SA
#undef PG8_SB
#undef PG8_STAGE
#undef PG8_LDA
#undef PG8_LDB
#undef PG8_MMA
#undef PG8_WAIT_V
#undef PG8_WAIT_L
#undef PG8_BAR
#undef PG8_SCHED
}
}
using pg8::Unit;
typedef f32x4 Acc[2][2][4][2];

struct Sched2 {
    int G, c; int nM0, nN0, nt0, nM1, nN1, nt1, ks1, pm1;
    const char* A0; const char* B0; const char* A1; const char* B1; size_t a_pm, b_pn;
    __device__ __forceinline__ bool next(int i, Unit& u) const {
        const int L = i * G + c, n0 = nM0 * nN0, n1 = nM1 * nN1 * ks1;
        if (L >= n0 + n1) return false;
        if (L < n0) { pg8::order_map(L, nM0, nN0, u.pm, u.pn); u.kind = 0; u.nt = nt0; u.ks = 0; u.A = A0 + (size_t)u.pm * a_pm; u.B = B0 + (size_t)u.pn * b_pn; }
        else { const int j = L - n0, ks = j % ks1, t = j / ks1; u.pm = pm1 + t % nM1; u.pn = t / nM1; u.kind = 1; u.nt = nt1; u.ks = ks;
               u.A = A1 + (size_t)u.pm * a_pm + (size_t)ks * nt1 * 128; u.B = B1 + (size_t)u.pn * b_pn + (size_t)ks * nt1 * 128; }
        return true;
    }
};

#define EPI_ROWS(...) _Pragma("unroll") for (int ai = 0; ai < 2; ++ai) _Pragma("unroll") for (int m = 0; m < 4; ++m) { const int row = u.pm * 256 + ai * 128 + wr * 64 + m * 16 + fr; \
    _Pragma("unroll") for (int bj = 0; bj < 2; ++bj) { const int col = u.pn * 256 + bj * 128 + wc * 32 + fq * 8; const f32x4 v0 = acc[ai][bj][m][0], v1 = acc[ai][bj][m][1]; __VA_ARGS__ } }

__device__ __forceinline__ u32x4 pack8(f32x4 v0, f32x4 v1) { u32x4 w; w.x = cvt_pk_bf16(v0[0], v0[1]); w.y = cvt_pk_bf16(v0[2], v0[3]); w.z = cvt_pk_bf16(v1[0], v1[1]); w.w = cvt_pk_bf16(v1[2], v1[3]); return w; }

struct EpiP1 {
    bf16_t* Z; float* outK; float* outV; bf16_t* KB; bf16_t* VT;
    __device__ __forceinline__ void operator()(Acc& acc, const Unit& u, int wr, int wc, int fr, int fq) const {
        if (u.kind == 0) {
            EPI_ROWS( *(u32x4*)(Z + (size_t)row * NZ + col) = pack8(v0, v1); )
        } else if (u.pn < 4) {
            EPI_ROWS( float* o = outK + (size_t)row * D + col; *(f32x4*)o = v0; *(f32x4*)(o + 4) = v1; *(u32x4*)(KB + (size_t)row * D + col) = pack8(v0, v1); )
        } else {
            EPI_ROWS( const int vc = col - 1024; float* o = outV + (size_t)row * D + vc; *(f32x4*)o = v0; *(f32x4*)(o + 4) = v1;
                      const int h = vc >> 8, d0 = vc & 255, key = row & 255; bf16_t* vt = VT + ((size_t)(u.pm * NH + h) * HD + d0) * NMEM + key;
                      const u32x4 w = pack8(v0, v1);
                      vt[0 * NMEM] = (bf16_t)(w.x & 0xffff); vt[1 * NMEM] = (bf16_t)(w.x >> 16); vt[2 * NMEM] = (bf16_t)(w.y & 0xffff); vt[3 * NMEM] = (bf16_t)(w.y >> 16);
                      vt[4 * NMEM] = (bf16_t)(w.z & 0xffff); vt[5 * NMEM] = (bf16_t)(w.z >> 16); vt[6 * NMEM] = (bf16_t)(w.w & 0xffff); vt[7 * NMEM] = (bf16_t)(w.w >> 16); )
        }
    }
};
struct EpiGlu {
    const bf16_t* YG; const float* bias; float* YS;
    __device__ __forceinline__ void operator()(Acc& acc, const Unit& u, int wr, int wc, int fr, int fq) const {
        EPI_ROWS( const u32x4 yw = *(const u32x4*)(YG + (size_t)row * MIX + col); const f32x4 b0 = *(const f32x4*)(bias + col), b1 = *(const f32x4*)(bias + col + 4);
                  f32x4 o0, o1;
                  o0[0] = bf_lo(yw.x) * sigmoidf(v0[0] + b0[0]); o0[1] = bf_hi(yw.x) * sigmoidf(v0[1] + b0[1]); o0[2] = bf_lo(yw.y) * sigmoidf(v0[2] + b0[2]); o0[3] = bf_hi(yw.y) * sigmoidf(v0[3] + b0[3]);
                  o1[0] = bf_lo(yw.z) * sigmoidf(v1[0] + b1[0]); o1[1] = bf_hi(yw.z) * sigmoidf(v1[1] + b1[1]); o1[2] = bf_lo(yw.w) * sigmoidf(v1[2] + b1[2]); o1[3] = bf_hi(yw.w) * sigmoidf(v1[3] + b1[3]);
                  float* o = YS + (size_t)row * MIX + col; *(f32x4*)o = o0; *(f32x4*)(o + 4) = o1; )
    }
};
struct EpiRes {
    const float* xp; float* X; float* PART; int first;
    __device__ __forceinline__ void operator()(Acc& acc, const Unit& u, int wr, int wc, int fr, int fq) const {
        if (u.kind == 0) {
            EPI_ROWS( const float* b = first ? xp + (size_t)row * D : (const float*)(X + (size_t)row * D);
                      const f32x4 r0 = *(const f32x4*)(b + col), r1 = *(const f32x4*)(b + col + 4);
                      float* o = X + (size_t)row * D + col; *(f32x4*)o = r0 + v0; *(f32x4*)(o + 4) = r1 + v1; )
        } else {
            EPI_ROWS( float* o = PART + ((size_t)u.ks * NS + (row - NP)) * D + col; *(f32x4*)o = v0; *(f32x4*)(o + 4) = v1; )
        }
    }
};
struct EpiQ {
    bf16_t* Q; float* PART;
    __device__ __forceinline__ void operator()(Acc& acc, const Unit& u, int wr, int wc, int fr, int fq) const {
        if (u.kind == 0) {
            EPI_ROWS( *(u32x4*)(Q + (size_t)row * D + col) = pack8(v0 * 0.0625f, v1 * 0.0625f); )
        } else {
            EPI_ROWS( float* o = PART + ((size_t)u.ks * NS + (row - NP)) * D + col; *(f32x4*)o = v0 * 0.0625f; *(f32x4*)(o + 4) = v1 * 0.0625f; )
        }
    }
};
struct EpiBf {
    bf16_t* O; int ld; float scale;
    __device__ __forceinline__ void operator()(Acc& acc, const Unit& u, int wr, int wc, int fr, int fq) const {
        EPI_ROWS( *(u32x4*)(O + (size_t)row * ld + col) = pack8(v0 * scale, v1 * scale); )
    }
};
struct EpiSoftmax {
    bf16_t* PR; LAS unsigned char* lds;
    __device__ __forceinline__ void operator()(Acc& acc, const Unit& u, int wr, int wc, int fr, int fq) const {
        LAS f32x2* X = (LAS f32x2*)(lds + XCH_OFF);
#pragma unroll
        for (int ai = 0; ai < 2; ++ai)
#pragma unroll
            for (int m = 0; m < 4; ++m) {
                float mx = -3.0e38f;
#pragma unroll
                for (int bj = 0; bj < 2; ++bj)
#pragma unroll
                    for (int n = 0; n < 2; ++n) { const f32x4 x = acc[ai][bj][m][n]; mx = fmaxf(mx, fmaxf(fmaxf(x[0], x[1]), fmaxf(x[2], x[3]))); }
                mx = fmaxf(mx, __shfl_xor(mx, 16)); mx = fmaxf(mx, __shfl_xor(mx, 32));
                float s = 0.f;
#pragma unroll
                for (int bj = 0; bj < 2; ++bj)
#pragma unroll
                    for (int n = 0; n < 2; ++n) { f32x4 x = acc[ai][bj][m][n];
                        x[0] = fast_exp(x[0] - mx); x[1] = fast_exp(x[1] - mx); x[2] = fast_exp(x[2] - mx); x[3] = fast_exp(x[3] - mx);
                        s += (x[0] + x[1]) + (x[2] + x[3]); acc[ai][bj][m][n] = x; }
                s += __shfl_xor(s, 16); s += __shfl_xor(s, 32);
                if (fq == 0) X[(ai * 128 + wr * 64 + m * 16 + fr) * 4 + wc] = (f32x2){mx, s};
            }
        asm volatile("s_waitcnt lgkmcnt(0)" ::: "memory"); __builtin_amdgcn_s_barrier(); asm volatile("" ::: "memory");
#pragma unroll
        for (int ai = 0; ai < 2; ++ai)
#pragma unroll
            for (int m = 0; m < 4; ++m) {
                const int rl = ai * 128 + wr * 64 + m * 16 + fr;
                const f32x2 a = X[rl * 4 + 0], b = X[rl * 4 + 1], c = X[rl * 4 + 2], d = X[rl * 4 + 3];
                const float M = fmaxf(fmaxf(a.x, b.x), fmaxf(c.x, d.x));
                const float tot = a.y * fast_exp(a.x - M) + b.y * fast_exp(b.x - M) + c.y * fast_exp(c.x - M) + d.y * fast_exp(d.x - M);
                const float own = wc == 0 ? a.x : (wc == 1 ? b.x : (wc == 2 ? c.x : d.x));
                const float f = fast_exp(own - M) / tot;
                bf16_t* prow = PR + ((size_t)(u.pm * NH + u.pn) * 256 + rl) * 256;
#pragma unroll
                for (int bj = 0; bj < 2; ++bj) { const int col = bj * 128 + wc * 32 + fq * 8; *(u32x4*)(prow + col) = pack8(acc[ai][bj][m][0] * f, acc[ai][bj][m][1] * f); }
                asm volatile("" ::: "memory");
            }
    }
};

#ifndef ONLY
#define ONLY -1
#endif
#define PH(k) (ONLY < 0 || ONLY == (k))
#define GSYNC() xcd_barrier(xb)
struct Args { const float* in[37]; float* out; unsigned char* ws; };

__device__ __forceinline__ void transpose_item(const float* W, int K, int N, bf16_t* WT, int row_off, LAS float* scr, int item, int lane) {
    const int nblk = N / 32, kb = item / nblk, nb = item % nblk, k0 = 64 * kb, n0 = 32 * nb;
#pragma unroll 8
    for (int i = 0; i < 32; ++i) { const int kk = 2 * i + (lane >> 5); scr[kk * 33 + (lane & 31)] = W[(size_t)(k0 + kk) * N + n0 + (lane & 31)]; }
    asm volatile("s_waitcnt lgkmcnt(0)" ::: "memory");
    const int c = lane & 7;
#pragma unroll
    for (int j = 0; j < 4; ++j) { const int n = (lane >> 3) + 8 * j; const LAS float* s = scr + (8 * c) * 33 + n;
        u32x4 o; o.x = cvt_pk_bf16(s[0 * 33], s[1 * 33]); o.y = cvt_pk_bf16(s[2 * 33], s[3 * 33]); o.z = cvt_pk_bf16(s[4 * 33], s[5 * 33]); o.w = cvt_pk_bf16(s[6 * 33], s[7 * 33]);
        *(u32x4*)(WT + (size_t)(row_off + n0 + n) * K + k0 + 8 * c) = o; }
    asm volatile("s_waitcnt lgkmcnt(0)" ::: "memory");
}

__device__ __forceinline__ void add_parts(float* xrow, const float* part, int nparts, size_t pstride, int lane) {
    f32x4* xr = (f32x4*)xrow + lane; f32x4 v[4];
#pragma unroll
    for (int j = 0; j < 4; ++j) v[j] = xr[64 * j];
    for (int k = 0; k < nparts; ++k) { const f32x4* pr = (const f32x4*)(part + (size_t)k * pstride) + lane;
#pragma unroll
        for (int j = 0; j < 4; ++j) v[j] += pr[64 * j]; }
#pragma unroll
    for (int j = 0; j < 4; ++j) xr[64 * j] = v[j];
}
__device__ __forceinline__ void rms_row_bf16(const float* xrow, const float* g, bf16_t* orow, int lane) {
    const f32x4* xr = (const f32x4*)xrow + lane; f32x4 v[4]; float s = 0.f;
#pragma unroll
    for (int j = 0; j < 4; ++j) { v[j] = xr[64 * j]; s += (v[j][0] * v[j][0] + v[j][1] * v[j][1]) + (v[j][2] * v[j][2] + v[j][3] * v[j][3]); }
    const float rstd = 1.0f / sqrtf(wave_sum(s) * (1.0f / D) + EPS);
    u32x2* o8 = (u32x2*)orow + lane;
#pragma unroll
    for (int j = 0; j < 4; ++j) { const f32x4 gg = ((const f32x4*)g)[lane + 64 * j]; u32x2 w; w.x = cvt_pk_bf16(v[j][0] * rstd * gg[0], v[j][1] * rstd * gg[1]); w.y = cvt_pk_bf16(v[j][2] * rstd * gg[2], v[j][3] * rstd * gg[3]); o8[64 * j] = w; }
}
__device__ __forceinline__ void rms_row_f32(const float* xrow, const float* g, float* orow, int lane) {
    const f32x4* xr = (const f32x4*)xrow + lane; f32x4 v[4]; float s = 0.f;
#pragma unroll
    for (int j = 0; j < 4; ++j) { v[j] = xr[64 * j]; s += (v[j][0] * v[j][0] + v[j][1] * v[j][1]) + (v[j][2] * v[j][2] + v[j][3] * v[j][3]); }
    const float rstd = 1.0f / sqrtf(wave_sum(s) * (1.0f / D) + EPS);
#pragma unroll
    for (int j = 0; j < 4; ++j) { const f32x4 gg = ((const f32x4*)g)[lane + 64 * j]; ((f32x4*)orow)[lane + 64 * j] = v[j] * rstd * gg; }
}

__device__ __forceinline__ float treduce16(float (&v)[16], int lane) {
    { const bool hi = lane & 32;
#pragma unroll
      for (int i = 0; i < 8; ++i) { const float send = hi ? v[i] : v[i + 8], keep = hi ? v[i + 8] : v[i]; v[i] = keep + __shfl_xor(send, 32); } }
    { const bool hi = lane & 16;
#pragma unroll
      for (int i = 0; i < 4; ++i) { const float send = hi ? v[i] : v[i + 4], keep = hi ? v[i + 4] : v[i]; v[i] = keep + __shfl_xor(send, 16); } }
    { const bool hi = lane & 8;
#pragma unroll
      for (int i = 0; i < 2; ++i) { const float send = hi ? v[i] : v[i + 2], keep = hi ? v[i + 2] : v[i]; v[i] = keep + __shfl_xor(send, 8); } }
    { const bool hi = lane & 4; const float send = hi ? v[0] : v[1], keep = hi ? v[1] : v[0]; v[0] = keep + __shfl_xor(send, 4); }
    v[0] += __shfl_xor(v[0], 2); v[0] += __shfl_xor(v[0], 1);
    return v[0];
}
template <int W> __device__ __forceinline__ void tr_step(float (&v)[64], int lane) {
    const bool hi = lane & W;
#pragma unroll
    for (int i = 0; i < W; ++i) { const float send = hi ? v[i] : v[i + W], keep = hi ? v[i + W] : v[i]; v[i] = keep + __shfl_xor(send, W); }
}
__device__ __forceinline__ float treduce64(float (&v)[64], int lane) {
    tr_step<32>(v, lane); tr_step<16>(v, lane); tr_step<8>(v, lane); tr_step<4>(v, lane); tr_step<2>(v, lane); tr_step<1>(v, lane);
    return v[0];
}

template <bool WITH_Y>
__device__ __forceinline__ void ssm_tile(const bf16_t* zu, int nsteps, float& sr, float& si, const float* BB, const float* AT, const float* Cre, const float* Cim, const float* Dv,
                                         int g, bf16_t* yg, int lane) {
    float Br[16], Bi[16];
    { const f32x4* bp = (const f32x4*)(BB + (size_t)(g * SN + lane) * 32);
#pragma unroll
      for (int j = 0; j < 4; ++j) { const f32x4 a = bp[j], b = bp[4 + j]; Br[4 * j] = a[0]; Br[4 * j + 1] = a[1]; Br[4 * j + 2] = a[2]; Br[4 * j + 3] = a[3]; Bi[4 * j] = b[0]; Bi[4 * j + 1] = b[1]; Bi[4 * j + 2] = b[2]; Bi[4 * j + 3] = b[3]; } }
    const f32x4 at = *(const f32x4*)(AT + (size_t)(g * SN + lane) * 4); const float ar = at[0], ai = at[1];
    float Cr[16], Ci[16], Dm[16];
    if (WITH_Y) {
#pragma unroll
        for (int p = 0; p < 16; ++p) { Cr[p] = Cre[(size_t)(g * SP + p) * SN + lane]; Ci[p] = Cim[(size_t)(g * SP + p) * SN + lane]; Dm[p] = (lane == 0) ? Dv[g * SP + p] : 0.f; }
    }
    u32x4 u0 = (u32x4){0, 0, 0, 0}, u1 = (u32x4){0, 0, 0, 0};
    if (lane < nsteps) { const u32x4* up = (const u32x4*)(zu + (size_t)lane * NZ); u0 = up[0]; u1 = up[1]; }
    const int p_own = ((lane >> 5) & 1) * 8 + ((lane >> 4) & 1) * 4 + ((lane >> 3) & 1) * 2 + ((lane >> 2) & 1);
    for (int t = 0; t < nsteps; ++t) {
        float uu[16];
        { unsigned w;
          w = __builtin_amdgcn_readlane(u0.x, t); uu[0] = bf_lo(w); uu[1] = bf_hi(w);
          w = __builtin_amdgcn_readlane(u0.y, t); uu[2] = bf_lo(w); uu[3] = bf_hi(w);
          w = __builtin_amdgcn_readlane(u0.z, t); uu[4] = bf_lo(w); uu[5] = bf_hi(w);
          w = __builtin_amdgcn_readlane(u0.w, t); uu[6] = bf_lo(w); uu[7] = bf_hi(w);
          w = __builtin_amdgcn_readlane(u1.x, t); uu[8] = bf_lo(w); uu[9] = bf_hi(w);
          w = __builtin_amdgcn_readlane(u1.y, t); uu[10] = bf_lo(w); uu[11] = bf_hi(w);
          w = __builtin_amdgcn_readlane(u1.z, t); uu[12] = bf_lo(w); uu[13] = bf_hi(w);
          w = __builtin_amdgcn_readlane(u1.w, t); uu[14] = bf_lo(w); uu[15] = bf_hi(w); }
        float br = 0.f, bi = 0.f;
#pragma unroll
        for (int p = 0; p < 16; ++p) { br = fmaf(Br[p], uu[p], br); bi = fmaf(Bi[p], uu[p], bi); }
        const float nr = ar * sr - ai * si + br, ni = ar * si + ai * sr + bi;
        sr = nr; si = ni;
        if (WITH_Y) {
            float v[16];
#pragma unroll
            for (int p = 0; p < 16; ++p) v[p] = fmaf(Dm[p], uu[p], Cr[p] * sr - Ci[p] * si);
            const float y = treduce16(v, lane);
            const float gy = gelu_tanh(y);
            if ((lane & 3) == 0) yg[(size_t)t * MIX + g * SP + p_own] = (bf16_t)(cvt_pk_bf16(gy, 0.f) & 0xffff);
        }
    }
}


#define XB_TMO      128
#define XB_XCNT(j)  (256  + 64 * (j))
#define XB_XSUB(j)  (1280 + 64 * (j))
#define XB_XGEN(j)  (2304 + 64 * (j))
#define XB_TOP      3328
#define XB_TOPGEN   3392
#define XCD_BAR_WORDS 3456
#define XB_SPIN_CAP (1u << 18)
__device__ __forceinline__ unsigned xb_ld(unsigned* p)              { return __hip_atomic_load(p, __ATOMIC_RELAXED, __HIP_MEMORY_SCOPE_AGENT); }
__device__ __forceinline__ unsigned xb_add(unsigned* p, unsigned v) { return __hip_atomic_fetch_add(p, v, __ATOMIC_RELAXED, __HIP_MEMORY_SCOPE_AGENT); }
__device__ __forceinline__ unsigned xb_xcc_id() { return (unsigned)__builtin_amdgcn_s_getreg((3 << 11) | 20) & 0xFu; }
#define XB_SPIN(cond, bar) do { unsigned _sp = 0; while (cond) { __builtin_amdgcn_s_sleep(1); \
    if ((++_sp & 255u) == 0u) { if (xb_ld(&(bar)[XB_TMO])) break; if (_sp > XB_SPIN_CAP) { atomicAdd(&(bar)[XB_TMO], 1u); break; } } } } while (0)
struct XcdBarrier { unsigned* bar; unsigned x; volatile LAS unsigned* st; };
__device__ __forceinline__ XcdBarrier xcd_barrier_post(unsigned* bar, volatile LAS unsigned* st) {
    XcdBarrier b; b.bar = bar; b.x = xb_xcc_id(); b.st = st;
    if (threadIdx.x == 0) (void)xb_add(&bar[XB_XCNT(b.x)], 1u);
    return b;
}
__device__ __forceinline__ void xcd_barrier_complete(unsigned* bar, unsigned x, unsigned& nloc, unsigned& nx) {
    const unsigned G = gridDim.x * gridDim.y * gridDim.z;
    unsigned sum, cnt, mine, sp = 0u;
    for (;;) {
        sum = 0u; cnt = 0u; mine = 0u;
#pragma unroll
        for (unsigned j = 0; j < 16; ++j) { const unsigned c = xb_ld(&bar[XB_XCNT(j)]); sum += c; cnt += (c > 0u) ? 1u : 0u; mine = (j == x) ? c : mine; }
        if (sum == G) break;
        __builtin_amdgcn_s_sleep(1);
        if ((++sp & 255u) == 0u) { if (xb_ld(&bar[XB_TMO])) break; if (sp > XB_SPIN_CAP) { atomicAdd(&bar[XB_TMO], 1u); break; } }
    }
    nloc = mine > 0u ? mine : 1u; nx = cnt > 0u ? cnt : 1u;
}
__device__ __forceinline__ void xcd_barrier(const XcdBarrier& b) {
    asm volatile("s_waitcnt vmcnt(0)" ::: "memory");
    __syncthreads();
    if (threadIdx.x == 0) {
        unsigned* bar = b.bar;
        __builtin_amdgcn_s_waitcnt(0);
        unsigned nloc = b.st[0], nx = b.st[1];
        if (nloc == 0u) { xcd_barrier_complete(bar, b.x, nloc, nx); b.st[0] = nloc; b.st[1] = nx; }
        const unsigned old = xb_add(&bar[XB_XSUB(b.x)], 1u);
        const unsigned gen = old / nloc;
        if (old + 1u == (gen + 1u) * nloc) {
            __builtin_amdgcn_fence(__ATOMIC_RELEASE, "agent");
            asm volatile("s_waitcnt vmcnt(0)" ::: "memory");
            const unsigned og = xb_add(&bar[XB_TOP], 1u);
            const unsigned tg = og / nx;
            if (og + 1u == (tg + 1u) * nx) xb_add(&bar[XB_TOPGEN], 1u);
            else XB_SPIN(xb_ld(&bar[XB_TOPGEN]) == tg, bar);
            __builtin_amdgcn_fence(__ATOMIC_ACQUIRE, "agent");
            xb_add(&bar[XB_XGEN(b.x)], 1u);
            asm volatile("s_waitcnt vmcnt(0)" ::: "memory");
        } else {
            XB_SPIN(xb_ld(&bar[XB_XGEN(b.x)]) == gen, bar);
            __builtin_amdgcn_fence(__ATOMIC_ACQUIRE, "agent");
            asm volatile("s_waitcnt vmcnt(0)" ::: "memory");
        }
    }
    __syncthreads();
}

__device__ __forceinline__ const float* ld_in(int k) {
    const __attribute__((address_space(4))) unsigned long long* t = (const __attribute__((address_space(4))) unsigned long long*)__builtin_amdgcn_kernarg_segment_ptr();
    asm volatile("" : "+s"(t));
    return (const float*)t[k];
}
__global__ void __launch_bounds__(NTHREADS, 2) hymba_fwd(Args args) {
    extern __shared__ __attribute__((aligned(16))) unsigned char lds_raw[];
    LAS unsigned char* lds = (LAS unsigned char*)lds_raw;
    cg::grid_group grid = cg::this_grid();
    const int tid = threadIdx.x, lane = tid & 63, wave = __builtin_amdgcn_readfirstlane(tid >> 6);
    const int G = gridDim.x, bx = blockIdx.x;
    const int gw = bx * NWAVES + wave, NGW = G * NWAVES;
#define IN(k) ld_in(k)
    unsigned char* ws = (unsigned char*)ld_in(38); float* out = (float*)ld_in(37);
    unsigned* barw = (unsigned*)(ws + WS_CTL);
    volatile LAS unsigned* bst = (volatile LAS unsigned*)(lds + XCH_OFF + 8192);
    if (bx == 0) for (int i = tid; i < XCD_BAR_WORDS; i += NTHREADS) barw[i] = 0u;
    if (tid < 2) bst[tid] = 0u;
    bf16_t* WIN = (bf16_t*)(ws + WS_WIN); bf16_t* WKV = (bf16_t*)(ws + WS_WKV); bf16_t* WGLU = (bf16_t*)(ws + WS_WGLU); bf16_t* WOUT = (bf16_t*)(ws + WS_WOUT);
    bf16_t* WQ = (bf16_t*)(ws + WS_WQ); bf16_t* WXO = (bf16_t*)(ws + WS_WXO); bf16_t* WUG = (bf16_t*)(ws + WS_WUG); bf16_t* WDN = (bf16_t*)(ws + WS_WDN);
    bf16_t* H = (bf16_t*)(ws + WS_H); float* X = (float*)(ws + WS_X);
    bf16_t* Z = (bf16_t*)(ws + WS_Z); bf16_t* YG = (bf16_t*)(ws + WS_YG); float* YS = (float*)(ws + WS_YS); bf16_t* MIXN = (bf16_t*)(ws + WS_MIXN);
    bf16_t* Q = (bf16_t*)(ws + WS_Q); bf16_t* PR = (bf16_t*)(ws + WS_PR); bf16_t* O = (bf16_t*)(ws + WS_O);
    bf16_t* MN = (bf16_t*)(ws + WS_MN); bf16_t* KB = (bf16_t*)(ws + WS_KB); bf16_t* VT = (bf16_t*)(ws + WS_VT);
    float* SE = (float*)(ws + WS_SE); float* SI = (float*)(ws + WS_SI); float* BB = (float*)(ws + WS_BB); float* AT = (float*)(ws + WS_AT);
    float* PART = (float*)(ws + WS_PART);
    bf16_t* UG = (bf16_t*)(ws + WS_UG); bf16_t* ACT = (bf16_t*)(ws + WS_ACT);

    if (PH(0)) {
        const float* x_prompt = IN(0); const float* x_sample = IN(1); const float* mem_prompt = IN(2); const float* norm_mix = IN(9); const float* w_in = IN(10);
        const float* A_re = IN(11); const float* A_im = IN(12); const float* log_dt = IN(13); const float* B_re = IN(14); const float* B_im = IN(15);
        const float* w_glu = IN(19); const float* w_out = IN(24); const float* norm_mem = IN(26); const float* w_q = IN(27); const float* w_k = IN(28); const float* w_v = IN(29); const float* w_xo = IN(30);
        const float* w_up = IN(32); const float* w_gate = IN(33); const float* w_down = IN(35);
        LAS float* scr = (LAS float*)(lds + wave * 16384);
        constexpr int I_IN = 16 * 64, I_D = 16 * 32, I_GLU = 8 * 16, I_UP = 16 * 88, I_DN = 44 * 32;
        constexpr int NITEMS = I_IN + 5 * I_D + I_GLU + 2 * I_UP + I_DN;
        for (int it = gw; it < NITEMS; it += NGW) {
            int r = it;
            if (r < I_IN) { transpose_item(w_in, D, NZ, WIN, 0, scr, r, lane); continue; } r -= I_IN;
            if (r < I_D) { transpose_item(w_k, D, D, WKV, 0, scr, r, lane); continue; } r -= I_D;
            if (r < I_D) { transpose_item(w_v, D, D, WKV, D, scr, r, lane); continue; } r -= I_D;
            if (r < I_D) { transpose_item(w_out, D, D, WOUT, 0, scr, r, lane); continue; } r -= I_D;
            if (r < I_D) { transpose_item(w_q, D, D, WQ, 0, scr, r, lane); continue; } r -= I_D;
            if (r < I_D) { transpose_item(w_xo, D, D, WXO, 0, scr, r, lane); continue; } r -= I_D;
            if (r < I_GLU) { transpose_item(w_glu, MIX, MIX, WGLU, 0, scr, r, lane); continue; } r -= I_GLU;
            if (r < I_UP) { transpose_item(w_up, D, DFF, WUG, 0, scr, r, lane); continue; } r -= I_UP;
            if (r < I_UP) { transpose_item(w_gate, D, DFF, WUG, DFF, scr, r, lane); continue; } r -= I_UP;
            transpose_item(w_down, DFF, D, WDN, 0, scr, r, lane);
        }
        for (int m = gw; m < MT; m += NGW) rms_row_bf16(m < NP ? x_prompt + (size_t)m * D : x_sample + (size_t)(m - NP) * D, norm_mix, H + (size_t)m * D, lane);
        for (int m = gw; m < BP * NMEM; m += NGW) rms_row_bf16(mem_prompt + (size_t)m * D, norm_mem, MN + (size_t)m * D, lane);
        for (size_t i = (size_t)bx * NTHREADS + tid; i < (size_t)NS * D / 4; i += (size_t)G * NTHREADS) { ((f32x4*)(X + (size_t)NP * D))[i] = ((const f32x4*)x_sample)[i]; }
        const int gt = bx * NTHREADS + tid;
        if (gt < SG * SN) {
            const int g = gt / SN;
            const float dt = expf(log_dt[g]), lr = A_re[gt], li = A_im[gt];
            const float mag = expf(dt * lr), ph = dt * li;
            double th = (double)ph * (1.0 / 1024.0), t2 = th * th;
            double c = 1.0 - t2 * (0.5 - t2 * (1.0 / 24.0 - t2 * (1.0 / 720.0)));
            double s = th * (1.0 - t2 * (1.0 / 6.0 - t2 * (1.0 / 120.0 - t2 * (1.0 / 5040.0))));
#pragma unroll 1
            for (int k = 0; k < 10; ++k) { const double c2 = c * c - s * s, s2 = 2.0 * c * s; c = c2; s = s2; }
            const float ar = mag * (float)c, ai = mag * (float)s;
            const float den = lr * lr + li * li;
            const float cr = ((ar - 1.0f) * lr + ai * li) / den, ci = (ai * lr - (ar - 1.0f) * li) / den;
#pragma unroll
            for (int p = 0; p < 16; ++p) { const float br = B_re[(size_t)gt * SP + p], bi = B_im[(size_t)gt * SP + p];
                BB[(size_t)gt * 32 + p] = cr * br - ci * bi; BB[(size_t)gt * 32 + 16 + p] = cr * bi + ci * br; }
            float pr = ar, pi = ai;
#pragma unroll 1
            for (int k = 0; k < 6; ++k) { const float r2 = pr * pr - pi * pi, i2 = 2.0f * pr * pi; pr = r2; pi = i2; }
            *(f32x4*)(AT + (size_t)gt * 4) = (f32x4){ar, ai, pr, pi};
        }
    }
    grid.sync();
    const XcdBarrier xb = xcd_barrier_post(barw, bst);

    if (PH(1)) {
        Sched2 S{G, bx, MT / 256, NZ / 256, 16, BP, 8, 16, 1, 0, (const char*)H, (const char*)WIN, (const char*)MN, (const char*)WKV, (size_t)256 * D * 2, (size_t)256 * D * 2};
        EpiP1 E{Z, out + O_MK, out + O_MV, KB, VT};
        pg8::gemm_phase(lds, D, D, S, E);
    }
    GSYNC();

    if (PH(2)) {
        const float* st_re = IN(5); const float* st_im = IN(6); const float* st_conv = IN(7); const float* C_re = IN(16); const float* C_im = IN(17); const float* Dssm = IN(18); const float* conv_w = IN(21); const float* norm_conv = IN(23);
        for (int task = gw; task < BP * SG * NCH; task += NGW) {
            const int c = task % NCH, g = (task / NCH) % SG, b = task / (NCH * SG);
            float sr = 0.f, si = 0.f;
            ssm_tile<false>(Z + (size_t)(b * TP + c * LCH) * NZ + g * SP, LCH, sr, si, BB, AT, C_re, C_im, Dssm, g, nullptr, lane);
            float* e = SE + ((size_t)(b * SG + g) * NCH + c) * 128; e[lane] = sr; e[64 + lane] = si;
        }
        for (int task = gw; task < BS * SG; task += NGW) {
            const int b = task % BS, g = task / BS;
            float sr = st_re[(size_t)(b * SG + g) * SN + lane], si = st_im[(size_t)(b * SG + g) * SN + lane];
            ssm_tile<true>(Z + (size_t)(NP + b * TS) * NZ + g * SP, TS, sr, si, BB, AT, C_re, C_im, Dssm, g, YG + (size_t)(NP + b * TS) * MIX, lane);
            out[O_SRS + (size_t)(b * SG + g) * SN + lane] = sr; out[O_SIS + (size_t)(b * SG + g) * SN + lane] = si;
        }
        for (int r = gw; r < MT; r += NGW) {
            int b, t; const float* prev; float* cout; int T;
            if (r < NP) { b = r / TP; t = r % TP; prev = nullptr; cout = out + O_CP + (size_t)b * 2 * MIX; T = TP; }
            else { const int rs = r - NP; b = rs / TS; t = rs % TS; prev = st_conv + (size_t)b * 2 * MIX; cout = out + O_CS + (size_t)b * 2 * MIX; T = TS; }
            const int c0 = lane * 8;
            float p[3][8];
#pragma unroll
            for (int k = 0; k < 3; ++k) {
                const int tt = t - k;
                if (tt >= 0) { const bf16_t* zr = Z + (size_t)(r - k) * NZ; const u32x4 xi = *(const u32x4*)(zr + MIX + c0), cgv = *(const u32x4*)(zr + 3 * MIX + c0);
                    p[k][0] = bf_lo(xi.x) * bf_lo(cgv.x); p[k][1] = bf_hi(xi.x) * bf_hi(cgv.x); p[k][2] = bf_lo(xi.y) * bf_lo(cgv.y); p[k][3] = bf_hi(xi.y) * bf_hi(cgv.y);
                    p[k][4] = bf_lo(xi.z) * bf_lo(cgv.z); p[k][5] = bf_hi(xi.z) * bf_hi(cgv.z); p[k][6] = bf_lo(xi.w) * bf_lo(cgv.w); p[k][7] = bf_hi(xi.w) * bf_hi(cgv.w); }
                else if (prev) { const float* pp = prev + (size_t)(2 + tt) * MIX + c0; const f32x4 a = *(const f32x4*)pp, bq = *(const f32x4*)(pp + 4);
                    p[k][0] = a[0]; p[k][1] = a[1]; p[k][2] = a[2]; p[k][3] = a[3]; p[k][4] = bq[0]; p[k][5] = bq[1]; p[k][6] = bq[2]; p[k][7] = bq[3]; }
                else {
#pragma unroll
                    for (int j = 0; j < 8; ++j) p[k][j] = 0.f; }
            }
            const u32x4 bgv = *(const u32x4*)(Z + (size_t)r * NZ + 2 * MIX + c0);
            float bg[8] = {bf_lo(bgv.x), bf_hi(bgv.x), bf_lo(bgv.y), bf_hi(bgv.y), bf_lo(bgv.z), bf_hi(bgv.z), bf_lo(bgv.w), bf_hi(bgv.w)};
            float y[8]; float ss = 0.f;
#pragma unroll
            for (int j = 0; j < 8; ++j) { const float w0 = conv_w[c0 + j], w1 = conv_w[MIX + c0 + j], w2 = conv_w[2 * MIX + c0 + j];
                y[j] = bg[j] * (w0 * p[2][j] + w1 * p[1][j] + w2 * p[0][j]); ss += y[j] * y[j]; }
            const float rstd = 1.0f / sqrtf(wave_sum(ss) * (1.0f / MIX) + EPS);
            const f32x4 g0 = *(const f32x4*)(norm_conv + c0), g1 = *(const f32x4*)(norm_conv + c0 + 4);
            u32x4 w; w.x = cvt_pk_bf16(y[0] * rstd * g0[0], y[1] * rstd * g0[1]); w.y = cvt_pk_bf16(y[2] * rstd * g0[2], y[3] * rstd * g0[3]);
            w.z = cvt_pk_bf16(y[4] * rstd * g1[0], y[5] * rstd * g1[1]); w.w = cvt_pk_bf16(y[6] * rstd * g1[2], y[7] * rstd * g1[3]);
            *(u32x4*)(MIXN + (size_t)r * D + MIX + c0) = w;
            if (t >= T - 2) { float* co = cout + (size_t)(t - (T - 2)) * MIX + c0; *(f32x4*)co = (f32x4){p[0][0], p[0][1], p[0][2], p[0][3]}; *(f32x4*)(co + 4) = (f32x4){p[0][4], p[0][5], p[0][6], p[0][7]}; }
        }
    }
    GSYNC();

    if (PH(3)) {
        for (int task = gw; task < BP * SG; task += NGW) {
            const int g = task % SG, b = task / SG;
            const f32x4 at = *(const f32x4*)(AT + (size_t)(g * SN + lane) * 4); const float aLr = at[2], aLi = at[3];
            float sr = 0.f, si = 0.f;
            for (int c = 0; c < NCH; ++c) {
                float* sip = SI + ((size_t)(b * SG + g) * NCH + c) * 128; sip[lane] = sr; sip[64 + lane] = si;
                const float* e = SE + ((size_t)(b * SG + g) * NCH + c) * 128; const float er = e[lane], ei = e[64 + lane];
                const float nr = aLr * sr - aLi * si + er, ni = aLr * si + aLi * sr + ei; sr = nr; si = ni;
            }
            out[O_SRP + (size_t)(b * SG + g) * SN + lane] = sr; out[O_SIP + (size_t)(b * SG + g) * SN + lane] = si;
        }
    }
    GSYNC();

    if (PH(4)) {
        const float* C_re = IN(16); const float* C_im = IN(17); const float* Dssm = IN(18);
        for (int task = gw; task < BP * SG * NCH; task += NGW) {
            const int c = task % NCH, g = (task / NCH) % SG, b = task / (NCH * SG);
            const float* sip = SI + ((size_t)(b * SG + g) * NCH + c) * 128; float sr = sip[lane], si = sip[64 + lane];
            ssm_tile<true>(Z + (size_t)(b * TP + c * LCH) * NZ + g * SP, LCH, sr, si, BB, AT, C_re, C_im, Dssm, g, YG + (size_t)(b * TP + c * LCH) * MIX, lane);
        }
    }
    GSYNC();

    if (PH(5)) {
        const float* b_glu = IN(20);
        Sched2 S{G, bx, MT / 256, MIX / 256, 8, 0, 0, 4, 1, 0, (const char*)YG, (const char*)WGLU, nullptr, nullptr, (size_t)256 * MIX * 2, (size_t)256 * MIX * 2};
        EpiGlu E{YG, b_glu, YS};
        pg8::gemm_phase(lds, MIX, MIX, S, E);
    }
    GSYNC();

    if (PH(6)) {
        const float* norm_ssm = IN(22);
        for (int r = gw; r < MT; r += NGW) {
            const f32x4* yr = (const f32x4*)(YS + (size_t)r * MIX) + lane; const f32x4 a = yr[0], b = yr[64];
            const float ss = (a[0] * a[0] + a[1] * a[1]) + (a[2] * a[2] + a[3] * a[3]) + (b[0] * b[0] + b[1] * b[1]) + (b[2] * b[2] + b[3] * b[3]);
            const float rstd = 1.0f / sqrtf(wave_sum(ss) * (1.0f / MIX) + EPS);
            const f32x4 ga = ((const f32x4*)norm_ssm)[lane], gb = ((const f32x4*)norm_ssm)[lane + 64];
            u32x2 w0, w1; w0.x = cvt_pk_bf16(a[0] * rstd * ga[0], a[1] * rstd * ga[1]); w0.y = cvt_pk_bf16(a[2] * rstd * ga[2], a[3] * rstd * ga[3]);
            w1.x = cvt_pk_bf16(b[0] * rstd * gb[0], b[1] * rstd * gb[1]); w1.y = cvt_pk_bf16(b[2] * rstd * gb[2], b[3] * rstd * gb[3]);
            u32x2* o8 = (u32x2*)(MIXN + (size_t)r * D) + lane; o8[0] = w0; o8[64] = w1;
        }
    }
    GSYNC();

    if (PH(7)) {
        const float* x_prompt = IN(0);
        Sched2 S{G, bx, NP / 256, D / 256, 16, NS / 256, D / 256, 4, 4, NP / 256, (const char*)MIXN, (const char*)WOUT, (const char*)MIXN, (const char*)WOUT, (size_t)256 * D * 2, (size_t)256 * D * 2};
        EpiRes E{x_prompt, X, PART, 1};
        pg8::gemm_phase(lds, D, D, S, E);
    }
    GSYNC();

    if (PH(8)) for (int m = gw; m < MT; m += NGW) { if (m >= NP) add_parts(X + (size_t)m * D, PART + (size_t)(m - NP) * D, 4, (size_t)NS * D, lane); rms_row_bf16(X + (size_t)m * D, IN(25), H + (size_t)m * D, lane); }
    GSYNC();

    if (PH(9)) {
        Sched2 S{G, bx, NP / 256, D / 256, 16, NS / 256, D / 256, 4, 4, NP / 256, (const char*)H, (const char*)WQ, (const char*)H, (const char*)WQ, (size_t)256 * D * 2, (size_t)256 * D * 2};
        EpiQ E{Q, PART};
        pg8::gemm_phase(lds, D, D, S, E);
    }
    GSYNC();

    if (PH(10)) {
        const float* cache_k = IN(3); const float* cache_v = IN(4);
        struct SchedQK { int G, c; const char* Q; const char* KB;
            __device__ __forceinline__ bool next(int i, Unit& u) const { const int L = i * G + c; if (L >= 64 * NH) return false; pg8::order_map(L, 64, NH, u.pm, u.pn); u.kind = 0; u.nt = 4; u.ks = 0;
                u.A = Q + ((size_t)u.pm * 256 * D + (size_t)u.pn * HD) * 2; u.B = KB + ((size_t)(u.pm >> 3) * NMEM * D + (size_t)u.pn * HD) * 2; return true; } };
        SchedQK S{G, bx, (const char*)Q, (const char*)KB};
        EpiSoftmax E{PR, lds};
#ifndef NO_QK
        pg8::gemm_phase(lds, D, D, S, E);
#endif

#ifndef NO_SATT
        LAS float* sc = (LAS float*)lds;
        LAS float* pr = (LAS float*)(lds + 4096);
        LAS float* po = (LAS float*)(lds + 8192);
        for (int unit = bx; unit < BS * NH; unit += G) {
            const int b = unit / NH, h = unit % NH;
            float q[4][4];
#pragma unroll
            for (int qi = 0; qi < 4; ++qi) { const float* qp = PART + (size_t)(b * TS + qi) * D + h * HD + 4 * lane; const f32x4 w = (*(const f32x4*)qp + *(const f32x4*)(qp + (size_t)NS * D)) + (*(const f32x4*)(qp + (size_t)2 * NS * D) + *(const f32x4*)(qp + (size_t)3 * NS * D)); q[qi][0] = w[0]; q[qi][1] = w[1]; q[qi][2] = w[2]; q[qi][3] = w[3]; }
            const float* kbase = cache_k + ((size_t)(b * NMEM) * NH + h) * HD + 4 * lane;
            const float* vbase = cache_v + ((size_t)(b * NMEM) * NH + h) * HD + 4 * lane;
#pragma unroll 1
            for (int blk = 0; blk < 2; ++blk) {
                const int key0 = wave * 32 + blk * 16;
                float v[64];
#pragma unroll
                for (int k = 0; k < 16; ++k) { const f32x4 kv = *(const f32x4*)(kbase + (size_t)(key0 + k) * NH * HD);
#pragma unroll
                    for (int qi = 0; qi < 4; ++qi) v[k * 4 + qi] = (kv[0] * q[qi][0] + kv[1] * q[qi][1]) + (kv[2] * q[qi][2] + kv[3] * q[qi][3]); }
                const float s = treduce64(v, lane);
                sc[(lane & 3) * 256 + key0 + (lane >> 2)] = s;
            }
            __syncthreads();
            {
                const int qi = lane & 3, kb = lane >> 2; float sv[16]; float mx = -3.0e38f;
#pragma unroll
                for (int j = 0; j < 16; ++j) { sv[j] = sc[qi * 256 + kb + 16 * j]; mx = fmaxf(mx, sv[j]); }
                mx = fmaxf(mx, __shfl_xor(mx, 4)); mx = fmaxf(mx, __shfl_xor(mx, 8)); mx = fmaxf(mx, __shfl_xor(mx, 16)); mx = fmaxf(mx, __shfl_xor(mx, 32));
                float sum = 0.f;
#pragma unroll
                for (int j = 0; j < 16; ++j) { sv[j] = fast_exp(sv[j] - mx); sum += sv[j]; }
                sum += __shfl_xor(sum, 4); sum += __shfl_xor(sum, 8); sum += __shfl_xor(sum, 16); sum += __shfl_xor(sum, 32);
                const float inv = 1.0f / sum;
                if (wave == 0) {
#pragma unroll
                    for (int j = 0; j < 16; ++j) pr[qi * 256 + kb + 16 * j] = sv[j] * inv; }
            }
            __syncthreads();
            {
                float o[4][4];
#pragma unroll
                for (int qi = 0; qi < 4; ++qi) { o[qi][0] = 0.f; o[qi][1] = 0.f; o[qi][2] = 0.f; o[qi][3] = 0.f; }
#pragma unroll 8
                for (int k = 0; k < 32; ++k) { const int key = wave * 32 + k; const f32x4 vv = *(const f32x4*)(vbase + (size_t)key * NH * HD);
#pragma unroll
                    for (int qi = 0; qi < 4; ++qi) { const float pp = pr[qi * 256 + key]; o[qi][0] = fmaf(pp, vv[0], o[qi][0]); o[qi][1] = fmaf(pp, vv[1], o[qi][1]); o[qi][2] = fmaf(pp, vv[2], o[qi][2]); o[qi][3] = fmaf(pp, vv[3], o[qi][3]); } }
#pragma unroll
                for (int qi = 0; qi < 4; ++qi) *(LAS f32x4*)(po + (wave * 4 + qi) * 256 + 4 * lane) = (f32x4){o[qi][0], o[qi][1], o[qi][2], o[qi][3]};
            }
            __syncthreads();
            {
                const int idx = tid * 2, qi = idx >> 8, d = idx & 255; float a0 = 0.f, a1 = 0.f;
#pragma unroll
                for (int w = 0; w < 8; ++w) { const f32x2 t2 = *(LAS f32x2*)(po + (w * 4 + qi) * 256 + d); a0 += t2[0]; a1 += t2[1]; }
                *(unsigned*)(O + (size_t)(NP + b * TS + qi) * D + h * HD + d) = cvt_pk_bf16(a0, a1);
            }
        }
#endif
    }
    GSYNC();

    if (PH(11)) {
        struct SchedPV { int G, c; const char* PR; const char* VT;
            __device__ __forceinline__ bool next(int i, Unit& u) const { const int L = i * G + c; if (L >= 64 * NH) return false; pg8::order_map(L, 64, NH, u.pm, u.pn); u.kind = 0; u.nt = 4; u.ks = 0;
                u.A = PR + (size_t)(u.pm * NH + u.pn) * 256 * 256 * 2; u.B = VT + (size_t)((u.pm >> 3) * NH + u.pn) * HD * NMEM * 2; return true; } };
        SchedPV S{G, bx, (const char*)PR, (const char*)VT};
        EpiBf E{O, D, 1.0f};
        pg8::gemm_phase(lds, NMEM, NMEM, S, E);
    }
    GSYNC();

    if (PH(12)) {
        Sched2 S{G, bx, NP / 256, D / 256, 16, NS / 256, D / 256, 4, 4, NP / 256, (const char*)O, (const char*)WXO, (const char*)O, (const char*)WXO, (size_t)256 * D * 2, (size_t)256 * D * 2};
        EpiRes E{nullptr, X, PART, 0};
        pg8::gemm_phase(lds, D, D, S, E);
    }
    GSYNC();

    if (PH(13)) for (int m = gw; m < MT; m += NGW) { if (m >= NP) add_parts(X + (size_t)m * D, PART + (size_t)(m - NP) * D, 4, (size_t)NS * D, lane); rms_row_bf16(X + (size_t)m * D, IN(31), H + (size_t)m * D, lane); }
    GSYNC();

    if (PH(14)) {
        Sched2 S{G, bx, MT / 256, NUG / 256, 16, 0, 0, 4, 1, 0, (const char*)H, (const char*)WUG, nullptr, nullptr, (size_t)256 * D * 2, (size_t)256 * D * 2};
        EpiBf E{UG, NUG, 1.0f};
        pg8::gemm_phase(lds, D, D, S, E);
    }
    GSYNC();

    if (PH(15)) {
        const float* st_ffn = IN(8); const float* ffn_conv_w = IN(34);
        constexpr int NV = DFF / 8;
        const size_t total = (size_t)MT * NV;
        for (size_t idx = (size_t)bx * NTHREADS + tid; idx < total; idx += (size_t)G * NTHREADS) {
            const int r = (int)(idx / NV), c0 = (int)(idx % NV) * 8;
            int b, t, T; const float* prev; float* fout;
            if (r < NP) { b = r / TP; t = r % TP; prev = nullptr; fout = out + O_FP + (size_t)b * 2 * DFF; T = TP; }
            else { const int rs = r - NP; b = rs / TS; t = rs % TS; prev = st_ffn + (size_t)b * 2 * DFF; fout = out + O_FS + (size_t)b * 2 * DFF; T = TS; }
            float p[3][8];
#pragma unroll
            for (int k = 0; k < 3; ++k) {
                const int tt = t - k;
                if (tt >= 0) { const u32x4 uw = *(const u32x4*)(UG + (size_t)(r - k) * NUG + c0);
                    p[k][0] = bf_lo(uw.x); p[k][1] = bf_hi(uw.x); p[k][2] = bf_lo(uw.y); p[k][3] = bf_hi(uw.y); p[k][4] = bf_lo(uw.z); p[k][5] = bf_hi(uw.z); p[k][6] = bf_lo(uw.w); p[k][7] = bf_hi(uw.w); }
                else if (prev) { const float* pp = prev + (size_t)(2 + tt) * DFF + c0; const f32x4 a = *(const f32x4*)pp, bq = *(const f32x4*)(pp + 4);
                    p[k][0] = a[0]; p[k][1] = a[1]; p[k][2] = a[2]; p[k][3] = a[3]; p[k][4] = bq[0]; p[k][5] = bq[1]; p[k][6] = bq[2]; p[k][7] = bq[3]; }
                else {
#pragma unroll
                    for (int j = 0; j < 8; ++j) p[k][j] = 0.f; }
            }
            const u32x4 gw4 = *(const u32x4*)(UG + (size_t)r * NUG + DFF + c0);
            const float gt8[8] = {bf_lo(gw4.x), bf_hi(gw4.x), bf_lo(gw4.y), bf_hi(gw4.y), bf_lo(gw4.z), bf_hi(gw4.z), bf_lo(gw4.w), bf_hi(gw4.w)};
            float a8[8];
#pragma unroll
            for (int j = 0; j < 8; ++j) { const float w0 = ffn_conv_w[c0 + j], w1 = ffn_conv_w[DFF + c0 + j], w2 = ffn_conv_w[2 * DFF + c0 + j];
                a8[j] = gelu_tanh(w0 * p[2][j] + w1 * p[1][j] + w2 * p[0][j]) * gt8[j]; }
            u32x4 w; w.x = cvt_pk_bf16(a8[0], a8[1]); w.y = cvt_pk_bf16(a8[2], a8[3]); w.z = cvt_pk_bf16(a8[4], a8[5]); w.w = cvt_pk_bf16(a8[6], a8[7]);
            *(u32x4*)(ACT + (size_t)r * DFF + c0) = w;
            if (t >= T - 2) { float* fo = fout + (size_t)(t - (T - 2)) * DFF + c0; *(f32x4*)fo = (f32x4){p[0][0], p[0][1], p[0][2], p[0][3]}; *(f32x4*)(fo + 4) = (f32x4){p[0][4], p[0][5], p[0][6], p[0][7]}; }
        }
    }
    GSYNC();

    if (PH(16)) {
        Sched2 S{G, bx, NP / 256, D / 256, DFF / 64, NS / 256, D / 256, 4, DFF / 256, NP / 256, (const char*)ACT, (const char*)WDN, (const char*)ACT, (const char*)WDN, (size_t)256 * DFF * 2, (size_t)256 * DFF * 2};
        EpiRes E{nullptr, X, PART, 0};
        pg8::gemm_phase(lds, DFF, DFF, S, E);
    }
    GSYNC();

    if (PH(17)) for (int m = gw; m < MT; m += NGW) { if (m >= NP) add_parts(X + (size_t)m * D, PART + (size_t)(m - NP) * D, DFF / 256, (size_t)NS * D, lane); rms_row_f32(X + (size_t)m * D, IN(36), out + (size_t)m * D, lane); }
}

extern "C" void kernel_launch(void* const* d_in, const int* in_sizes, int n_in, void* d_out, int out_size, void* d_ws, size_t ws_size, hipStream_t stream) {
    static int grid = 0;
    if (grid == 0) {
        if (n_in != 37 || (size_t)out_size != O_END || ws_size < WS_END) { fprintf(stderr, "kernel_launch: unexpected sizes n_in %d out %d ws %zu\n", n_in, out_size, ws_size); grid = -1; return; }
        int dev = 0, cus = 0, per_cu = 0;
        (void)hipGetDevice(&dev); (void)hipDeviceGetAttribute(&cus, hipDeviceAttributeMultiprocessorCount, dev);
        (void)hipFuncSetAttribute((const void*)hymba_fwd, hipFuncAttributeMaxDynamicSharedMemorySize, LDS_BYTES);
        (void)hipOccupancyMaxActiveBlocksPerMultiprocessor(&per_cu, (const void*)hymba_fwd, NTHREADS, LDS_BYTES);
        if (per_cu < 1) { fprintf(stderr, "kernel_launch: occupancy query reports %d blocks per CU\n", per_cu); per_cu = 1; }
        (void)hipGetLastError();
        grid = cus;
        if (grid % 8) grid -= grid % 8;
    }
    if (grid < 0) return;
    Args a{};
    for (int i = 0; i < 37; ++i) a.in[i] = (const float*)d_in[i];
    a.out = (float*)d_out; a.ws = (unsigned char*)d_ws;
    void* kargs[] = {&a};
    hipError_t e = hipLaunchCooperativeKernel((const void*)hymba_fwd, dim3(grid), dim3(NTHREADS), kargs, LDS_BYTES, stream);
    if (e != hipSuccess) fprintf(stderr, "cooperative launch failed: %s (grid %d)\n", hipGetErrorString(e), grid);
}
```

```cpp
#include <hip/hip_runtime.h>
#include <hip/hip_cooperative_groups.h>
#include <cstdio>
#include <cstdint>
namespace cg = cooperative_groups;

#define LAS __attribute__((address_space(3)))
typedef unsigned short bf16_t;
typedef short bf16x8 __attribute__((ext_vector_type(8)));
typedef float f32x4 __attribute__((ext_vector_type(4)));
typedef float f32x2 __attribute__((ext_vector_type(2)));
typedef unsigned u32x4 __attribute__((ext_vector_type(4)));
typedef unsigned u32x2 __attribute__((ext_vector_type(2)));

constexpr int D = 1024, NP = 16384, NS = 512, MT = NP + NS;
constexpr int TP = 2048, TS = 4, BP = 8, BS = 128;
constexpr int NZ = 2048, MIX = 512, DFF = 2816, NUG = 2 * DFF;
constexpr int SG = 32, SP = 16, SN = 64, LCH = 64, NCH = TP / LCH;
constexpr int NMEM = 256, NH = 4, HD = 256;
constexpr float EPS = 1e-6f;
constexpr int NWAVES = 8, NTHREADS = 512;

constexpr size_t MiB = 1u << 20;
constexpr size_t WS_WIN = 0;
constexpr size_t WS_WKV = WS_WIN + 4 * MiB;
constexpr size_t WS_WGLU = WS_WKV + 4 * MiB;
constexpr size_t WS_WOUT = WS_WGLU + 1 * MiB;
constexpr size_t WS_WQ = WS_WOUT + 2 * MiB;
constexpr size_t WS_WXO = WS_WQ + 2 * MiB;
constexpr size_t WS_WUG = WS_WXO + 2 * MiB;
constexpr size_t WS_WDN = WS_WUG + 11 * MiB;
constexpr size_t WS_H = WS_WDN + 6 * MiB;
constexpr size_t WS_X = WS_H + 33 * MiB;
constexpr size_t WS_OV = WS_X + 66 * MiB;
constexpr size_t WS_Z = WS_OV;
constexpr size_t WS_YG = WS_Z + 66 * MiB;
constexpr size_t WS_YS = WS_YG + 17 * MiB;
constexpr size_t WS_MIXN = WS_YS + 33 * MiB;
constexpr size_t WS_Q = WS_MIXN + 33 * MiB;
constexpr size_t WS_PR = WS_Q + 33 * MiB;
constexpr size_t WS_O = WS_PR + 32 * MiB;
constexpr size_t WS_MN = WS_O + 33 * MiB;
constexpr size_t WS_KB = WS_MN + 4 * MiB;
constexpr size_t WS_VT = WS_KB + 4 * MiB;
constexpr size_t WS_SE = WS_VT + 4 * MiB;
constexpr size_t WS_SI = WS_SE + 4 * MiB;
constexpr size_t WS_BB = WS_SI + 4 * MiB;
constexpr size_t WS_AT = WS_BB + 1 * MiB;
constexpr size_t WS_BTR = WS_AT + 1 * MiB;
constexpr size_t WS_BTI = WS_BTR + 65536;
constexpr size_t WS_CT = WS_BTI + 65536;
constexpr size_t WS_OV_END1 = WS_CT + 131072;
constexpr size_t WS_UG = WS_OV;
constexpr size_t WS_ACT = WS_UG + 182 * MiB;
constexpr size_t WS_CTL = WS_ACT + 91 * MiB;
constexpr size_t WS_PART = WS_CTL + 1 * MiB;
constexpr size_t WS_END = WS_PART + 22 * MiB;
static_assert(WS_OV_END1 <= WS_CTL, "overlay");
static_assert(WS_END <= 512 * MiB, "workspace");

constexpr size_t O_YP = 0;
constexpr size_t O_YS = O_YP + (size_t)NP * D;
constexpr size_t O_MK = O_YS + (size_t)NS * D;
constexpr size_t O_MV = O_MK + (size_t)BP * NMEM * D;
constexpr size_t O_SRP = O_MV + (size_t)BP * NMEM * D;
constexpr size_t O_SIP = O_SRP + (size_t)BP * SG * SN;
constexpr size_t O_CP = O_SIP + (size_t)BP * SG * SN;
constexpr size_t O_FP = O_CP + (size_t)BP * 2 * MIX;
constexpr size_t O_SRS = O_FP + (size_t)BP * 2 * DFF;
constexpr size_t O_SIS = O_SRS + (size_t)BS * SG * SN;
constexpr size_t O_CS = O_SIS + (size_t)BS * SG * SN;
constexpr size_t O_FS = O_CS + (size_t)BS * 2 * MIX;
constexpr size_t O_END = O_FS + (size_t)BS * 2 * DFF;

constexpr int RING_BYTES = 131072, XCH_OFF = RING_BYTES, LDS_BYTES = 147456;

typedef __bf16 bf16x2_t __attribute__((ext_vector_type(2)));
__device__ __forceinline__ unsigned cvt_pk_bf16(float lo, float hi) { const f32x2 v = {lo, hi}; const bf16x2_t b = __builtin_convertvector(v, bf16x2_t); return __builtin_bit_cast(unsigned, b); }
__device__ __forceinline__ float bf_lo(unsigned w) { return __uint_as_float(w << 16); }
__device__ __forceinline__ float bf_hi(unsigned w) { return __uint_as_float(w & 0xffff0000u); }
__device__ __forceinline__ float wave_sum(float v) {
#pragma unroll
    for (int o = 1; o < 64; o <<= 1) v += __shfl_xor(v, o);
    return v;
}
__device__ __forceinline__ float fast_exp(float x) { return __builtin_amdgcn_exp2f(x * 1.4426950408889634f); }
__device__ __forceinline__ float gelu_tanh(float x) {
    const float z = 0.7978845608028654f * (x + 0.044715f * x * x * x);
    return x * __builtin_amdgcn_rcpf(1.0f + fast_exp(-2.0f * z));
}
__device__ __forceinline__ float sigmoidf(float a) { return __builtin_amdgcn_rcpf(1.0f + fast_exp(-a)); }

namespace pg8 {
constexpr int BM = 256, BK = 64, HALF = 128, HTB = HALF * BK * 2;
__host__ __device__ __forceinline__ int lds_byte(int r, int c) { const int st = (r >> 4) * 2 + (c >> 5), rr = r & 15, cc = c & 31, ob = rr * 64 + cc * 2; return st * 1024 + (ob ^ (((ob >> 9) & 1) << 5)); }
__host__ __device__ __forceinline__ void stage_rc(int b, int& R, int& C) { const int st = b / 1024, sb = b % 1024, swz = sb ^ (((sb >> 9) & 1) << 5); R = (st >> 1) * 16 + swz / 64; C = (st & 1) * 32 + (swz % 64) / 2; }
__host__ __device__ __forceinline__ int perm32(int rho) { const int n = rho >> 4, i = rho & 15; return 8 * (i >> 2) + 4 * n + (i & 3); }

struct Unit { int pm, pn, kind, nt, ks; const char* A; const char* B; };

__device__ __forceinline__ void order_map(int L, int nM, int nN, int& pm, int& pn) {
    const int nwg = nM * nN; int wgid = L;
    { const int q = nwg / 8, r = nwg % 8, xcd = wgid % 8, off = wgid / 8; wgid = (xcd < r ? xcd * (q + 1) : r * (q + 1) + (xcd - r) * q) + off; }
    const int nig = 8 * nN, gid = wgid / nig, fm = gid * 8, gsz = (nM - fm) < 8 ? (nM - fm) : 8;
    pm = fm + ((wgid % nig) % gsz); pn = (wgid % nig) / gsz;
}

template <class Epi, class Sched>
__device__ __forceinline__ void gemm_phase(LAS unsigned char* lds, const int lda, const int ldb, const Sched& S, Epi& E) {
    int tid_l = threadIdx.x; asm volatile("" : "+v"(tid_l));
    const int tid = tid_l, wid = __builtin_amdgcn_readfirstlane(tid >> 6), lane = tid & 63, wr = wid >> 2, wc = wid & 3, fr = lane & 15, fq = lane >> 4;
    unsigned voffA[2], voffB[2];
#pragma unroll
    for (int i = 0; i < 2; ++i) { int R, C; stage_rc(tid * 16 + i * 8192, R, C); const int Rb = (R & ~31) + perm32(R & 31);
        voffA[i] = (unsigned)(R * lda + C) * 2u; voffB[i] = (unsigned)(Rb * ldb + C) * 2u; }
    const size_t kstep = (size_t)(BK * 2);
    const size_t hstepA = (size_t)HALF * lda * 2, hstepB = (size_t)HALF * ldb * 2;
    const unsigned ldsw = (unsigned)wid * 1024u;
    const int aoff = lds_byte(wr * 64 + fr, fq * 8), boff = lds_byte(wc * 32 + fr, fq * 8);
#define PG8_SA(b, h) (((b) * 2 + (h)) * HTB)
#define PG8_SB(b, h) ((4 + (b) * 2 + (h)) * HTB)
#define PG8_STAGE(bufoff, gbase, voff) do { _Pragma("unroll") for (int _i = 0; _i < 2; ++_i) \
        __builtin_amdgcn_global_load_lds((const unsigned*)((const char*)(gbase) + (voff)[_i]), (LAS unsigned*)(lds + (bufoff) + ldsw + _i * 8192), 16, 0, 0); } while (0)
#define PG8_LDA(dst, b, h) do { _Pragma("unroll") for (int m = 0; m < 4; ++m) _Pragma("unroll") for (int k = 0; k < 2; ++k) dst[m][k] = *(const LAS bf16x8*)(lds + PG8_SA(b, h) + aoff + m * 2048 + k * 1024); } while (0)
#define PG8_LDB(dst, b, h) do { _Pragma("unroll") for (int n = 0; n < 2; ++n) _Pragma("unroll") for (int k = 0; k < 2; ++k) dst[n][k] = *(const LAS bf16x8*)(lds + PG8_SB(b, h) + boff + n * 2048 + k * 1024); } while (0)
#define PG8_MMA(ai, bj, At, Bt) do { __builtin_amdgcn_s_setprio(1); _Pragma("unroll") for (int m = 0; m < 4; ++m) _Pragma("unroll") for (int n = 0; n < 2; ++n) _Pragma("unroll") for (int k = 0; k < 2; ++k) \
        acc[ai][bj][m][n] = __builtin_amdgcn_mfma_f32_16x16x32_bf16(Bt[n][k], At[m][k], acc[ai][bj][m][n], 0, 0, 0); __builtin_amdgcn_s_setprio(0); } while (0)
#define PG8_WAIT_V(n) asm volatile("s_waitcnt vmcnt(" #n ")" ::: "memory")
#define PG8_WAIT_L(n) asm volatile("s_waitcnt lgkmcnt(" #n ")" ::: "memory")
#define PG8_BAR __builtin_amdgcn_s_barrier()
#define PG8_SCHED __builtin_amdgcn_sched_barrier(0)
    Unit cur, nxt; int ui = 0;
    if (!S.next(0, cur)) return;
    f32x4 acc[2][2][4][2];
#pragma unroll
    for (int a = 0; a < 2; ++a)
#pragma unroll
        for (int b = 0; b < 2; ++b)
#pragma unroll
            for (int m = 0; m < 4; ++m)
#pragma unroll
                for (int n = 0; n < 2; ++n) acc[a][b][m][n] = (f32x4){0.f, 0.f, 0.f, 0.f};
    bf16x8 At[4][2], B0[2][2], B1[2][2];
    const char* cA = cur.A; const char* cB = cur.B;
    PG8_STAGE(PG8_SB(0, 0), cB, voffB); PG8_STAGE(PG8_SB(0, 1), cB + hstepB, voffB); PG8_STAGE(PG8_SA(0, 0), cA, voffA); PG8_STAGE(PG8_SA(0, 1), cA + hstepA, voffA);
    if (wr == 1) PG8_BAR;
    PG8_WAIT_V(2); PG8_BAR;
    PG8_STAGE(PG8_SB(1, 0), cB + kstep, voffB); PG8_STAGE(PG8_SA(1, 0), cA + kstep, voffA); PG8_STAGE(PG8_SB(1, 1), cB + hstepB + kstep, voffB);
    PG8_WAIT_V(6); PG8_BAR;
    for (;;) {
        const bool has_next = S.next(ui + 1, nxt);
        const char* nA = has_next ? nxt.A : cA; const char* nB = has_next ? nxt.B : cB;
        const int nt = cur.nt;
#pragma unroll 1
        for (int t = 0; t < nt; t += 2) {
            const bool last = (t == nt - 2);
            const char* a1 = cA + (size_t)(t + 1) * kstep;
            const char* a2 = last ? nA : cA + (size_t)(t + 2) * kstep; const char* b2 = last ? nB : cB + (size_t)(t + 2) * kstep;
            const char* a3 = a2 + kstep; const char* b3 = b2 + kstep;
            PG8_LDB(B0, 0, 0); PG8_LDB(B1, 0, 1); PG8_SCHED; PG8_LDA(At, 0, 0); PG8_STAGE(PG8_SA(1, 1), a1 + hstepA, voffA);
            PG8_WAIT_V(8); PG8_WAIT_L(0); PG8_BAR; PG8_MMA(0, 0, At, B0); PG8_MMA(0, 1, At, B1); PG8_BAR; PG8_SCHED;
            PG8_LDA(At, 0, 1); PG8_STAGE(PG8_SB(0, 0), b2, voffB); PG8_STAGE(PG8_SB(0, 1), b2 + hstepB, voffB); PG8_STAGE(PG8_SA(0, 0), a2, voffA);
            PG8_WAIT_V(8); PG8_WAIT_L(0); PG8_BAR; PG8_MMA(1, 0, At, B0); PG8_MMA(1, 1, At, B1); PG8_BAR; PG8_SCHED;
            PG8_LDB(B0, 1, 0); PG8_LDB(B1, 1, 1); PG8_SCHED; PG8_LDA(At, 1, 0); PG8_STAGE(PG8_SA(0, 1), a2 + hstepA, voffA);
            PG8_WAIT_V(8); PG8_WAIT_L(0); PG8_BAR; PG8_MMA(0, 0, At, B0); PG8_MMA(0, 1, At, B1); PG8_BAR; PG8_SCHED;
            PG8_LDA(At, 1, 1); PG8_STAGE(PG8_SB(1, 0), b3, voffB); PG8_STAGE(PG8_SB(1, 1), b3 + hstepB, voffB); PG8_STAGE(PG8_SA(1, 0), a3, voffA);
            PG8_WAIT_V(8); PG8_WAIT_L(0); PG8_BAR; PG8_MMA(1, 0, At, B0); PG8_MMA(1, 1, At, B1); PG8_BAR; PG8_SCHED;
        }
        if (wr == 0) PG8_BAR;
        E(acc, cur, wr, wc, fr, fq);
        if (!has_next) break;
#pragma unroll
        for (int a = 0; a < 2; ++a)
#pragma unroll
            for (int b = 0; b < 2; ++b)
#pragma unroll
                for (int m = 0; m < 4; ++m)
#pragma unroll
                    for (int n = 0; n < 2; ++n) acc[a][b][m][n] = (f32x4){0.f, 0.f, 0.f, 0.f};
        cur = nxt; cA = nA; cB = nB; ++ui;
        if (wr == 1) PG8_BAR;
    }
    PG8_WAIT_V(0);
    PG8_BAR;
#undef PG8_SA
#undef PG8_SB
#undef PG8_STAGE
#undef PG8_LDA
#undef PG8_LDB
#undef PG8_MMA
#undef PG8_WAIT_V
#undef PG8_WAIT_L
#undef PG8_BAR
#undef PG8_SCHED
}
}
using pg8::Unit;
typedef f32x4 Acc[2][2][4][2];

struct Sched2 {
    int G, c; int nM0, nN0, nt0, nM1, nN1, nt1, ks1, pm1;
    const char* A0; const char* B0; const char* A1; const char* B1; size_t a_pm, b_pn;
    __device__ __forceinline__ bool next(int i, Unit& u) const {
        const int L = i * G + c, n0 = nM0 * nN0, n1 = nM1 * nN1 * ks1;
        if (L >= n0 + n1) return false;
        if (L < n0) { pg8::order_map(L, nM0, nN0, u.pm, u.pn); u.kind = 0; u.nt = nt0; u.ks = 0; u.A = A0 + (size_t)u.pm * a_pm; u.B = B0 + (size_t)u.pn * b_pn; }
        else { const int j = L - n0, ks = j % ks1, t = j / ks1; u.pm = pm1 + t % nM1; u.pn = t / nM1; u.kind = 1; u.nt = nt1; u.ks = ks;
               u.A = A1 + (size_t)u.pm * a_pm + (size_t)ks * nt1 * 128; u.B = B1 + (size_t)u.pn * b_pn + (size_t)ks * nt1 * 128; }
        return true;
    }
};

#define EPI_ROWS(...) _Pragma("unroll") for (int ai = 0; ai < 2; ++ai) _Pragma("unroll") for (int m = 0; m < 4; ++m) { const int row = u.pm * 256 + ai * 128 + wr * 64 + m * 16 + fr; \
    _Pragma("unroll") for (int bj = 0; bj < 2; ++bj) { const int col = u.pn * 256 + bj * 128 + wc * 32 + fq * 8; const f32x4 v0 = acc[ai][bj][m][0], v1 = acc[ai][bj][m][1]; __VA_ARGS__ } }

__device__ __forceinline__ u32x4 pack8(f32x4 v0, f32x4 v1) { u32x4 w; w.x = cvt_pk_bf16(v0[0], v0[1]); w.y = cvt_pk_bf16(v0[2], v0[3]); w.z = cvt_pk_bf16(v1[0], v1[1]); w.w = cvt_pk_bf16(v1[2], v1[3]); return w; }

struct EpiP1 {
    bf16_t* Z; float* outK; float* outV; bf16_t* KB; bf16_t* VT;
    __device__ __forceinline__ void operator()(Acc& acc, const Unit& u, int wr, int wc, int fr, int fq) const {
        if (u.kind == 0) {
            EPI_ROWS( *(u32x4*)(Z + (size_t)row * NZ + col) = pack8(v0, v1); )
        } else if (u.pn < 4) {
            EPI_ROWS( float* o = outK + (size_t)row * D + col; *(f32x4*)o = v0; *(f32x4*)(o + 4) = v1; *(u32x4*)(KB + (size_t)row * D + col) = pack8(v0, v1); )
        } else {
            EPI_ROWS( const int vc = col - 1024; float* o = outV + (size_t)row * D + vc; *(f32x4*)o = v0; *(f32x4*)(o + 4) = v1;
                      const int h = vc >> 8, d0 = vc & 255, key = row & 255; bf16_t* vt = VT + ((size_t)(u.pm * NH + h) * HD + d0) * NMEM + key;
                      const u32x4 w = pack8(v0, v1);
                      vt[0 * NMEM] = (bf16_t)(w.x & 0xffff); vt[1 * NMEM] = (bf16_t)(w.x >> 16); vt[2 * NMEM] = (bf16_t)(w.y & 0xffff); vt[3 * NMEM] = (bf16_t)(w.y >> 16);
                      vt[4 * NMEM] = (bf16_t)(w.z & 0xffff); vt[5 * NMEM] = (bf16_t)(w.z >> 16); vt[6 * NMEM] = (bf16_t)(w.w & 0xffff); vt[7 * NMEM] = (bf16_t)(w.w >> 16); )
        }
    }
};
struct EpiGlu {
    const bf16_t* YG; const float* bias; float* YS;
    __device__ __forceinline__ void operator()(Acc& acc, const Unit& u, int wr, int wc, int fr, int fq) const {
        EPI_ROWS( const u32x4 yw = *(const u32x4*)(YG + (size_t)row * MIX + col); const f32x4 b0 = *(const f32x4*)(bias + col), b1 = *(const f32x4*)(bias + col + 4);
                  f32x4 o0, o1;
                  o0[0] = bf_lo(yw.x) * sigmoidf(v0[0] + b0[0]); o0[1] = bf_hi(yw.x) * sigmoidf(v0[1] + b0[1]); o0[2] = bf_lo(yw.y) * sigmoidf(v0[2] + b0[2]); o0[3] = bf_hi(yw.y) * sigmoidf(v0[3] + b0[3]);
                  o1[0] = bf_lo(yw.z) * sigmoidf(v1[0] + b1[0]); o1[1] = bf_hi(yw.z) * sigmoidf(v1[1] + b1[1]); o1[2] = bf_lo(yw.w) * sigmoidf(v1[2] + b1[2]); o1[3] = bf_hi(yw.w) * sigmoidf(v1[3] + b1[3]);
                  float* o = YS + (size_t)row * MIX + col; *(f32x4*)o = o0; *(f32x4*)(o + 4) = o1; )
    }
};
struct EpiRes {
    const float* xp; float* X; float* PART; int first;
    __device__ __forceinline__ void operator()(Acc& acc, const Unit& u, int wr, int wc, int fr, int fq) const {
        if (u.kind == 0) {
            EPI_ROWS( const float* b = first ? xp + (size_t)row * D : (const float*)(X + (size_t)row * D);
                      const f32x4 r0 = *(const f32x4*)(b + col), r1 = *(const f32x4*)(b + col + 4);
                      float* o = X + (size_t)row * D + col; *(f32x4*)o = r0 + v0; *(f32x4*)(o + 4) = r1 + v1; )
        } else {
            EPI_ROWS( float* o = PART + ((size_t)u.ks * NS + (row - NP)) * D + col; *(f32x4*)o = v0; *(f32x4*)(o + 4) = v1; )
        }
    }
};
struct EpiQ {
    bf16_t* Q; float* PART;
    __device__ __forceinline__ void operator()(Acc& acc, const Unit& u, int wr, int wc, int fr, int fq) const {
        if (u.kind == 0) {
            EPI_ROWS( *(u32x4*)(Q + (size_t)row * D + col) = pack8(v0 * 0.0625f, v1 * 0.0625f); )
        } else {
            EPI_ROWS( float* o = PART + ((size_t)u.ks * NS + (row - NP)) * D + col; *(f32x4*)o = v0 * 0.0625f; *(f32x4*)(o + 4) = v1 * 0.0625f; )
        }
    }
};
struct EpiBf {
    bf16_t* O; int ld; float scale;
    __device__ __forceinline__ void operator()(Acc& acc, const Unit& u, int wr, int wc, int fr, int fq) const {
        EPI_ROWS( *(u32x4*)(O + (size_t)row * ld + col) = pack8(v0 * scale, v1 * scale); )
    }
};
struct EpiSoftmax {
    bf16_t* PR; LAS unsigned char* lds;
    __device__ __forceinline__ void operator()(Acc& acc, const Unit& u, int wr, int wc, int fr, int fq) const {
        LAS f32x2* X = (LAS f32x2*)(lds + XCH_OFF);
#pragma unroll
        for (int ai = 0; ai < 2; ++ai)
#pragma unroll
            for (int m = 0; m < 4; ++m) {
                float mx = -3.0e38f;
#pragma unroll
                for (int bj = 0; bj < 2; ++bj)
#pragma unroll
                    for (int n = 0; n < 2; ++n) { const f32x4 x = acc[ai][bj][m][n]; mx = fmaxf(mx, fmaxf(fmaxf(x[0], x[1]), fmaxf(x[2], x[3]))); }
                mx = fmaxf(mx, __shfl_xor(mx, 16)); mx = fmaxf(mx, __shfl_xor(mx, 32));
                float s = 0.f;
#pragma unroll
                for (int bj = 0; bj < 2; ++bj)
#pragma unroll
                    for (int n = 0; n < 2; ++n) { f32x4 x = acc[ai][bj][m][n];
                        x[0] = fast_exp(x[0] - mx); x[1] = fast_exp(x[1] - mx); x[2] = fast_exp(x[2] - mx); x[3] = fast_exp(x[3] - mx);
                        s += (x[0] + x[1]) + (x[2] + x[3]); acc[ai][bj][m][n] = x; }
                s += __shfl_xor(s, 16); s += __shfl_xor(s, 32);
                if (fq == 0) X[(ai * 128 + wr * 64 + m * 16 + fr) * 4 + wc] = (f32x2){mx, s};
            }
        asm volatile("s_waitcnt lgkmcnt(0)" ::: "memory"); __builtin_amdgcn_s_barrier(); asm volatile("" ::: "memory");
#pragma unroll
        for (int ai = 0; ai < 2; ++ai)
#pragma unroll
            for (int m = 0; m < 4; ++m) {
                const int rl = ai * 128 + wr * 64 + m * 16 + fr;
                const f32x2 a = X[rl * 4 + 0], b = X[rl * 4 + 1], c = X[rl * 4 + 2], d = X[rl * 4 + 3];
                const float M = fmaxf(fmaxf(a.x, b.x), fmaxf(c.x, d.x));
                const float tot = a.y * fast_exp(a.x - M) + b.y * fast_exp(b.x - M) + c.y * fast_exp(c.x - M) + d.y * fast_exp(d.x - M);
                const float own = wc == 0 ? a.x : (wc == 1 ? b.x : (wc == 2 ? c.x : d.x));
                const float f = fast_exp(own - M) / tot;
                bf16_t* prow = PR + ((size_t)(u.pm * NH + u.pn) * 256 + rl) * 256;
#pragma unroll
                for (int bj = 0; bj < 2; ++bj) { const int col = bj * 128 + wc * 32 + fq * 8; *(u32x4*)(prow + col) = pack8(acc[ai][bj][m][0] * f, acc[ai][bj][m][1] * f); }
                asm volatile("" ::: "memory");
            }
    }
};

#ifndef ONLY
#define ONLY -1
#endif
#define PH(k) (ONLY < 0 || ONLY == (k))
#define GSYNC() xcd_barrier(xb)
struct Args { const float* in[37]; float* out; unsigned char* ws; };

__device__ __forceinline__ void transpose_item(const float* W, int K, int N, bf16_t* WT, int row_off, LAS float* scr, int item, int lane) {
    const int nblk = N / 32, kb = item / nblk, nb = item % nblk, k0 = 64 * kb, n0 = 32 * nb;
#pragma unroll 8
    for (int i = 0; i < 32; ++i) { const int kk = 2 * i + (lane >> 5); scr[kk * 33 + (lane & 31)] = W[(size_t)(k0 + kk) * N + n0 + (lane & 31)]; }
    asm volatile("s_waitcnt lgkmcnt(0)" ::: "memory");
    const int c = lane & 7;
#pragma unroll
    for (int j = 0; j < 4; ++j) { const int n = (lane >> 3) + 8 * j; const LAS float* s = scr + (8 * c) * 33 + n;
        u32x4 o; o.x = cvt_pk_bf16(s[0 * 33], s[1 * 33]); o.y = cvt_pk_bf16(s[2 * 33], s[3 * 33]); o.z = cvt_pk_bf16(s[4 * 33], s[5 * 33]); o.w = cvt_pk_bf16(s[6 * 33], s[7 * 33]);
        *(u32x4*)(WT + (size_t)(row_off + n0 + n) * K + k0 + 8 * c) = o; }
    asm volatile("s_waitcnt lgkmcnt(0)" ::: "memory");
}

__device__ __forceinline__ void add_parts(float* xrow, const float* part, int nparts, size_t pstride, int lane) {
    f32x4* xr = (f32x4*)xrow + lane; f32x4 v[4];
#pragma unroll
    for (int j = 0; j < 4; ++j) v[j] = xr[64 * j];
    for (int k = 0; k < nparts; ++k) { const f32x4* pr = (const f32x4*)(part + (size_t)k * pstride) + lane;
#pragma unroll
        for (int j = 0; j < 4; ++j) v[j] += pr[64 * j]; }
#pragma unroll
    for (int j = 0; j < 4; ++j) xr[64 * j] = v[j];
}
__device__ __forceinline__ void rms_row_bf16(const float* xrow, const float* g, bf16_t* orow, int lane) {
    const f32x4* xr = (const f32x4*)xrow + lane; f32x4 v[4]; float s = 0.f;
#pragma unroll
    for (int j = 0; j < 4; ++j) { v[j] = xr[64 * j]; s += (v[j][0] * v[j][0] + v[j][1] * v[j][1]) + (v[j][2] * v[j][2] + v[j][3] * v[j][3]); }
    const float rstd = 1.0f / sqrtf(wave_sum(s) * (1.0f / D) + EPS);
    u32x2* o8 = (u32x2*)orow + lane;
#pragma unroll
    for (int j = 0; j < 4; ++j) { const f32x4 gg = ((const f32x4*)g)[lane + 64 * j]; u32x2 w; w.x = cvt_pk_bf16(v[j][0] * rstd * gg[0], v[j][1] * rstd * gg[1]); w.y = cvt_pk_bf16(v[j][2] * rstd * gg[2], v[j][3] * rstd * gg[3]); o8[64 * j] = w; }
}
__device__ __forceinline__ void rms_row_f32(const float* xrow, const float* g, float* orow, int lane) {
    const f32x4* xr = (const f32x4*)xrow + lane; f32x4 v[4]; float s = 0.f;
#pragma unroll
    for (int j = 0; j < 4; ++j) { v[j] = xr[64 * j]; s += (v[j][0] * v[j][0] + v[j][1] * v[j][1]) + (v[j][2] * v[j][2] + v[j][3] * v[j][3]); }
    const float rstd = 1.0f / sqrtf(wave_sum(s) * (1.0f / D) + EPS);
#pragma unroll
    for (int j = 0; j < 4; ++j) { const f32x4 gg = ((const f32x4*)g)[lane + 64 * j]; ((f32x4*)orow)[lane + 64 * j] = v[j] * rstd * gg; }
}

__device__ __forceinline__ float treduce16(float (&v)[16], int lane) {
    { const bool hi = lane & 32;
#pragma unroll
      for (int i = 0; i < 8; ++i) { const float send = hi ? v[i] : v[i + 8], keep = hi ? v[i + 8] : v[i]; v[i] = keep + __shfl_xor(send, 32); } }
    { const bool hi = lane & 16;
#pragma unroll
      for (int i = 0; i < 4; ++i) { const float send = hi ? v[i] : v[i + 4], keep = hi ? v[i + 4] : v[i]; v[i] = keep + __shfl_xor(send, 16); } }
    { const bool hi = lane & 8;
#pragma unroll
      for (int i = 0; i < 2; ++i) { const float send = hi ? v[i] : v[i + 2], keep = hi ? v[i + 2] : v[i]; v[i] = keep + __shfl_xor(send, 8); } }
    { const bool hi = lane & 4; const float send = hi ? v[0] : v[1], keep = hi ? v[1] : v[0]; v[0] = keep + __shfl_xor(send, 4); }
    v[0] += __shfl_xor(v[0], 2); v[0] += __shfl_xor(v[0], 1);
    return v[0];
}
template <int W> __device__ __forceinline__ void tr_step(float (&v)[64], int lane) {
    const bool hi = lane & W;
#pragma unroll
    for (int i = 0; i < W; ++i) { const float send = hi ? v[i] : v[i + W], keep = hi ? v[i + W] : v[i]; v[i] = keep + __shfl_xor(send, W); }
}
__device__ __forceinline__ float treduce64(float (&v)[64], int lane) {
    tr_step<32>(v, lane); tr_step<16>(v, lane); tr_step<8>(v, lane); tr_step<4>(v, lane); tr_step<2>(v, lane); tr_step<1>(v, lane);
    return v[0];
}

template <bool WITH_Y>
__device__ __forceinline__ void ssm_tile(const bf16_t* zu, int nsteps, float& sr, float& si, const float* BB, const float* AT, const float* Cre, const float* Cim, const float* Dv,
                                         int g, bf16_t* yg, int lane) {
    float Br[16], Bi[16];
    { const f32x4* bp = (const f32x4*)(BB + (size_t)(g * SN + lane) * 32);
#pragma unroll
      for (int j = 0; j < 4; ++j) { const f32x4 a = bp[j], b = bp[4 + j]; Br[4 * j] = a[0]; Br[4 * j + 1] = a[1]; Br[4 * j + 2] = a[2]; Br[4 * j + 3] = a[3]; Bi[4 * j] = b[0]; Bi[4 * j + 1] = b[1]; Bi[4 * j + 2] = b[2]; Bi[4 * j + 3] = b[3]; } }
    const f32x4 at = *(const f32x4*)(AT + (size_t)(g * SN + lane) * 4); const float ar = at[0], ai = at[1];
    float Cr[16], Ci[16], Dm[16];
    if (WITH_Y) {
#pragma unroll
        for (int p = 0; p < 16; ++p) { Cr[p] = Cre[(size_t)(g * SP + p) * SN + lane]; Ci[p] = Cim[(size_t)(g * SP + p) * SN + lane]; Dm[p] = (lane == 0) ? Dv[g * SP + p] : 0.f; }
    }
    u32x4 u0 = (u32x4){0, 0, 0, 0}, u1 = (u32x4){0, 0, 0, 0};
    if (lane < nsteps) { const u32x4* up = (const u32x4*)(zu + (size_t)lane * NZ); u0 = up[0]; u1 = up[1]; }
    const int p_own = ((lane >> 5) & 1) * 8 + ((lane >> 4) & 1) * 4 + ((lane >> 3) & 1) * 2 + ((lane >> 2) & 1);
    for (int t = 0; t < nsteps; ++t) {
        float uu[16];
        { unsigned w;
          w = __builtin_amdgcn_readlane(u0.x, t); uu[0] = bf_lo(w); uu[1] = bf_hi(w);
          w = __builtin_amdgcn_readlane(u0.y, t); uu[2] = bf_lo(w); uu[3] = bf_hi(w);
          w = __builtin_amdgcn_readlane(u0.z, t); uu[4] = bf_lo(w); uu[5] = bf_hi(w);
          w = __builtin_amdgcn_readlane(u0.w, t); uu[6] = bf_lo(w); uu[7] = bf_hi(w);
          w = __builtin_amdgcn_readlane(u1.x, t); uu[8] = bf_lo(w); uu[9] = bf_hi(w);
          w = __builtin_amdgcn_readlane(u1.y, t); uu[10] = bf_lo(w); uu[11] = bf_hi(w);
          w = __builtin_amdgcn_readlane(u1.z, t); uu[12] = bf_lo(w); uu[13] = bf_hi(w);
          w = __builtin_amdgcn_readlane(u1.w, t); uu[14] = bf_lo(w); uu[15] = bf_hi(w); }
        float br = 0.f, bi = 0.f;
#pragma unroll
        for (int p = 0; p < 16; ++p) { br = fmaf(Br[p], uu[p], br); bi = fmaf(Bi[p], uu[p], bi); }
        const float nr = ar * sr - ai * si + br, ni = ar * si + ai * sr + bi;
        sr = nr; si = ni;
        if (WITH_Y) {
            float v[16];
#pragma unroll
            for (int p = 0; p < 16; ++p) v[p] = fmaf(Dm[p], uu[p], Cr[p] * sr - Ci[p] * si);
            const float y = treduce16(v, lane);
            const float gy = gelu_tanh(y);
            if ((lane & 3) == 0) yg[(size_t)t * MIX + g * SP + p_own] = (bf16_t)(cvt_pk_bf16(gy, 0.f) & 0xffff);
        }
    }
}


typedef short bf16x4 __attribute__((ext_vector_type(4)));
struct SsmTab { bf16x4 Bre[4], Bim[4]; bf16x8 Ct[4]; float dp; float ar, ai; };
__device__ __forceinline__ void ssm_load_tab(SsmTab& T, int g, const bf16_t* BTR, const bf16_t* BTI, const bf16_t* CT, const float* AT, const float* Dv, int lane, bool with_y) {
    const int li = lane & 15, lq = lane >> 4;
#pragma unroll
    for (int nt = 0; nt < 4; ++nt) { T.Bre[nt] = *(const bf16x4*)(BTR + ((size_t)(g * SN + 16 * nt + li)) * 16 + 4 * lq); T.Bim[nt] = *(const bf16x4*)(BTI + ((size_t)(g * SN + 16 * nt + li)) * 16 + 4 * lq); }
    const f32x4 at = *(const f32x4*)(AT + (size_t)(g * SN + lane) * 4); T.ar = at[0]; T.ai = at[1];
    if (with_y) {
#pragma unroll
        for (int kb = 0; kb < 4; ++kb) T.Ct[kb] = *(const bf16x8*)(CT + ((size_t)(g * SP + li)) * 128 + kb * 32 + 8 * lq);
        T.dp = Dv[g * SP + li];
    }
}
template <bool WITH_Y>
__device__ __forceinline__ void ssm_chunk(LAS unsigned char* wl, const bf16_t* zu, float& sr, float& si, const SsmTab& T, bf16_t* yg, int lane) {
    const int li = lane & 15, lq = lane >> 4;
    bf16x4 U[4];
#pragma unroll
    for (int mt = 0; mt < 4; ++mt) U[mt] = *(const bf16x4*)(zu + (size_t)(16 * mt + li) * NZ + 4 * lq);
    {
        int rofs[4], nofs[4];
#pragma unroll
        for (int r = 0; r < 4; ++r) { rofs[r] = lq * 1024 + (li & 3) * 4 + r * 256 + (((li >> 2) ^ r) << 4); nofs[r] = ((r ^ lq) << 6); }
#pragma unroll 1
        for (int mt = 0; mt < 4; ++mt) {
            LAS unsigned char* pm = wl + mt * 4096;
            const bf16x4 um = mt == 0 ? U[0] : (mt == 1 ? U[1] : (mt == 2 ? U[2] : U[3]));
#pragma unroll
            for (int nt = 0; nt < 4; ++nt) {
                const f32x4 dre = __builtin_amdgcn_mfma_f32_16x16x16bf16_1k(um, T.Bre[nt], (f32x4){0.f, 0.f, 0.f, 0.f}, 0, 0, 0);
                const f32x4 dim = __builtin_amdgcn_mfma_f32_16x16x16bf16_1k(um, T.Bim[nt], (f32x4){0.f, 0.f, 0.f, 0.f}, 0, 0, 0);
#pragma unroll
                for (int r = 0; r < 4; ++r) *(LAS unsigned*)(pm + rofs[r] + nofs[nt]) = cvt_pk_bf16(dre[r], dim[r]);
            }
        }
    }
    asm volatile("s_waitcnt lgkmcnt(0)" ::: "memory");
    {
        const float ar = T.ar, ai = T.ai;
        int xj[16];
#pragma unroll
        for (int j = 0; j < 16; ++j) xj[j] = (((lane >> 2) ^ j) << 4) + (lane & 3) * 4 + j * 256;
#pragma unroll 1
        for (int tb = 0; tb < 4; ++tb) {
            LAS unsigned char* pb = wl + tb * 4096;
            unsigned w[16];
#pragma unroll
            for (int j = 0; j < 16; ++j) w[j] = *(const LAS unsigned*)(pb + xj[j]);
#pragma unroll
            for (int j = 0; j < 16; ++j) {
                const float nr = ar * sr - ai * si + bf_lo(w[j]), ni = ar * si + ai * sr + bf_hi(w[j]);
                sr = nr; si = ni;
                if (WITH_Y) *(LAS unsigned*)(pb + xj[j]) = cvt_pk_bf16(sr, si);
            }
        }
    }
    if (WITH_Y) {
        asm volatile("s_waitcnt lgkmcnt(0)" ::: "memory");
        int kofs[4];
#pragma unroll
        for (int kb = 0; kb < 4; ++kb) kofs[kb] = li * 256 + ((((kb * 4 + lq) ^ li)) << 4);
#pragma unroll 1
        for (int mt = 0; mt < 4; ++mt) {
            const LAS unsigned char* pm = wl + mt * 4096;
            f32x4 acc = (f32x4){0.f, 0.f, 0.f, 0.f};
#pragma unroll
            for (int kb = 0; kb < 4; ++kb) { const bf16x8 a = *(const LAS bf16x8*)(pm + kofs[kb]); acc = __builtin_amdgcn_mfma_f32_16x16x32_bf16(a, T.Ct[kb], acc, 0, 0, 0); }
            bf16_t* yp = yg + (size_t)(16 * mt + 4 * lq) * MIX + li;
            const bf16_t* up = zu + (size_t)(16 * mt + 4 * lq) * NZ + li;
#pragma unroll
            for (int r = 0; r < 4; ++r) { const float uv = __uint_as_float(((unsigned)up[(size_t)r * NZ]) << 16);
                yp[(size_t)r * MIX] = (bf16_t)(cvt_pk_bf16(gelu_tanh(fmaf(T.dp, uv, acc[r])), 0.f) & 0xffff); }
        }
        asm volatile("s_waitcnt lgkmcnt(0)" ::: "memory");
    }
}

#define XB_TMO      128
#define XB_XCNT(j)  (256  + 64 * (j))
#define XB_XSUB(j)  (1280 + 64 * (j))
#define XB_XGEN(j)  (2304 + 64 * (j))
#define XB_TOP      3328
#define XB_TOPGEN   3392
#define XCD_BAR_WORDS 3456
#define XB_SPIN_CAP (1u << 18)
__device__ __forceinline__ unsigned xb_ld(unsigned* p)              { return __hip_atomic_load(p, __ATOMIC_RELAXED, __HIP_MEMORY_SCOPE_AGENT); }
__device__ __forceinline__ unsigned xb_add(unsigned* p, unsigned v) { return __hip_atomic_fetch_add(p, v, __ATOMIC_RELAXED, __HIP_MEMORY_SCOPE_AGENT); }
__device__ __forceinline__ unsigned xb_xcc_id() { return (unsigned)__builtin_amdgcn_s_getreg((3 << 11) | 20) & 0xFu; }
#define XB_SPIN(cond, bar) do { unsigned _sp = 0; while (cond) { __builtin_amdgcn_s_sleep(1); \
    if ((++_sp & 255u) == 0u) { if (xb_ld(&(bar)[XB_TMO])) break; if (_sp > XB_SPIN_CAP) { atomicAdd(&(bar)[XB_TMO], 1u); break; } } } } while (0)
struct XcdBarrier { unsigned* bar; unsigned x; volatile LAS unsigned* st; };
__device__ __forceinline__ XcdBarrier xcd_barrier_post(unsigned* bar, volatile LAS unsigned* st) {
    XcdBarrier b; b.bar = bar; b.x = xb_xcc_id(); b.st = st;
    if (threadIdx.x == 0) (void)xb_add(&bar[XB_XCNT(b.x)], 1u);
    return b;
}
__device__ __forceinline__ void xcd_barrier_complete(unsigned* bar, unsigned x, unsigned& nloc, unsigned& nx) {
    const unsigned G = gridDim.x * gridDim.y * gridDim.z;
    unsigned sum, cnt, mine, sp = 0u;
    for (;;) {
        sum = 0u; cnt = 0u; mine = 0u;
#pragma unroll
        for (unsigned j = 0; j < 16; ++j) { const unsigned c = xb_ld(&bar[XB_XCNT(j)]); sum += c; cnt += (c > 0u) ? 1u : 0u; mine = (j == x) ? c : mine; }
        if (sum == G) break;
        __builtin_amdgcn_s_sleep(1);
        if ((++sp & 255u) == 0u) { if (xb_ld(&bar[XB_TMO])) break; if (sp > XB_SPIN_CAP) { atomicAdd(&bar[XB_TMO], 1u); break; } }
    }
    nloc = mine > 0u ? mine : 1u; nx = cnt > 0u ? cnt : 1u;
}
__device__ __forceinline__ void xcd_barrier(const XcdBarrier& b) {
    asm volatile("s_waitcnt vmcnt(0)" ::: "memory");
    __syncthreads();
    if (threadIdx.x == 0) {
        unsigned* bar = b.bar;
        __builtin_amdgcn_s_waitcnt(0);
        unsigned nloc = b.st[0], nx = b.st[1];
        if (nloc == 0u) { xcd_barrier_complete(bar, b.x, nloc, nx); b.st[0] = nloc; b.st[1] = nx; }
        const unsigned old = xb_add(&bar[XB_XSUB(b.x)], 1u);
        const unsigned gen = old / nloc;
        if (old + 1u == (gen + 1u) * nloc) {
            __builtin_amdgcn_fence(__ATOMIC_RELEASE, "agent");
            asm volatile("s_waitcnt vmcnt(0)" ::: "memory");
            const unsigned og = xb_add(&bar[XB_TOP], 1u);
            const unsigned tg = og / nx;
            if (og + 1u == (tg + 1u) * nx) xb_add(&bar[XB_TOPGEN], 1u);
            else XB_SPIN(xb_ld(&bar[XB_TOPGEN]) == tg, bar);
            __builtin_amdgcn_fence(__ATOMIC_ACQUIRE, "agent");
            xb_add(&bar[XB_XGEN(b.x)], 1u);
            asm volatile("s_waitcnt vmcnt(0)" ::: "memory");
        } else {
            XB_SPIN(xb_ld(&bar[XB_XGEN(b.x)]) == gen, bar);
            __builtin_amdgcn_fence(__ATOMIC_ACQUIRE, "agent");
            asm volatile("s_waitcnt vmcnt(0)" ::: "memory");
        }
    }
    __syncthreads();
}

__device__ __forceinline__ const float* ld_in(int k) {
    const __attribute__((address_space(4))) unsigned long long* t = (const __attribute__((address_space(4))) unsigned long long*)__builtin_amdgcn_kernarg_segment_ptr();
    asm volatile("" : "+s"(t));
    return (const float*)t[k];
}
__global__ void __launch_bounds__(NTHREADS, 2) hymba_fwd(Args args) {
    extern __shared__ __attribute__((aligned(16))) unsigned char lds_raw[];
    LAS unsigned char* lds = (LAS unsigned char*)lds_raw;
    cg::grid_group grid = cg::this_grid();
    const int tid = threadIdx.x, lane = tid & 63, wave = __builtin_amdgcn_readfirstlane(tid >> 6);
    const int G = gridDim.x, bx = blockIdx.x;
    const int gw = bx * NWAVES + wave, NGW = G * NWAVES;
#define IN(k) ld_in(k)
    unsigned char* ws = (unsigned char*)ld_in(38); float* out = (float*)ld_in(37);
    unsigned* barw = (unsigned*)(ws + WS_CTL);
    volatile LAS unsigned* bst = (volatile LAS unsigned*)(lds + XCH_OFF + 8192);
    if (bx == 0) for (int i = tid; i < XCD_BAR_WORDS; i += NTHREADS) barw[i] = 0u;
    if (tid < 2) bst[tid] = 0u;
    bf16_t* WIN = (bf16_t*)(ws + WS_WIN); bf16_t* WKV = (bf16_t*)(ws + WS_WKV); bf16_t* WGLU = (bf16_t*)(ws + WS_WGLU); bf16_t* WOUT = (bf16_t*)(ws + WS_WOUT);
    bf16_t* WQ = (bf16_t*)(ws + WS_WQ); bf16_t* WXO = (bf16_t*)(ws + WS_WXO); bf16_t* WUG = (bf16_t*)(ws + WS_WUG); bf16_t* WDN = (bf16_t*)(ws + WS_WDN);
    bf16_t* H = (bf16_t*)(ws + WS_H); float* X = (float*)(ws + WS_X);
    bf16_t* Z = (bf16_t*)(ws + WS_Z); bf16_t* YG = (bf16_t*)(ws + WS_YG); float* YS = (float*)(ws + WS_YS); bf16_t* MIXN = (bf16_t*)(ws + WS_MIXN);
    bf16_t* Q = (bf16_t*)(ws + WS_Q); bf16_t* PR = (bf16_t*)(ws + WS_PR); bf16_t* O = (bf16_t*)(ws + WS_O);
    bf16_t* MN = (bf16_t*)(ws + WS_MN); bf16_t* KB = (bf16_t*)(ws + WS_KB); bf16_t* VT = (bf16_t*)(ws + WS_VT);
    float* SE = (float*)(ws + WS_SE); float* SI = (float*)(ws + WS_SI); float* BB = (float*)(ws + WS_BB); float* AT = (float*)(ws + WS_AT);
    float* PART = (float*)(ws + WS_PART);
    bf16_t* BTR = (bf16_t*)(ws + WS_BTR); bf16_t* BTI = (bf16_t*)(ws + WS_BTI); bf16_t* CT = (bf16_t*)(ws + WS_CT);
    bf16_t* UG = (bf16_t*)(ws + WS_UG); bf16_t* ACT = (bf16_t*)(ws + WS_ACT);

    if (PH(0)) {
        const float* x_prompt = IN(0); const float* x_sample = IN(1); const float* mem_prompt = IN(2); const float* norm_mix = IN(9); const float* w_in = IN(10);
        const float* C_re = IN(16); const float* C_im = IN(17);
        const float* A_re = IN(11); const float* A_im = IN(12); const float* log_dt = IN(13); const float* B_re = IN(14); const float* B_im = IN(15);
        const float* w_glu = IN(19); const float* w_out = IN(24); const float* norm_mem = IN(26); const float* w_q = IN(27); const float* w_k = IN(28); const float* w_v = IN(29); const float* w_xo = IN(30);
        const float* w_up = IN(32); const float* w_gate = IN(33); const float* w_down = IN(35);
        LAS float* scr = (LAS float*)(lds + wave * 16384);
        constexpr int I_IN = 16 * 64, I_D = 16 * 32, I_GLU = 8 * 16, I_UP = 16 * 88, I_DN = 44 * 32;
        constexpr int NITEMS = I_IN + 5 * I_D + I_GLU + 2 * I_UP + I_DN;
        for (int it = gw; it < NITEMS; it += NGW) {
            int r = it;
            if (r < I_IN) { transpose_item(w_in, D, NZ, WIN, 0, scr, r, lane); continue; } r -= I_IN;
            if (r < I_D) { transpose_item(w_k, D, D, WKV, 0, scr, r, lane); continue; } r -= I_D;
            if (r < I_D) { transpose_item(w_v, D, D, WKV, D, scr, r, lane); continue; } r -= I_D;
            if (r < I_D) { transpose_item(w_out, D, D, WOUT, 0, scr, r, lane); continue; } r -= I_D;
            if (r < I_D) { transpose_item(w_q, D, D, WQ, 0, scr, r, lane); continue; } r -= I_D;
            if (r < I_D) { transpose_item(w_xo, D, D, WXO, 0, scr, r, lane); continue; } r -= I_D;
            if (r < I_GLU) { transpose_item(w_glu, MIX, MIX, WGLU, 0, scr, r, lane); continue; } r -= I_GLU;
            if (r < I_UP) { transpose_item(w_up, D, DFF, WUG, 0, scr, r, lane); continue; } r -= I_UP;
            if (r < I_UP) { transpose_item(w_gate, D, DFF, WUG, DFF, scr, r, lane); continue; } r -= I_UP;
            transpose_item(w_down, DFF, D, WDN, 0, scr, r, lane);
        }
        for (int m = gw; m < MT; m += NGW) rms_row_bf16(m < NP ? x_prompt + (size_t)m * D : x_sample + (size_t)(m - NP) * D, norm_mix, H + (size_t)m * D, lane);
        for (int m = gw; m < BP * NMEM; m += NGW) rms_row_bf16(mem_prompt + (size_t)m * D, norm_mem, MN + (size_t)m * D, lane);
        for (size_t i = (size_t)bx * NTHREADS + tid; i < (size_t)NS * D / 4; i += (size_t)G * NTHREADS) { ((f32x4*)(X + (size_t)NP * D))[i] = ((const f32x4*)x_sample)[i]; }
        const int gt = bx * NTHREADS + tid;
        if (gt < SG * SN) {
            const int g = gt / SN;
            const float dt = expf(log_dt[g]), lr = A_re[gt], li = A_im[gt];
            const float mag = expf(dt * lr), ph = dt * li;
            double th = (double)ph * (1.0 / 1024.0), t2 = th * th;
            double c = 1.0 - t2 * (0.5 - t2 * (1.0 / 24.0 - t2 * (1.0 / 720.0)));
            double s = th * (1.0 - t2 * (1.0 / 6.0 - t2 * (1.0 / 120.0 - t2 * (1.0 / 5040.0))));
#pragma unroll 1
            for (int k = 0; k < 10; ++k) { const double c2 = c * c - s * s, s2 = 2.0 * c * s; c = c2; s = s2; }
            const float ar = mag * (float)c, ai = mag * (float)s;
            const float den = lr * lr + li * li;
            const float cr = ((ar - 1.0f) * lr + ai * li) / den, ci = (ai * lr - (ar - 1.0f) * li) / den;
#pragma unroll
            for (int p = 0; p < 16; ++p) { const float br = B_re[(size_t)gt * SP + p], bi = B_im[(size_t)gt * SP + p];
                const float bbr = cr * br - ci * bi, bbi = cr * bi + ci * br;
                BB[(size_t)gt * 32 + p] = bbr; BB[(size_t)gt * 32 + 16 + p] = bbi;
                BTR[(size_t)gt * 16 + p] = (bf16_t)(cvt_pk_bf16(bbr, 0.f) & 0xffff); BTI[(size_t)gt * 16 + p] = (bf16_t)(cvt_pk_bf16(bbi, 0.f) & 0xffff); }
            float pr = ar, pi = ai;
#pragma unroll 1
            for (int k = 0; k < 6; ++k) { const float r2 = pr * pr - pi * pi, i2 = 2.0f * pr * pi; pr = r2; pi = i2; }
            *(f32x4*)(AT + (size_t)gt * 4) = (f32x4){ar, ai, pr, pi};
        }
        if (gt < SG * SP * SN) {
            const float cre = C_re[gt], cim = C_im[gt];
            ((unsigned*)CT)[gt] = cvt_pk_bf16(cre, -cim);
        }
    }
    grid.sync();
    const XcdBarrier xb = xcd_barrier_post(barw, bst);

    if (PH(1)) {
        Sched2 S{G, bx, MT / 256, NZ / 256, 16, BP, 8, 16, 1, 0, (const char*)H, (const char*)WIN, (const char*)MN, (const char*)WKV, (size_t)256 * D * 2, (size_t)256 * D * 2};
        EpiP1 E{Z, out + O_MK, out + O_MV, KB, VT};
        pg8::gemm_phase(lds, D, D, S, E);
    }
    GSYNC();

    if (PH(2)) {
        const float* st_re = IN(5); const float* st_im = IN(6); const float* st_conv = IN(7); const float* C_re = IN(16); const float* C_im = IN(17); const float* Dssm = IN(18); const float* conv_w = IN(21); const float* norm_conv = IN(23);
        {
            SsmTab T; int gcur = -1;
            for (int task = gw; task < BP * SG * NCH; task += NGW) {
                const int c = task % NCH, g = (task / NCH) % SG, b = task / (NCH * SG);
                if (g != gcur) { ssm_load_tab(T, g, BTR, BTI, CT, AT, Dssm, lane, false); gcur = g; }
                float sr = 0.f, si = 0.f;
#ifdef OLD_PASS1
                ssm_tile<false>(Z + (size_t)(b * TP + c * LCH) * NZ + g * SP, LCH, sr, si, BB, AT, C_re, C_im, Dssm, g, nullptr, lane);
#else
                ssm_chunk<false>(lds + wave * 16384, Z + (size_t)(b * TP + c * LCH) * NZ + g * SP, sr, si, T, nullptr, lane);
#endif
                float* e = SE + ((size_t)(b * SG + g) * NCH + c) * 128; e[lane] = sr; e[64 + lane] = si;
            }
        }
        for (int task = gw; task < BS * SG; task += NGW) {
            const int b = task % BS, g = task / BS;
            float sr = st_re[(size_t)(b * SG + g) * SN + lane], si = st_im[(size_t)(b * SG + g) * SN + lane];
            ssm_tile<true>(Z + (size_t)(NP + b * TS) * NZ + g * SP, TS, sr, si, BB, AT, C_re, C_im, Dssm, g, YG + (size_t)(NP + b * TS) * MIX, lane);
            out[O_SRS + (size_t)(b * SG + g) * SN + lane] = sr; out[O_SIS + (size_t)(b * SG + g) * SN + lane] = si;
        }
        for (int r = gw; r < MT; r += NGW) {
            int b, t; const float* prev; float* cout; int T;
            if (r < NP) { b = r / TP; t = r % TP; prev = nullptr; cout = out + O_CP + (size_t)b * 2 * MIX; T = TP; }
            else { const int rs = r - NP; b = rs / TS; t = rs % TS; prev = st_conv + (size_t)b * 2 * MIX; cout = out + O_CS + (size_t)b * 2 * MIX; T = TS; }
            const int c0 = lane * 8;
            float p[3][8];
#pragma unroll
            for (int k = 0; k < 3; ++k) {
                const int tt = t - k;
                if (tt >= 0) { const bf16_t* zr = Z + (size_t)(r - k) * NZ; const u32x4 xi = *(const u32x4*)(zr + MIX + c0), cgv = *(const u32x4*)(zr + 3 * MIX + c0);
                    p[k][0] = bf_lo(xi.x) * bf_lo(cgv.x); p[k][1] = bf_hi(xi.x) * bf_hi(cgv.x); p[k][2] = bf_lo(xi.y) * bf_lo(cgv.y); p[k][3] = bf_hi(xi.y) * bf_hi(cgv.y);
                    p[k][4] = bf_lo(xi.z) * bf_lo(cgv.z); p[k][5] = bf_hi(xi.z) * bf_hi(cgv.z); p[k][6] = bf_lo(xi.w) * bf_lo(cgv.w); p[k][7] = bf_hi(xi.w) * bf_hi(cgv.w); }
                else if (prev) { const float* pp = prev + (size_t)(2 + tt) * MIX + c0; const f32x4 a = *(const f32x4*)pp, bq = *(const f32x4*)(pp + 4);
                    p[k][0] = a[0]; p[k][1] = a[1]; p[k][2] = a[2]; p[k][3] = a[3]; p[k][4] = bq[0]; p[k][5] = bq[1]; p[k][6] = bq[2]; p[k][7] = bq[3]; }
                else {
#pragma unroll
                    for (int j = 0; j < 8; ++j) p[k][j] = 0.f; }
            }
            const u32x4 bgv = *(const u32x4*)(Z + (size_t)r * NZ + 2 * MIX + c0);
            float bg[8] = {bf_lo(bgv.x), bf_hi(bgv.x), bf_lo(bgv.y), bf_hi(bgv.y), bf_lo(bgv.z), bf_hi(bgv.z), bf_lo(bgv.w), bf_hi(bgv.w)};
            float y[8]; float ss = 0.f;
#pragma unroll
            for (int j = 0; j < 8; ++j) { const float w0 = conv_w[c0 + j], w1 = conv_w[MIX + c0 + j], w2 = conv_w[2 * MIX + c0 + j];
                y[j] = bg[j] * (w0 * p[2][j] + w1 * p[1][j] + w2 * p[0][j]); ss += y[j] * y[j]; }
            const float rstd = 1.0f / sqrtf(wave_sum(ss) * (1.0f / MIX) + EPS);
            const f32x4 g0 = *(const f32x4*)(norm_conv + c0), g1 = *(const f32x4*)(norm_conv + c0 + 4);
            u32x4 w; w.x = cvt_pk_bf16(y[0] * rstd * g0[0], y[1] * rstd * g0[1]); w.y = cvt_pk_bf16(y[2] * rstd * g0[2], y[3] * rstd * g0[3]);
            w.z = cvt_pk_bf16(y[4] * rstd * g1[0], y[5] * rstd * g1[1]); w.w = cvt_pk_bf16(y[6] * rstd * g1[2], y[7] * rstd * g1[3]);
            *(u32x4*)(MIXN + (size_t)r * D + MIX + c0) = w;
            if (t >= T - 2) { float* co = cout + (size_t)(t - (T - 2)) * MIX + c0; *(f32x4*)co = (f32x4){p[0][0], p[0][1], p[0][2], p[0][3]}; *(f32x4*)(co + 4) = (f32x4){p[0][4], p[0][5], p[0][6], p[0][7]}; }
        }
    }
    GSYNC();

    if (PH(3)) {
        for (int task = gw; task < BP * SG; task += NGW) {
            const int g = task % SG, b = task / SG;
            const f32x4 at = *(const f32x4*)(AT + (size_t)(g * SN + lane) * 4); const float aLr = at[2], aLi = at[3];
            float sr = 0.f, si = 0.f;
            for (int c = 0; c < NCH; ++c) {
                float* sip = SI + ((size_t)(b * SG + g) * NCH + c) * 128; sip[lane] = sr; sip[64 + lane] = si;
                const float* e = SE + ((size_t)(b * SG + g) * NCH + c) * 128; const float er = e[lane], ei = e[64 + lane];
                const float nr = aLr * sr - aLi * si + er, ni = aLr * si + aLi * sr + ei; sr = nr; si = ni;
            }
            out[O_SRP + (size_t)(b * SG + g) * SN + lane] = sr; out[O_SIP + (size_t)(b * SG + g) * SN + lane] = si;
        }
    }
    GSYNC();

    if (PH(4)) {
        const float* C_re = IN(16); const float* C_im = IN(17); const float* Dssm = IN(18);
        SsmTab T; int gcur = -1;
        for (int task = gw; task < BP * SG * NCH; task += NGW) {
            const int c = task % NCH, g = (task / NCH) % SG, b = task / (NCH * SG);
            if (g != gcur) { ssm_load_tab(T, g, BTR, BTI, CT, AT, Dssm, lane, true); gcur = g; }
            const float* sip = SI + ((size_t)(b * SG + g) * NCH + c) * 128; float sr = sip[lane], si = sip[64 + lane];
#ifdef OLD_PASS2
            ssm_tile<true>(Z + (size_t)(b * TP + c * LCH) * NZ + g * SP, LCH, sr, si, BB, AT, C_re, C_im, Dssm, g, YG + (size_t)(b * TP + c * LCH) * MIX, lane);
#else
            ssm_chunk<true>(lds + wave * 16384, Z + (size_t)(b * TP + c * LCH) * NZ + g * SP, sr, si, T, YG + (size_t)(b * TP + c * LCH) * MIX + g * SP, lane);
#endif
        }
    }
    GSYNC();

    if (PH(5)) {
        const float* b_glu = IN(20);
        Sched2 S{G, bx, MT / 256, MIX / 256, 8, 0, 0, 4, 1, 0, (const char*)YG, (const char*)WGLU, nullptr, nullptr, (size_t)256 * MIX * 2, (size_t)256 * MIX * 2};
        EpiGlu E{YG, b_glu, YS};
        pg8::gemm_phase(lds, MIX, MIX, S, E);
    }
    GSYNC();

    if (PH(6)) {
        const float* norm_ssm = IN(22);
        for (int r = gw; r < MT; r += NGW) {
            const f32x4* yr = (const f32x4*)(YS + (size_t)r * MIX) + lane; const f32x4 a = yr[0], b = yr[64];
            const float ss = (a[0] * a[0] + a[1] * a[1]) + (a[2] * a[2] + a[3] * a[3]) + (b[0] * b[0] + b[1] * b[1]) + (b[2] * b[2] + b[3] * b[3]);
            const float rstd = 1.0f / sqrtf(wave_sum(ss) * (1.0f / MIX) + EPS);
            const f32x4 ga = ((const f32x4*)norm_ssm)[lane], gb = ((const f32x4*)norm_ssm)[lane + 64];
            u32x2 w0, w1; w0.x = cvt_pk_bf16(a[0] * rstd * ga[0], a[1] * rstd * ga[1]); w0.y = cvt_pk_bf16(a[2] * rstd * ga[2], a[3] * rstd * ga[3]);
            w1.x = cvt_pk_bf16(b[0] * rstd * gb[0], b[1] * rstd * gb[1]); w1.y = cvt_pk_bf16(b[2] * rstd * gb[2], b[3] * rstd * gb[3]);
            u32x2* o8 = (u32x2*)(MIXN + (size_t)r * D) + lane; o8[0] = w0; o8[64] = w1;
        }
    }
    GSYNC();

    if (PH(7)) {
        const float* x_prompt = IN(0);
        Sched2 S{G, bx, NP / 256, D / 256, 16, NS / 256, D / 256, 4, 4, NP / 256, (const char*)MIXN, (const char*)WOUT, (const char*)MIXN, (const char*)WOUT, (size_t)256 * D * 2, (size_t)256 * D * 2};
        EpiRes E{x_prompt, X, PART, 1};
        pg8::gemm_phase(lds, D, D, S, E);
    }
    GSYNC();

    if (PH(8)) for (int m = gw; m < MT; m += NGW) { if (m >= NP) add_parts(X + (size_t)m * D, PART + (size_t)(m - NP) * D, 4, (size_t)NS * D, lane); rms_row_bf16(X + (size_t)m * D, IN(25), H + (size_t)m * D, lane); }
    GSYNC();

    if (PH(9)) {
        Sched2 S{G, bx, NP / 256, D / 256, 16, NS / 256, D / 256, 4, 4, NP / 256, (const char*)H, (const char*)WQ, (const char*)H, (const char*)WQ, (size_t)256 * D * 2, (size_t)256 * D * 2};
        EpiQ E{Q, PART};
        pg8::gemm_phase(lds, D, D, S, E);
    }
    GSYNC();

    if (PH(10)) {
        const float* cache_k = IN(3); const float* cache_v = IN(4);
        struct SchedQK { int G, c; const char* Q; const char* KB;
            __device__ __forceinline__ bool next(int i, Unit& u) const { const int L = i * G + c; if (L >= 64 * NH) return false; pg8::order_map(L, 64, NH, u.pm, u.pn); u.kind = 0; u.nt = 4; u.ks = 0;
                u.A = Q + ((size_t)u.pm * 256 * D + (size_t)u.pn * HD) * 2; u.B = KB + ((size_t)(u.pm >> 3) * NMEM * D + (size_t)u.pn * HD) * 2; return true; } };
        SchedQK S{G, bx, (const char*)Q, (const char*)KB};
        EpiSoftmax E{PR, lds};
#ifndef NO_QK
        pg8::gemm_phase(lds, D, D, S, E);
#endif

#ifndef NO_SATT
        LAS float* sc = (LAS float*)lds;
        LAS float* pr = (LAS float*)(lds + 4096);
        LAS float* po = (LAS float*)(lds + 8192);
        for (int unit = bx; unit < BS * NH; unit += G) {
            const int b = unit / NH, h = unit % NH;
            float q[4][4];
#pragma unroll
            for (int qi = 0; qi < 4; ++qi) { const float* qp = PART + (size_t)(b * TS + qi) * D + h * HD + 4 * lane; const f32x4 w = (*(const f32x4*)qp + *(const f32x4*)(qp + (size_t)NS * D)) + (*(const f32x4*)(qp + (size_t)2 * NS * D) + *(const f32x4*)(qp + (size_t)3 * NS * D)); q[qi][0] = w[0]; q[qi][1] = w[1]; q[qi][2] = w[2]; q[qi][3] = w[3]; }
            const float* kbase = cache_k + ((size_t)(b * NMEM) * NH + h) * HD + 4 * lane;
            const float* vbase = cache_v + ((size_t)(b * NMEM) * NH + h) * HD + 4 * lane;
#pragma unroll 1
            for (int blk = 0; blk < 2; ++blk) {
                const int key0 = wave * 32 + blk * 16;
                float v[64];
#pragma unroll
                for (int k = 0; k < 16; ++k) { const f32x4 kv = *(const f32x4*)(kbase + (size_t)(key0 + k) * NH * HD);
#pragma unroll
                    for (int qi = 0; qi < 4; ++qi) v[k * 4 + qi] = (kv[0] * q[qi][0] + kv[1] * q[qi][1]) + (kv[2] * q[qi][2] + kv[3] * q[qi][3]); }
                const float s = treduce64(v, lane);
                sc[(lane & 3) * 256 + key0 + (lane >> 2)] = s;
            }
            __syncthreads();
            {
                const int qi = lane & 3, kb = lane >> 2; float sv[16]; float mx = -3.0e38f;
#pragma unroll
                for (int j = 0; j < 16; ++j) { sv[j] = sc[qi * 256 + kb + 16 * j]; mx = fmaxf(mx, sv[j]); }
                mx = fmaxf(mx, __shfl_xor(mx, 4)); mx = fmaxf(mx, __shfl_xor(mx, 8)); mx = fmaxf(mx, __shfl_xor(mx, 16)); mx = fmaxf(mx, __shfl_xor(mx, 32));
                float sum = 0.f;
#pragma unroll
                for (int j = 0; j < 16; ++j) { sv[j] = fast_exp(sv[j] - mx); sum += sv[j]; }
                sum += __shfl_xor(sum, 4); sum += __shfl_xor(sum, 8); sum += __shfl_xor(sum, 16); sum += __shfl_xor(sum, 32);
                const float inv = 1.0f / sum;
                if (wave == 0) {
#pragma unroll
                    for (int j = 0; j < 16; ++j) pr[qi * 256 + kb + 16 * j] = sv[j] * inv; }
            }
            __syncthreads();
            {
                float o[4][4];
#pragma unroll
                for (int qi = 0; qi < 4; ++qi) { o[qi][0] = 0.f; o[qi][1] = 0.f; o[qi][2] = 0.f; o[qi][3] = 0.f; }
#pragma unroll 8
                for (int k = 0; k < 32; ++k) { const int key = wave * 32 + k; const f32x4 vv = *(const f32x4*)(vbase + (size_t)key * NH * HD);
#pragma unroll
                    for (int qi = 0; qi < 4; ++qi) { const float pp = pr[qi * 256 + key]; o[qi][0] = fmaf(pp, vv[0], o[qi][0]); o[qi][1] = fmaf(pp, vv[1], o[qi][1]); o[qi][2] = fmaf(pp, vv[2], o[qi][2]); o[qi][3] = fmaf(pp, vv[3], o[qi][3]); } }
#pragma unroll
                for (int qi = 0; qi < 4; ++qi) *(LAS f32x4*)(po + (wave * 4 + qi) * 256 + 4 * lane) = (f32x4){o[qi][0], o[qi][1], o[qi][2], o[qi][3]};
            }
            __syncthreads();
            {
                const int idx = tid * 2, qi = idx >> 8, d = idx & 255; float a0 = 0.f, a1 = 0.f;
#pragma unroll
                for (int w = 0; w < 8; ++w) { const f32x2 t2 = *(LAS f32x2*)(po + (w * 4 + qi) * 256 + d); a0 += t2[0]; a1 += t2[1]; }
                *(unsigned*)(O + (size_t)(NP + b * TS + qi) * D + h * HD + d) = cvt_pk_bf16(a0, a1);
            }
        }
#endif
    }
    GSYNC();

    if (PH(11)) {
        struct SchedPV { int G, c; const char* PR; const char* VT;
            __device__ __forceinline__ bool next(int i, Unit& u) const { const int L = i * G + c; if (L >= 64 * NH) return false; pg8::order_map(L, 64, NH, u.pm, u.pn); u.kind = 0; u.nt = 4; u.ks = 0;
                u.A = PR + (size_t)(u.pm * NH + u.pn) * 256 * 256 * 2; u.B = VT + (size_t)((u.pm >> 3) * NH + u.pn) * HD * NMEM * 2; return true; } };
        SchedPV S{G, bx, (const char*)PR, (const char*)VT};
        EpiBf E{O, D, 1.0f};
        pg8::gemm_phase(lds, NMEM, NMEM, S, E);
    }
    GSYNC();

    if (PH(12)) {
        Sched2 S{G, bx, NP / 256, D / 256, 16, NS / 256, D / 256, 4, 4, NP / 256, (const char*)O, (const char*)WXO, (const char*)O, (const char*)WXO, (size_t)256 * D * 2, (size_t)256 * D * 2};
        EpiRes E{nullptr, X, PART, 0};
        pg8::gemm_phase(lds, D, D, S, E);
    }
    GSYNC();

    if (PH(13)) for (int m = gw; m < MT; m += NGW) { if (m >= NP) add_parts(X + (size_t)m * D, PART + (size_t)(m - NP) * D, 4, (size_t)NS * D, lane); rms_row_bf16(X + (size_t)m * D, IN(31), H + (size_t)m * D, lane); }
    GSYNC();

    if (PH(14)) {
        Sched2 S{G, bx, MT / 256, NUG / 256, 16, 0, 0, 4, 1, 0, (const char*)H, (const char*)WUG, nullptr, nullptr, (size_t)256 * D * 2, (size_t)256 * D * 2};
        EpiBf E{UG, NUG, 1.0f};
        pg8::gemm_phase(lds, D, D, S, E);
    }
    GSYNC();

    if (PH(15)) {
        const float* st_ffn = IN(8); const float* ffn_conv_w = IN(34);
        constexpr int NV = DFF / 8;
        const size_t total = (size_t)MT * NV;
        for (size_t idx = (size_t)bx * NTHREADS + tid; idx < total; idx += (size_t)G * NTHREADS) {
            const int r = (int)(idx / NV), c0 = (int)(idx % NV) * 8;
            int b, t, T; const float* prev; float* fout;
            if (r < NP) { b = r / TP; t = r % TP; prev = nullptr; fout = out + O_FP + (size_t)b * 2 * DFF; T = TP; }
            else { const int rs = r - NP; b = rs / TS; t = rs % TS; prev = st_ffn + (size_t)b * 2 * DFF; fout = out + O_FS + (size_t)b * 2 * DFF; T = TS; }
            float p[3][8];
#pragma unroll
            for (int k = 0; k < 3; ++k) {
                const int tt = t - k;
                if (tt >= 0) { const u32x4 uw = *(const u32x4*)(UG + (size_t)(r - k) * NUG + c0);
                    p[k][0] = bf_lo(uw.x); p[k][1] = bf_hi(uw.x); p[k][2] = bf_lo(uw.y); p[k][3] = bf_hi(uw.y); p[k][4] = bf_lo(uw.z); p[k][5] = bf_hi(uw.z); p[k][6] = bf_lo(uw.w); p[k][7] = bf_hi(uw.w); }
                else if (prev) { const float* pp = prev + (size_t)(2 + tt) * DFF + c0; const f32x4 a = *(const f32x4*)pp, bq = *(const f32x4*)(pp + 4);
                    p[k][0] = a[0]; p[k][1] = a[1]; p[k][2] = a[2]; p[k][3] = a[3]; p[k][4] = bq[0]; p[k][5] = bq[1]; p[k][6] = bq[2]; p[k][7] = bq[3]; }
                else {
#pragma unroll
                    for (int j = 0; j < 8; ++j) p[k][j] = 0.f; }
            }
            const u32x4 gw4 = *(const u32x4*)(UG + (size_t)r * NUG + DFF + c0);
            const float gt8[8] = {bf_lo(gw4.x), bf_hi(gw4.x), bf_lo(gw4.y), bf_hi(gw4.y), bf_lo(gw4.z), bf_hi(gw4.z), bf_lo(gw4.w), bf_hi(gw4.w)};
            float a8[8];
#pragma unroll
            for (int j = 0; j < 8; ++j) { const float w0 = ffn_conv_w[c0 + j], w1 = ffn_conv_w[DFF + c0 + j], w2 = ffn_conv_w[2 * DFF + c0 + j];
                a8[j] = gelu_tanh(w0 * p[2][j] + w1 * p[1][j] + w2 * p[0][j]) * gt8[j]; }
            u32x4 w; w.x = cvt_pk_bf16(a8[0], a8[1]); w.y = cvt_pk_bf16(a8[2], a8[3]); w.z = cvt_pk_bf16(a8[4], a8[5]); w.w = cvt_pk_bf16(a8[6], a8[7]);
            *(u32x4*)(ACT + (size_t)r * DFF + c0) = w;
            if (t >= T - 2) { float* fo = fout + (size_t)(t - (T - 2)) * DFF + c0; *(f32x4*)fo = (f32x4){p[0][0], p[0][1], p[0][2], p[0][3]}; *(f32x4*)(fo + 4) = (f32x4){p[0][4], p[0][5], p[0][6], p[0][7]}; }
        }
    }
    GSYNC();

    if (PH(16)) {
        Sched2 S{G, bx, NP / 256, D / 256, DFF / 64, NS / 256, D / 256, 4, DFF / 256, NP / 256, (const char*)ACT, (const char*)WDN, (const char*)ACT, (const char*)WDN, (size_t)256 * DFF * 2, (size_t)256 * DFF * 2};
        EpiRes E{nullptr, X, PART, 0};
        pg8::gemm_phase(lds, DFF, DFF, S, E);
    }
    GSYNC();

    if (PH(17)) for (int m = gw; m < MT; m += NGW) { if (m >= NP) add_parts(X + (size_t)m * D, PART + (size_t)(m - NP) * D, DFF / 256, (size_t)NS * D, lane); rms_row_f32(X + (size_t)m * D, IN(36), out + (size_t)m * D, lane); }
}

extern "C" void kernel_launch(void* const* d_in, const int* in_sizes, int n_in, void* d_out, int out_size, void* d_ws, size_t ws_size, hipStream_t stream) {
    static int grid = 0;
    if (grid == 0) {
        if (n_in != 37 || (size_t)out_size != O_END || ws_size < WS_END) { fprintf(stderr, "kernel_launch: unexpected sizes n_in %d out %d ws %zu\n", n_in, out_size, ws_size); grid = -1; return; }
        int dev = 0, cus = 0, per_cu = 0;
        (void)hipGetDevice(&dev); (void)hipDeviceGetAttribute(&cus, hipDeviceAttributeMultiprocessorCount, dev);
        (void)hipFuncSetAttribute((const void*)hymba_fwd, hipFuncAttributeMaxDynamicSharedMemorySize, LDS_BYTES);
        (void)hipOccupancyMaxActiveBlocksPerMultiprocessor(&per_cu, (const void*)hymba_fwd, NTHREADS, LDS_BYTES);
        if (per_cu < 1) { fprintf(stderr, "kernel_launch: occupancy query reports %d blocks per CU\n", per_cu); per_cu = 1; }
        (void)hipGetLastError();
        grid = cus;
        if (grid % 8) grid -= grid % 8;
    }
    if (grid < 0) return;
    Args a{};
    for (int i = 0; i < 37; ++i) a.in[i] = (const float*)d_in[i];
    a.out = (float*)d_out; a.ws = (unsigned char*)d_ws;
    void* kargs[] = {&a};
    hipError_t e = hipLaunchCooperativeKernel((const void*)hymba_fwd, dim3(grid), dim3(NTHREADS), kargs, LDS_BYTES, stream);
    if (e != hipSuccess) fprintf(stderr, "cooperative launch failed: %s (grid %d)\n", hipGetErrorString(e), grid);
}
```

```cpp
#include <hip/hip_runtime.h>
#include <hip/hip_cooperative_groups.h>
#include <cstdio>
#include <cstdint>
namespace cg = cooperative_groups;

#define LAS __attribute__((address_space(3)))
typedef unsigned short bf16_t;
typedef short bf16x8 __attribute__((ext_vector_type(8)));
typedef float f32x4 __attribute__((ext_vector_type(4)));
typedef float f32x2 __attribute__((ext_vector_type(2)));
typedef unsigned u32x4 __attribute__((ext_vector_type(4)));
typedef unsigned u32x2 __attribute__((ext_vector_type(2)));

constexpr int D = 1024, NP = 16384, NS = 512, MT = NP + NS;
constexpr int TP = 2048, TS = 4, BP = 8, BS = 128;
constexpr int NZ = 2048, MIX = 512, DFF = 2816, NUG = 2 * DFF;
constexpr int SG = 32, SP = 16, SN = 64, LCH = 64, NCH = TP / LCH;
constexpr int NMEM = 256, NH = 4, HD = 256;
constexpr float EPS = 1e-6f;
constexpr int NWAVES = 8, NTHREADS = 512;

constexpr size_t MiB = 1u << 20;
constexpr size_t WS_WIN = 0;
constexpr size_t WS_WKV = WS_WIN + 4 * MiB;
constexpr size_t WS_WGLU = WS_WKV + 4 * MiB;
constexpr size_t WS_WOUT = WS_WGLU + 1 * MiB;
constexpr size_t WS_WQ = WS_WOUT + 2 * MiB;
constexpr size_t WS_WXO = WS_WQ + 2 * MiB;
constexpr size_t WS_WUG = WS_WXO + 2 * MiB;
constexpr size_t WS_WDN = WS_WUG + 11 * MiB;
constexpr size_t WS_H = WS_WDN + 6 * MiB;
constexpr size_t WS_X = WS_H + 33 * MiB;
constexpr size_t WS_OV = WS_X + 66 * MiB;
constexpr size_t WS_Z = WS_OV;
constexpr size_t WS_YG = WS_Z + 66 * MiB;
constexpr size_t WS_YS = WS_YG + 17 * MiB;
constexpr size_t WS_MIXN = WS_YS + 33 * MiB;
constexpr size_t WS_Q = WS_MIXN + 33 * MiB;
constexpr size_t WS_PR = WS_Q + 33 * MiB;
constexpr size_t WS_O = WS_PR + 32 * MiB;
constexpr size_t WS_MN = WS_O + 33 * MiB;
constexpr size_t WS_KB = WS_MN + 4 * MiB;
constexpr size_t WS_VT = WS_KB + 4 * MiB;
constexpr size_t WS_SE = WS_VT + 4 * MiB;
constexpr size_t WS_SI = WS_SE + 4 * MiB;
constexpr size_t WS_BB = WS_SI + 4 * MiB;
constexpr size_t WS_AT = WS_BB + 1 * MiB;
constexpr size_t WS_BTR = WS_AT + 1 * MiB;
constexpr size_t WS_BTI = WS_BTR + 65536;
constexpr size_t WS_CT = WS_BTI + 65536;
constexpr size_t WS_OV_END1 = WS_CT + 131072;
constexpr size_t WS_UG = WS_OV;
constexpr size_t WS_ACT = WS_UG + 182 * MiB;
constexpr size_t WS_CTL = WS_ACT + 91 * MiB;
constexpr size_t WS_PART = WS_CTL + 1 * MiB;
constexpr size_t WS_SSQ = WS_PART + 22 * MiB;
constexpr size_t WS_END = WS_SSQ + 1 * MiB;
static_assert(WS_OV_END1 <= WS_CTL, "overlay");
static_assert(WS_END <= 512 * MiB, "workspace");

constexpr size_t O_YP = 0;
constexpr size_t O_YS = O_YP + (size_t)NP * D;
constexpr size_t O_MK = O_YS + (size_t)NS * D;
constexpr size_t O_MV = O_MK + (size_t)BP * NMEM * D;
constexpr size_t O_SRP = O_MV + (size_t)BP * NMEM * D;
constexpr size_t O_SIP = O_SRP + (size_t)BP * SG * SN;
constexpr size_t O_CP = O_SIP + (size_t)BP * SG * SN;
constexpr size_t O_FP = O_CP + (size_t)BP * 2 * MIX;
constexpr size_t O_SRS = O_FP + (size_t)BP * 2 * DFF;
constexpr size_t O_SIS = O_SRS + (size_t)BS * SG * SN;
constexpr size_t O_CS = O_SIS + (size_t)BS * SG * SN;
constexpr size_t O_FS = O_CS + (size_t)BS * 2 * MIX;
constexpr size_t O_END = O_FS + (size_t)BS * 2 * DFF;

constexpr int RING_BYTES = 131072, XCH_OFF = RING_BYTES, LDS_BYTES = 147456;

typedef __bf16 bf16x2_t __attribute__((ext_vector_type(2)));
__device__ __forceinline__ unsigned cvt_pk_bf16(float lo, float hi) { const f32x2 v = {lo, hi}; const bf16x2_t b = __builtin_convertvector(v, bf16x2_t); return __builtin_bit_cast(unsigned, b); }
__device__ __forceinline__ float bf_lo(unsigned w) { return __uint_as_float(w << 16); }
__device__ __forceinline__ float bf_hi(unsigned w) { return __uint_as_float(w & 0xffff0000u); }
__device__ __forceinline__ float wave_sum(float v) {
#pragma unroll
    for (int o = 1; o < 64; o <<= 1) v += __shfl_xor(v, o);
    return v;
}
__device__ __forceinline__ float fast_exp(float x) { return __builtin_amdgcn_exp2f(x * 1.4426950408889634f); }
__device__ __forceinline__ float gelu_tanh(float x) {
    const float z = 0.7978845608028654f * (x + 0.044715f * x * x * x);
    return x * __builtin_amdgcn_rcpf(1.0f + fast_exp(-2.0f * z));
}
__device__ __forceinline__ float sigmoidf(float a) { return __builtin_amdgcn_rcpf(1.0f + fast_exp(-a)); }

namespace pg8 {
constexpr int BM = 256, BK = 64, HALF = 128, HTB = HALF * BK * 2;
__host__ __device__ __forceinline__ int lds_byte(int r, int c) { const int st = (r >> 4) * 2 + (c >> 5), rr = r & 15, cc = c & 31, ob = rr * 64 + cc * 2; return st * 1024 + (ob ^ (((ob >> 9) & 1) << 5)); }
__host__ __device__ __forceinline__ void stage_rc(int b, int& R, int& C) { const int st = b / 1024, sb = b % 1024, swz = sb ^ (((sb >> 9) & 1) << 5); R = (st >> 1) * 16 + swz / 64; C = (st & 1) * 32 + (swz % 64) / 2; }
__host__ __device__ __forceinline__ int perm32(int rho) { const int n = rho >> 4, i = rho & 15; return 8 * (i >> 2) + 4 * n + (i & 3); }

struct Unit { int pm, pn, kind, nt, ks; const char* A; const char* B; };

__device__ __forceinline__ void order_map(int L, int nM, int nN, int& pm, int& pn) {
    const int nwg = nM * nN; int wgid = L;
    { const int q = nwg / 8, r = nwg % 8, xcd = wgid % 8, off = wgid / 8; wgid = (xcd < r ? xcd * (q + 1) : r * (q + 1) + (xcd - r) * q) + off; }
    const int nig = 8 * nN, gid = wgid / nig, fm = gid * 8, gsz = (nM - fm) < 8 ? (nM - fm) : 8;
    pm = fm + ((wgid % nig) % gsz); pn = (wgid % nig) / gsz;
}

template <class Epi, class Sched>
__device__ __forceinline__ void gemm_phase(LAS unsigned char* lds, const int lda, const int ldb, const Sched& S, Epi& E) {
    int tid_l = threadIdx.x; asm volatile("" : "+v"(tid_l));
    const int tid = tid_l, wid = __builtin_amdgcn_readfirstlane(tid >> 6), lane = tid & 63, wr = wid >> 2, wc = wid & 3, fr = lane & 15, fq = lane >> 4;
    unsigned voffA[2], voffB[2];
#pragma unroll
    for (int i = 0; i < 2; ++i) { int R, C; stage_rc(tid * 16 + i * 8192, R, C); const int Rb = (R & ~31) + perm32(R & 31);
        voffA[i] = (unsigned)(R * lda + C) * 2u; voffB[i] = (unsigned)(Rb * ldb + C) * 2u; }
    const size_t kstep = (size_t)(BK * 2);
    const size_t hstepA = (size_t)HALF * lda * 2, hstepB = (size_t)HALF * ldb * 2;
    const unsigned ldsw = (unsigned)wid * 1024u;
    const int aoff = lds_byte(wr * 64 + fr, fq * 8), boff = lds_byte(wc * 32 + fr, fq * 8);
#define PG8_SA(b, h) (((b) * 2 + (h)) * HTB)
#define PG8_SB(b, h) ((4 + (b) * 2 + (h)) * HTB)
#define PG8_STAGE(bufoff, gbase, voff) do { _Pragma("unroll") for (int _i = 0; _i < 2; ++_i) \
        __builtin_amdgcn_global_load_lds((const unsigned*)((const char*)(gbase) + (voff)[_i]), (LAS unsigned*)(lds + (bufoff) + ldsw + _i * 8192), 16, 0, 0); } while (0)
#define PG8_LDA(dst, b, h) do { _Pragma("unroll") for (int m = 0; m < 4; ++m) _Pragma("unroll") for (int k = 0; k < 2; ++k) dst[m][k] = *(const LAS bf16x8*)(lds + PG8_SA(b, h) + aoff + m * 2048 + k * 1024); } while (0)
#define PG8_LDB(dst, b, h) do { _Pragma("unroll") for (int n = 0; n < 2; ++n) _Pragma("unroll") for (int k = 0; k < 2; ++k) dst[n][k] = *(const LAS bf16x8*)(lds + PG8_SB(b, h) + boff + n * 2048 + k * 1024); } while (0)
#define PG8_MMA(ai, bj, At, Bt) do { __builtin_amdgcn_s_setprio(1); _Pragma("unroll") for (int m = 0; m < 4; ++m) _Pragma("unroll") for (int n = 0; n < 2; ++n) _Pragma("unroll") for (int k = 0; k < 2; ++k) \
        acc[ai][bj][m][n] = __builtin_amdgcn_mfma_f32_16x16x32_bf16(Bt[n][k], At[m][k], acc[ai][bj][m][n], 0, 0, 0); __builtin_amdgcn_s_setprio(0); } while (0)
#define PG8_WAIT_V(n) asm volatile("s_waitcnt vmcnt(" #n ")" ::: "memory")
#define PG8_WAIT_L(n) asm volatile("s_waitcnt lgkmcnt(" #n ")" ::: "memory")
#define PG8_BAR __builtin_amdgcn_s_barrier()
#define PG8_SCHED __builtin_amdgcn_sched_barrier(0)
    Unit cur, nxt; int ui = 0;
    if (!S.next(0, cur)) return;
    f32x4 acc[2][2][4][2];
#pragma unroll
    for (int a = 0; a < 2; ++a)
#pragma unroll
        for (int b = 0; b < 2; ++b)
#pragma unroll
            for (int m = 0; m < 4; ++m)
#pragma unroll
                for (int n = 0; n < 2; ++n) acc[a][b][m][n] = (f32x4){0.f, 0.f, 0.f, 0.f};
    bf16x8 At[4][2], B0[2][2], B1[2][2];
    const char* cA = cur.A; const char* cB = cur.B;
    PG8_STAGE(PG8_SB(0, 0), cB, voffB); PG8_STAGE(PG8_SB(0, 1), cB + hstepB, voffB); PG8_STAGE(PG8_SA(0, 0), cA, voffA); PG8_STAGE(PG8_SA(0, 1), cA + hstepA, voffA);
    if (wr == 1) PG8_BAR;
    PG8_WAIT_V(2); PG8_BAR;
    PG8_STAGE(PG8_SB(1, 0), cB + kstep, voffB); PG8_STAGE(PG8_SA(1, 0), cA + kstep, voffA); PG8_STAGE(PG8_SB(1, 1), cB + hstepB + kstep, voffB);
    PG8_WAIT_V(6); PG8_BAR;
    for (;;) {
        const bool has_next = S.next(ui + 1, nxt);
        const char* nA = has_next ? nxt.A : cA; const char* nB = has_next ? nxt.B : cB;
        const int nt = cur.nt;
#pragma unroll 1
        for (int t = 0; t < nt; t += 2) {
            const bool last = (t == nt - 2);
            const char* a1 = cA + (size_t)(t + 1) * kstep;
            const char* a2 = last ? nA : cA + (size_t)(t + 2) * kstep; const char* b2 = last ? nB : cB + (size_t)(t + 2) * kstep;
            const char* a3 = a2 + kstep; const char* b3 = b2 + kstep;
            PG8_LDB(B0, 0, 0); PG8_LDB(B1, 0, 1); PG8_SCHED; PG8_LDA(At, 0, 0); PG8_STAGE(PG8_SA(1, 1), a1 + hstepA, voffA);
            PG8_WAIT_V(8); PG8_WAIT_L(0); PG8_BAR; PG8_MMA(0, 0, At, B0); PG8_MMA(0, 1, At, B1); PG8_BAR; PG8_SCHED;
            PG8_LDA(At, 0, 1); PG8_STAGE(PG8_SB(0, 0), b2, voffB); PG8_STAGE(PG8_SB(0, 1), b2 + hstepB, voffB); PG8_STAGE(PG8_SA(0, 0), a2, voffA);
            PG8_WAIT_V(8); PG8_WAIT_L(0); PG8_BAR; PG8_MMA(1, 0, At, B0); PG8_MMA(1, 1, At, B1); PG8_BAR; PG8_SCHED;
            PG8_LDB(B0, 1, 0); PG8_LDB(B1, 1, 1); PG8_SCHED; PG8_LDA(At, 1, 0); PG8_STAGE(PG8_SA(0, 1), a2 + hstepA, voffA);
            PG8_WAIT_V(8); PG8_WAIT_L(0); PG8_BAR; PG8_MMA(0, 0, At, B0); PG8_MMA(0, 1, At, B1); PG8_BAR; PG8_SCHED;
            PG8_LDA(At, 1, 1); PG8_STAGE(PG8_SB(1, 0), b3, voffB); PG8_STAGE(PG8_SB(1, 1), b3 + hstepB, voffB); PG8_STAGE(PG8_SA(1, 0), a3, voffA);
            PG8_WAIT_V(8); PG8_WAIT_L(0); PG8_BAR; PG8_MMA(1, 0, At, B0); PG8_MMA(1, 1, At, B1); PG8_BAR; PG8_SCHED;
        }
        if (wr == 0) PG8_BAR;
        E(acc, cur, wr, wc, fr, fq);
        if (!has_next) break;
#pragma unroll
        for (int a = 0; a < 2; ++a)
#pragma unroll
            for (int b = 0; b < 2; ++b)
#pragma unroll
                for (int m = 0; m < 4; ++m)
#pragma unroll
                    for (int n = 0; n < 2; ++n) acc[a][b][m][n] = (f32x4){0.f, 0.f, 0.f, 0.f};
        cur = nxt; cA = nA; cB = nB; ++ui;
        if (wr == 1) PG8_BAR;
    }
    PG8_WAIT_V(0);
    PG8_BAR;
#undef PG8_SA
#undef PG8_SB
#undef PG8_STAGE
#undef PG8_LDA
#undef PG8_LDB
#undef PG8_MMA
#undef PG8_WAIT_V
#undef PG8_WAIT_L
#undef PG8_BAR
#undef PG8_SCHED
}
}
using pg8::Unit;
typedef f32x4 Acc[2][2][4][2];

struct Sched2 {
    int G, c; int nM0, nN0, nt0, nM1, nN1, nt1, ks1, pm1;
    const char* A0; const char* B0; const char* A1; const char* B1; size_t a_pm, b_pn;
    __device__ __forceinline__ bool next(int i, Unit& u) const {
        const int L = i * G + c, n0 = nM0 * nN0, n1 = nM1 * nN1 * ks1;
        if (L >= n0 + n1) return false;
        if (L < n0) { pg8::order_map(L, nM0, nN0, u.pm, u.pn); u.kind = 0; u.nt = nt0; u.ks = 0; u.A = A0 + (size_t)u.pm * a_pm; u.B = B0 + (size_t)u.pn * b_pn; }
        else { const int j = L - n0, ks = j % ks1, t = j / ks1; u.pm = pm1 + t % nM1; u.pn = t / nM1; u.kind = 1; u.nt = nt1; u.ks = ks;
               u.A = A1 + (size_t)u.pm * a_pm + (size_t)ks * nt1 * 128; u.B = B1 + (size_t)u.pn * b_pn + (size_t)ks * nt1 * 128; }
        return true;
    }
};

#define EPI_ROWS(...) _Pragma("unroll") for (int ai = 0; ai < 2; ++ai) _Pragma("unroll") for (int m = 0; m < 4; ++m) { const int row = u.pm * 256 + ai * 128 + wr * 64 + m * 16 + fr; \
    _Pragma("unroll") for (int bj = 0; bj < 2; ++bj) { const int col = u.pn * 256 + bj * 128 + wc * 32 + fq * 8; const f32x4 v0 = acc[ai][bj][m][0], v1 = acc[ai][bj][m][1]; __VA_ARGS__ } }

__device__ __forceinline__ u32x4 pack8(f32x4 v0, f32x4 v1) { u32x4 w; w.x = cvt_pk_bf16(v0[0], v0[1]); w.y = cvt_pk_bf16(v0[2], v0[3]); w.z = cvt_pk_bf16(v1[0], v1[1]); w.w = cvt_pk_bf16(v1[2], v1[3]); return w; }

struct EpiP1 {
    bf16_t* Z; float* outK; float* outV; bf16_t* KB; bf16_t* VT;
    __device__ __forceinline__ void operator()(Acc& acc, const Unit& u, int wr, int wc, int fr, int fq) const {
        if (u.kind == 0) {
            EPI_ROWS( *(u32x4*)(Z + (size_t)row * NZ + col) = pack8(v0, v1); )
        } else if (u.pn < 4) {
            EPI_ROWS( float* o = outK + (size_t)row * D + col; *(f32x4*)o = v0; *(f32x4*)(o + 4) = v1; *(u32x4*)(KB + (size_t)row * D + col) = pack8(v0, v1); )
        } else {
            EPI_ROWS( const int vc = col - 1024; float* o = outV + (size_t)row * D + vc; *(f32x4*)o = v0; *(f32x4*)(o + 4) = v1;
                      const int h = vc >> 8, d0 = vc & 255, key = row & 255; bf16_t* vt = VT + ((size_t)(u.pm * NH + h) * HD + d0) * NMEM + key;
                      const u32x4 w = pack8(v0, v1);
                      vt[0 * NMEM] = (bf16_t)(w.x & 0xffff); vt[1 * NMEM] = (bf16_t)(w.x >> 16); vt[2 * NMEM] = (bf16_t)(w.y & 0xffff); vt[3 * NMEM] = (bf16_t)(w.y >> 16);
                      vt[4 * NMEM] = (bf16_t)(w.z & 0xffff); vt[5 * NMEM] = (bf16_t)(w.z >> 16); vt[6 * NMEM] = (bf16_t)(w.w & 0xffff); vt[7 * NMEM] = (bf16_t)(w.w >> 16); )
        }
    }
};
struct EpiGlu {
    const bf16_t* YG; const float* bias; float* YS;
    __device__ __forceinline__ void operator()(Acc& acc, const Unit& u, int wr, int wc, int fr, int fq) const {
        EPI_ROWS( const u32x4 yw = *(const u32x4*)(YG + (size_t)row * MIX + col); const f32x4 b0 = *(const f32x4*)(bias + col), b1 = *(const f32x4*)(bias + col + 4);
                  f32x4 o0, o1;
                  o0[0] = bf_lo(yw.x) * sigmoidf(v0[0] + b0[0]); o0[1] = bf_hi(yw.x) * sigmoidf(v0[1] + b0[1]); o0[2] = bf_lo(yw.y) * sigmoidf(v0[2] + b0[2]); o0[3] = bf_hi(yw.y) * sigmoidf(v0[3] + b0[3]);
                  o1[0] = bf_lo(yw.z) * sigmoidf(v1[0] + b1[0]); o1[1] = bf_hi(yw.z) * sigmoidf(v1[1] + b1[1]); o1[2] = bf_lo(yw.w) * sigmoidf(v1[2] + b1[2]); o1[3] = bf_hi(yw.w) * sigmoidf(v1[3] + b1[3]);
                  float* o = YS + (size_t)row * MIX + col; *(f32x4*)o = o0; *(f32x4*)(o + 4) = o1; )
    }
};
struct EpiRes {
    const float* xp; float* X; float* PART; int first; bf16_t* Hn; const float* g; float* ssq;
    __device__ __forceinline__ void operator()(Acc& acc, const Unit& u, int wr, int wc, int fr, int fq) const {
        if (u.kind == 0) {
            f32x4 gv[2][2];
            if (Hn) {
#pragma unroll
                for (int bj = 0; bj < 2; ++bj) { const int col = u.pn * 256 + bj * 128 + wc * 32 + fq * 8; gv[bj][0] = *(const f32x4*)(g + col); gv[bj][1] = *(const f32x4*)(g + col + 4); }
            }
#pragma unroll
            for (int ai = 0; ai < 2; ++ai)
#pragma unroll
                for (int m = 0; m < 4; ++m) { const int row = u.pm * 256 + ai * 128 + wr * 64 + m * 16 + fr; float ss = 0.f;
#pragma unroll
                    for (int bj = 0; bj < 2; ++bj) { const int col = u.pn * 256 + bj * 128 + wc * 32 + fq * 8;
                        const float* b = first ? xp + (size_t)row * D : (const float*)(X + (size_t)row * D);
                        const f32x4 r0 = *(const f32x4*)(b + col) + acc[ai][bj][m][0], r1 = *(const f32x4*)(b + col + 4) + acc[ai][bj][m][1];
                        float* o = X + (size_t)row * D + col; *(f32x4*)o = r0; *(f32x4*)(o + 4) = r1;
                        if (Hn) { *(u32x4*)(Hn + (size_t)row * D + col) = pack8(r0 * gv[bj][0], r1 * gv[bj][1]);
                            ss += (r0[0] * r0[0] + r0[1] * r0[1]) + (r0[2] * r0[2] + r0[3] * r0[3]) + (r1[0] * r1[0] + r1[1] * r1[1]) + (r1[2] * r1[2] + r1[3] * r1[3]); } }
                    if (Hn) { ss += __shfl_xor(ss, 16); ss += __shfl_xor(ss, 32); if (fq == 0) unsafeAtomicAdd(ssq + row, ss); }
                    asm volatile("" ::: "memory"); }
        } else {
            EPI_ROWS( float* o = PART + ((size_t)u.ks * NS + (row - NP)) * D + col; *(f32x4*)o = v0; *(f32x4*)(o + 4) = v1; )
        }
    }
};
struct EpiQ {
    bf16_t* Q; float* PART; const float* ssq;
    __device__ __forceinline__ void operator()(Acc& acc, const Unit& u, int wr, int wc, int fr, int fq) const {
        if (u.kind == 0) {
#pragma unroll
            for (int ai = 0; ai < 2; ++ai)
#pragma unroll
                for (int m = 0; m < 4; ++m) { const int row = u.pm * 256 + ai * 128 + wr * 64 + m * 16 + fr; const float sc = 0.0625f / sqrtf(ssq[row] * (1.0f / D) + EPS);
#pragma unroll
                    for (int bj = 0; bj < 2; ++bj) { const int col = u.pn * 256 + bj * 128 + wc * 32 + fq * 8; *(u32x4*)(Q + (size_t)row * D + col) = pack8(acc[ai][bj][m][0] * sc, acc[ai][bj][m][1] * sc); } }
        } else {
            EPI_ROWS( float* o = PART + ((size_t)u.ks * NS + (row - NP)) * D + col; *(f32x4*)o = v0 * 0.0625f; *(f32x4*)(o + 4) = v1 * 0.0625f; )
        }
    }
};
struct EpiBf {
    bf16_t* O; int ld; float scale; const float* ssq;
    __device__ __forceinline__ void operator()(Acc& acc, const Unit& u, int wr, int wc, int fr, int fq) const {
#pragma unroll
        for (int ai = 0; ai < 2; ++ai)
#pragma unroll
            for (int m = 0; m < 4; ++m) { const int row = u.pm * 256 + ai * 128 + wr * 64 + m * 16 + fr;
                const float sc = (ssq && row < NP) ? scale / sqrtf(ssq[row] * (1.0f / D) + EPS) : scale;
#pragma unroll
                for (int bj = 0; bj < 2; ++bj) { const int col = u.pn * 256 + bj * 128 + wc * 32 + fq * 8; *(u32x4*)(O + (size_t)row * ld + col) = pack8(acc[ai][bj][m][0] * sc, acc[ai][bj][m][1] * sc); } }
    }
};
struct EpiSoftmax {
    bf16_t* PR; LAS unsigned char* lds;
    __device__ __forceinline__ void operator()(Acc& acc, const Unit& u, int wr, int wc, int fr, int fq) const {
        LAS f32x2* X = (LAS f32x2*)(lds + XCH_OFF);
#pragma unroll
        for (int ai = 0; ai < 2; ++ai)
#pragma unroll
            for (int m = 0; m < 4; ++m) {
                float mx = -3.0e38f;
#pragma unroll
                for (int bj = 0; bj < 2; ++bj)
#pragma unroll
                    for (int n = 0; n < 2; ++n) { const f32x4 x = acc[ai][bj][m][n]; mx = fmaxf(mx, fmaxf(fmaxf(x[0], x[1]), fmaxf(x[2], x[3]))); }
                mx = fmaxf(mx, __shfl_xor(mx, 16)); mx = fmaxf(mx, __shfl_xor(mx, 32));
                float s = 0.f;
#pragma unroll
                for (int bj = 0; bj < 2; ++bj)
#pragma unroll
                    for (int n = 0; n < 2; ++n) { f32x4 x = acc[ai][bj][m][n];
                        x[0] = fast_exp(x[0] - mx); x[1] = fast_exp(x[1] - mx); x[2] = fast_exp(x[2] - mx); x[3] = fast_exp(x[3] - mx);
                        s += (x[0] + x[1]) + (x[2] + x[3]); acc[ai][bj][m][n] = x; }
                s += __shfl_xor(s, 16); s += __shfl_xor(s, 32);
                if (fq == 0) X[(ai * 128 + wr * 64 + m * 16 + fr) * 4 + wc] = (f32x2){mx, s};
            }
        asm volatile("s_waitcnt lgkmcnt(0)" ::: "memory"); __builtin_amdgcn_s_barrier(); asm volatile("" ::: "memory");
#pragma unroll
        for (int ai = 0; ai < 2; ++ai)
#pragma unroll
            for (int m = 0; m < 4; ++m) {
                const int rl = ai * 128 + wr * 64 + m * 16 + fr;
                const f32x2 a = X[rl * 4 + 0], b = X[rl * 4 + 1], c = X[rl * 4 + 2], d = X[rl * 4 + 3];
                const float M = fmaxf(fmaxf(a.x, b.x), fmaxf(c.x, d.x));
                const float tot = a.y * fast_exp(a.x - M) + b.y * fast_exp(b.x - M) + c.y * fast_exp(c.x - M) + d.y * fast_exp(d.x - M);
                const float own = wc == 0 ? a.x : (wc == 1 ? b.x : (wc == 2 ? c.x : d.x));
                const float f = fast_exp(own - M) / tot;
                bf16_t* prow = PR + ((size_t)(u.pm * NH + u.pn) * 256 + rl) * 256;
#pragma unroll
                for (int bj = 0; bj < 2; ++bj) { const int col = bj * 128 + wc * 32 + fq * 8; *(u32x4*)(prow + col) = pack8(acc[ai][bj][m][0] * f, acc[ai][bj][m][1] * f); }
                asm volatile("" ::: "memory");
            }
    }
};

#ifndef ONLY
#define ONLY -1
#endif
#define PH(k) (ONLY < 0 || ONLY == (k))
#define GSYNC() xcd_barrier(xb)
struct Args { const float* in[37]; float* out; unsigned char* ws; };

__device__ __forceinline__ void transpose_item(const float* W, int K, int N, bf16_t* WT, int row_off, LAS float* scr, int item, int lane) {
    const int nblk = N / 32, kb = item / nblk, nb = item % nblk, k0 = 64 * kb, n0 = 32 * nb;
#pragma unroll 8
    for (int i = 0; i < 32; ++i) { const int kk = 2 * i + (lane >> 5); scr[kk * 33 + (lane & 31)] = W[(size_t)(k0 + kk) * N + n0 + (lane & 31)]; }
    asm volatile("s_waitcnt lgkmcnt(0)" ::: "memory");
    const int c = lane & 7;
#pragma unroll
    for (int j = 0; j < 4; ++j) { const int n = (lane >> 3) + 8 * j; const LAS float* s = scr + (8 * c) * 33 + n;
        u32x4 o; o.x = cvt_pk_bf16(s[0 * 33], s[1 * 33]); o.y = cvt_pk_bf16(s[2 * 33], s[3 * 33]); o.z = cvt_pk_bf16(s[4 * 33], s[5 * 33]); o.w = cvt_pk_bf16(s[6 * 33], s[7 * 33]);
        *(u32x4*)(WT + (size_t)(row_off + n0 + n) * K + k0 + 8 * c) = o; }
    asm volatile("s_waitcnt lgkmcnt(0)" ::: "memory");
}

__device__ __forceinline__ void add_parts(float* xrow, const float* part, int nparts, size_t pstride, int lane) {
    f32x4* xr = (f32x4*)xrow + lane; f32x4 v[4];
#pragma unroll
    for (int j = 0; j < 4; ++j) v[j] = xr[64 * j];
    for (int k = 0; k < nparts; ++k) { const f32x4* pr = (const f32x4*)(part + (size_t)k * pstride) + lane;
#pragma unroll
        for (int j = 0; j < 4; ++j) v[j] += pr[64 * j]; }
#pragma unroll
    for (int j = 0; j < 4; ++j) xr[64 * j] = v[j];
}
__device__ __forceinline__ void rms_row_bf16(const float* xrow, const float* g, bf16_t* orow, int lane) {
    const f32x4* xr = (const f32x4*)xrow + lane; f32x4 v[4]; float s = 0.f;
#pragma unroll
    for (int j = 0; j < 4; ++j) { v[j] = xr[64 * j]; s += (v[j][0] * v[j][0] + v[j][1] * v[j][1]) + (v[j][2] * v[j][2] + v[j][3] * v[j][3]); }
    const float rstd = 1.0f / sqrtf(wave_sum(s) * (1.0f / D) + EPS);
    u32x2* o8 = (u32x2*)orow + lane;
#pragma unroll
    for (int j = 0; j < 4; ++j) { const f32x4 gg = ((const f32x4*)g)[lane + 64 * j]; u32x2 w; w.x = cvt_pk_bf16(v[j][0] * rstd * gg[0], v[j][1] * rstd * gg[1]); w.y = cvt_pk_bf16(v[j][2] * rstd * gg[2], v[j][3] * rstd * gg[3]); o8[64 * j] = w; }
}
__device__ __forceinline__ void rms_row_f32(const float* xrow, const float* g, float* orow, int lane) {
    const f32x4* xr = (const f32x4*)xrow + lane; f32x4 v[4]; float s = 0.f;
#pragma unroll
    for (int j = 0; j < 4; ++j) { v[j] = xr[64 * j]; s += (v[j][0] * v[j][0] + v[j][1] * v[j][1]) + (v[j][2] * v[j][2] + v[j][3] * v[j][3]); }
    const float rstd = 1.0f / sqrtf(wave_sum(s) * (1.0f / D) + EPS);
#pragma unroll
    for (int j = 0; j < 4; ++j) { const f32x4 gg = ((const f32x4*)g)[lane + 64 * j]; ((f32x4*)orow)[lane + 64 * j] = v[j] * rstd * gg; }
}

__device__ __forceinline__ float treduce16(float (&v)[16], int lane) {
    { const bool hi = lane & 32;
#pragma unroll
      for (int i = 0; i < 8; ++i) { const float send = hi ? v[i] : v[i + 8], keep = hi ? v[i + 8] : v[i]; v[i] = keep + __shfl_xor(send, 32); } }
    { const bool hi = lane & 16;
#pragma unroll
      for (int i = 0; i < 4; ++i) { const float send = hi ? v[i] : v[i + 4], keep = hi ? v[i + 4] : v[i]; v[i] = keep + __shfl_xor(send, 16); } }
    { const bool hi = lane & 8;
#pragma unroll
      for (int i = 0; i < 2; ++i) { const float send = hi ? v[i] : v[i + 2], keep = hi ? v[i + 2] : v[i]; v[i] = keep + __shfl_xor(send, 8); } }
    { const bool hi = lane & 4; const float send = hi ? v[0] : v[1], keep = hi ? v[1] : v[0]; v[0] = keep + __shfl_xor(send, 4); }
    v[0] += __shfl_xor(v[0], 2); v[0] += __shfl_xor(v[0], 1);
    return v[0];
}
template <int W> __device__ __forceinline__ void tr_step(float (&v)[64], int lane) {
    const bool hi = lane & W;
#pragma unroll
    for (int i = 0; i < W; ++i) { const float send = hi ? v[i] : v[i + W], keep = hi ? v[i + W] : v[i]; v[i] = keep + __shfl_xor(send, W); }
}
__device__ __forceinline__ float treduce64(float (&v)[64], int lane) {
    tr_step<32>(v, lane); tr_step<16>(v, lane); tr_step<8>(v, lane); tr_step<4>(v, lane); tr_step<2>(v, lane); tr_step<1>(v, lane);
    return v[0];
}

template <bool WITH_Y>
__device__ __forceinline__ void ssm_tile(const bf16_t* zu, int nsteps, float& sr, float& si, const float* BB, const float* AT, const float* Cre, const float* Cim, const float* Dv,
                                         int g, bf16_t* yg, int lane) {
    float Br[16], Bi[16];
    { const f32x4* bp = (const f32x4*)(BB + (size_t)(g * SN + lane) * 32);
#pragma unroll
      for (int j = 0; j < 4; ++j) { const f32x4 a = bp[j], b = bp[4 + j]; Br[4 * j] = a[0]; Br[4 * j + 1] = a[1]; Br[4 * j + 2] = a[2]; Br[4 * j + 3] = a[3]; Bi[4 * j] = b[0]; Bi[4 * j + 1] = b[1]; Bi[4 * j + 2] = b[2]; Bi[4 * j + 3] = b[3]; } }
    const f32x4 at = *(const f32x4*)(AT + (size_t)(g * SN + lane) * 4); const float ar = at[0], ai = at[1];
    float Cr[16], Ci[16], Dm[16];
    if (WITH_Y) {
#pragma unroll
        for (int p = 0; p < 16; ++p) { Cr[p] = Cre[(size_t)(g * SP + p) * SN + lane]; Ci[p] = Cim[(size_t)(g * SP + p) * SN + lane]; Dm[p] = (lane == 0) ? Dv[g * SP + p] : 0.f; }
    }
    u32x4 u0 = (u32x4){0, 0, 0, 0}, u1 = (u32x4){0, 0, 0, 0};
    if (lane < nsteps) { const u32x4* up = (const u32x4*)(zu + (size_t)lane * NZ); u0 = up[0]; u1 = up[1]; }
    const int p_own = ((lane >> 5) & 1) * 8 + ((lane >> 4) & 1) * 4 + ((lane >> 3) & 1) * 2 + ((lane >> 2) & 1);
    for (int t = 0; t < nsteps; ++t) {
        float uu[16];
        { unsigned w;
          w = __builtin_amdgcn_readlane(u0.x, t); uu[0] = bf_lo(w); uu[1] = bf_hi(w);
          w = __builtin_amdgcn_readlane(u0.y, t); uu[2] = bf_lo(w); uu[3] = bf_hi(w);
          w = __builtin_amdgcn_readlane(u0.z, t); uu[4] = bf_lo(w); uu[5] = bf_hi(w);
          w = __builtin_amdgcn_readlane(u0.w, t); uu[6] = bf_lo(w); uu[7] = bf_hi(w);
          w = __builtin_amdgcn_readlane(u1.x, t); uu[8] = bf_lo(w); uu[9] = bf_hi(w);
          w = __builtin_amdgcn_readlane(u1.y, t); uu[10] = bf_lo(w); uu[11] = bf_hi(w);
          w = __builtin_amdgcn_readlane(u1.z, t); uu[12] = bf_lo(w); uu[13] = bf_hi(w);
          w = __builtin_amdgcn_readlane(u1.w, t); uu[14] = bf_lo(w); uu[15] = bf_hi(w); }
        float br = 0.f, bi = 0.f;
#pragma unroll
        for (int p = 0; p < 16; ++p) { br = fmaf(Br[p], uu[p], br); bi = fmaf(Bi[p], uu[p], bi); }
        const float nr = ar * sr - ai * si + br, ni = ar * si + ai * sr + bi;
        sr = nr; si = ni;
        if (WITH_Y) {
            float v[16];
#pragma unroll
            for (int p = 0; p < 16; ++p) v[p] = fmaf(Dm[p], uu[p], Cr[p] * sr - Ci[p] * si);
            const float y = treduce16(v, lane);
            const float gy = gelu_tanh(y);
            if ((lane & 3) == 0) yg[(size_t)t * MIX + g * SP + p_own] = (bf16_t)(cvt_pk_bf16(gy, 0.f) & 0xffff);
        }
    }
}


typedef short bf16x4 __attribute__((ext_vector_type(4)));
struct SsmTab { bf16x4 Bre[4], Bim[4]; bf16x8 Ct[4]; float dp; float ar, ai; };
__device__ __forceinline__ void ssm_load_tab(SsmTab& T, int g, const bf16_t* BTR, const bf16_t* BTI, const bf16_t* CT, const float* AT, const float* Dv, int lane, bool with_y) {
    const int li = lane & 15, lq = lane >> 4;
#pragma unroll
    for (int nt = 0; nt < 4; ++nt) { T.Bre[nt] = *(const bf16x4*)(BTR + ((size_t)(g * SN + 16 * nt + li)) * 16 + 4 * lq); T.Bim[nt] = *(const bf16x4*)(BTI + ((size_t)(g * SN + 16 * nt + li)) * 16 + 4 * lq); }
    const f32x4 at = *(const f32x4*)(AT + (size_t)(g * SN + lane) * 4); T.ar = at[0]; T.ai = at[1];
    if (with_y) {
#pragma unroll
        for (int kb = 0; kb < 4; ++kb) T.Ct[kb] = *(const bf16x8*)(CT + ((size_t)(g * SP + li)) * 128 + kb * 32 + 8 * lq);
        T.dp = Dv[g * SP + li];
    }
}
template <bool WITH_Y>
__device__ __forceinline__ void ssm_chunk(LAS unsigned char* wl, const bf16_t* zu, float& sr, float& si, const SsmTab& T, bf16_t* yg, int lane) {
    const int li = lane & 15, lq = lane >> 4;
    bf16x4 U[4];
#pragma unroll
    for (int mt = 0; mt < 4; ++mt) U[mt] = *(const bf16x4*)(zu + (size_t)(16 * mt + li) * NZ + 4 * lq);
    {
        int rofs[4], nofs[4];
#pragma unroll
        for (int r = 0; r < 4; ++r) { rofs[r] = lq * 1024 + (li & 3) * 4 + r * 256 + (((li >> 2) ^ r) << 4); nofs[r] = ((r ^ lq) << 6); }
#pragma unroll 1
        for (int mt = 0; mt < 4; ++mt) {
            LAS unsigned char* pm = wl + mt * 4096;
            const bf16x4 um = mt == 0 ? U[0] : (mt == 1 ? U[1] : (mt == 2 ? U[2] : U[3]));
#pragma unroll
            for (int nt = 0; nt < 4; ++nt) {
                const f32x4 dre = __builtin_amdgcn_mfma_f32_16x16x16bf16_1k(um, T.Bre[nt], (f32x4){0.f, 0.f, 0.f, 0.f}, 0, 0, 0);
                const f32x4 dim = __builtin_amdgcn_mfma_f32_16x16x16bf16_1k(um, T.Bim[nt], (f32x4){0.f, 0.f, 0.f, 0.f}, 0, 0, 0);
#pragma unroll
                for (int r = 0; r < 4; ++r) *(LAS unsigned*)(pm + rofs[r] + nofs[nt]) = cvt_pk_bf16(dre[r], dim[r]);
            }
        }
    }
    asm volatile("s_waitcnt lgkmcnt(0)" ::: "memory");
    {
        const float ar = T.ar, ai = T.ai;
        int xj[16];
#pragma unroll
        for (int j = 0; j < 16; ++j) xj[j] = (((lane >> 2) ^ j) << 4) + (lane & 3) * 4 + j * 256;
#pragma unroll 1
        for (int tb = 0; tb < 4; ++tb) {
            LAS unsigned char* pb = wl + tb * 4096;
            unsigned w[16];
#pragma unroll
            for (int j = 0; j < 16; ++j) w[j] = *(const LAS unsigned*)(pb + xj[j]);
#pragma unroll
            for (int j = 0; j < 16; ++j) {
                const float nr = ar * sr - ai * si + bf_lo(w[j]), ni = ar * si + ai * sr + bf_hi(w[j]);
                sr = nr; si = ni;
                if (WITH_Y) *(LAS unsigned*)(pb + xj[j]) = cvt_pk_bf16(sr, si);
            }
        }
    }
    if (WITH_Y) {
        asm volatile("s_waitcnt lgkmcnt(0)" ::: "memory");
        int kofs[4];
#pragma unroll
        for (int kb = 0; kb < 4; ++kb) kofs[kb] = li * 256 + ((((kb * 4 + lq) ^ li)) << 4);
#pragma unroll 1
        for (int mt = 0; mt < 4; ++mt) {
            const LAS unsigned char* pm = wl + mt * 4096;
            f32x4 acc = (f32x4){0.f, 0.f, 0.f, 0.f};
#pragma unroll
            for (int kb = 0; kb < 4; ++kb) { const bf16x8 a = *(const LAS bf16x8*)(pm + kofs[kb]); acc = __builtin_amdgcn_mfma_f32_16x16x32_bf16(a, T.Ct[kb], acc, 0, 0, 0); }
            bf16_t* yp = yg + (size_t)(16 * mt + 4 * lq) * MIX + li;
            const bf16_t* up = zu + (size_t)(16 * mt + 4 * lq) * NZ + li;
#pragma unroll
            for (int r = 0; r < 4; ++r) { const float uv = __uint_as_float(((unsigned)up[(size_t)r * NZ]) << 16);
                yp[(size_t)r * MIX] = (bf16_t)(cvt_pk_bf16(gelu_tanh(fmaf(T.dp, uv, acc[r])), 0.f) & 0xffff); }
        }
        asm volatile("s_waitcnt lgkmcnt(0)" ::: "memory");
    }
}

#define XB_TMO      128
#define XB_XCNT(j)  (256  + 64 * (j))
#define XB_XSUB(j)  (1280 + 64 * (j))
#define XB_XGEN(j)  (2304 + 64 * (j))
#define XB_TOP      3328
#define XB_TOPGEN   3392
#define XCD_BAR_WORDS 3456
#define XB_SPIN_CAP (1u << 18)
__device__ __forceinline__ unsigned xb_ld(unsigned* p)              { return __hip_atomic_load(p, __ATOMIC_RELAXED, __HIP_MEMORY_SCOPE_AGENT); }
__device__ __forceinline__ unsigned xb_add(unsigned* p, unsigned v) { return __hip_atomic_fetch_add(p, v, __ATOMIC_RELAXED, __HIP_MEMORY_SCOPE_AGENT); }
__device__ __forceinline__ unsigned xb_xcc_id() { return (unsigned)__builtin_amdgcn_s_getreg((3 << 11) | 20) & 0xFu; }
#define XB_SPIN(cond, bar) do { unsigned _sp = 0; while (cond) { __builtin_amdgcn_s_sleep(1); \
    if ((++_sp & 255u) == 0u) { if (xb_ld(&(bar)[XB_TMO])) break; if (_sp > XB_SPIN_CAP) { atomicAdd(&(bar)[XB_TMO], 1u); break; } } } } while (0)
struct XcdBarrier { unsigned* bar; unsigned x; volatile LAS unsigned* st; };
__device__ __forceinline__ XcdBarrier xcd_barrier_post(unsigned* bar, volatile LAS unsigned* st) {
    XcdBarrier b; b.bar = bar; b.x = xb_xcc_id(); b.st = st;
    if (threadIdx.x == 0) (void)xb_add(&bar[XB_XCNT(b.x)], 1u);
    return b;
}
__device__ __forceinline__ void xcd_barrier_complete(unsigned* bar, unsigned x, unsigned& nloc, unsigned& nx) {
    const unsigned G = gridDim.x * gridDim.y * gridDim.z;
    unsigned sum, cnt, mine, sp = 0u;
    for (;;) {
        sum = 0u; cnt = 0u; mine = 0u;
#pragma unroll
        for (unsigned j = 0; j < 16; ++j) { const unsigned c = xb_ld(&bar[XB_XCNT(j)]); sum += c; cnt += (c > 0u) ? 1u : 0u; mine = (j == x) ? c : mine; }
        if (sum == G) break;
        __builtin_amdgcn_s_sleep(1);
        if ((++sp & 255u) == 0u) { if (xb_ld(&bar[XB_TMO])) break; if (sp > XB_SPIN_CAP) { atomicAdd(&bar[XB_TMO], 1u); break; } }
    }
    nloc = mine > 0u ? mine : 1u; nx = cnt > 0u ? cnt : 1u;
}
__device__ __forceinline__ void xcd_barrier(const XcdBarrier& b) {
    asm volatile("s_waitcnt vmcnt(0)" ::: "memory");
    __syncthreads();
    if (threadIdx.x == 0) {
        unsigned* bar = b.bar;
        __builtin_amdgcn_s_waitcnt(0);
        unsigned nloc = b.st[0], nx = b.st[1];
        if (nloc == 0u) { xcd_barrier_complete(bar, b.x, nloc, nx); b.st[0] = nloc; b.st[1] = nx; }
        const unsigned old = xb_add(&bar[XB_XSUB(b.x)], 1u);
        const unsigned gen = old / nloc;
        if (old + 1u == (gen + 1u) * nloc) {
            __builtin_amdgcn_fence(__ATOMIC_RELEASE, "agent");
            asm volatile("s_waitcnt vmcnt(0)" ::: "memory");
            const unsigned og = xb_add(&bar[XB_TOP], 1u);
            const unsigned tg = og / nx;
            if (og + 1u == (tg + 1u) * nx) xb_add(&bar[XB_TOPGEN], 1u);
            else XB_SPIN(xb_ld(&bar[XB_TOPGEN]) == tg, bar);
            __builtin_amdgcn_fence(__ATOMIC_ACQUIRE, "agent");
            xb_add(&bar[XB_XGEN(b.x)], 1u);
            asm volatile("s_waitcnt vmcnt(0)" ::: "memory");
        } else {
            XB_SPIN(xb_ld(&bar[XB_XGEN(b.x)]) == gen, bar);
            __builtin_amdgcn_fence(__ATOMIC_ACQUIRE, "agent");
            asm volatile("s_waitcnt vmcnt(0)" ::: "memory");
        }
    }
    __syncthreads();
}

__device__ __forceinline__ const float* ld_in(int k) {
    const __attribute__((address_space(4))) unsigned long long* t = (const __attribute__((address_space(4))) unsigned long long*)__builtin_amdgcn_kernarg_segment_ptr();
    asm volatile("" : "+s"(t));
    return (const float*)t[k];
}
__global__ void __launch_bounds__(NTHREADS, 2) hymba_fwd(Args args) {
    extern __shared__ __attribute__((aligned(16))) unsigned char lds_raw[];
    LAS unsigned char* lds = (LAS unsigned char*)lds_raw;
    cg::grid_group grid = cg::this_grid();
    const int tid = threadIdx.x, lane = tid & 63, wave = __builtin_amdgcn_readfirstlane(tid >> 6);
    const int G = gridDim.x, bx = blockIdx.x;
    const int gw = bx * NWAVES + wave, NGW = G * NWAVES;
#define IN(k) ld_in(k)
    unsigned char* ws = (unsigned char*)ld_in(38); float* out = (float*)ld_in(37);
    unsigned* barw = (unsigned*)(ws + WS_CTL);
    volatile LAS unsigned* bst = (volatile LAS unsigned*)(lds + XCH_OFF + 8192);
    if (bx == 0) for (int i = tid; i < XCD_BAR_WORDS; i += NTHREADS) barw[i] = 0u;
    if (tid < 2) bst[tid] = 0u;
    bf16_t* WIN = (bf16_t*)(ws + WS_WIN); bf16_t* WKV = (bf16_t*)(ws + WS_WKV); bf16_t* WGLU = (bf16_t*)(ws + WS_WGLU); bf16_t* WOUT = (bf16_t*)(ws + WS_WOUT);
    bf16_t* WQ = (bf16_t*)(ws + WS_WQ); bf16_t* WXO = (bf16_t*)(ws + WS_WXO); bf16_t* WUG = (bf16_t*)(ws + WS_WUG); bf16_t* WDN = (bf16_t*)(ws + WS_WDN);
    bf16_t* H = (bf16_t*)(ws + WS_H); float* X = (float*)(ws + WS_X);
    bf16_t* Z = (bf16_t*)(ws + WS_Z); bf16_t* YG = (bf16_t*)(ws + WS_YG); float* YS = (float*)(ws + WS_YS); bf16_t* MIXN = (bf16_t*)(ws + WS_MIXN);
    bf16_t* Q = (bf16_t*)(ws + WS_Q); bf16_t* PR = (bf16_t*)(ws + WS_PR); bf16_t* O = (bf16_t*)(ws + WS_O);
    bf16_t* MN = (bf16_t*)(ws + WS_MN); bf16_t* KB = (bf16_t*)(ws + WS_KB); bf16_t* VT = (bf16_t*)(ws + WS_VT);
    float* SE = (float*)(ws + WS_SE); float* SI = (float*)(ws + WS_SI); float* BB = (float*)(ws + WS_BB); float* AT = (float*)(ws + WS_AT);
    float* PART = (float*)(ws + WS_PART); float* SSQ = (float*)(ws + WS_SSQ);
    bf16_t* BTR = (bf16_t*)(ws + WS_BTR); bf16_t* BTI = (bf16_t*)(ws + WS_BTI); bf16_t* CT = (bf16_t*)(ws + WS_CT);
    bf16_t* UG = (bf16_t*)(ws + WS_UG); bf16_t* ACT = (bf16_t*)(ws + WS_ACT);

    if (PH(0)) {
        const float* x_prompt = IN(0); const float* x_sample = IN(1); const float* mem_prompt = IN(2); const float* norm_mix = IN(9); const float* w_in = IN(10);
        const float* C_re = IN(16); const float* C_im = IN(17);
        const float* A_re = IN(11); const float* A_im = IN(12); const float* log_dt = IN(13); const float* B_re = IN(14); const float* B_im = IN(15);
        const float* w_glu = IN(19); const float* w_out = IN(24); const float* norm_mem = IN(26); const float* w_q = IN(27); const float* w_k = IN(28); const float* w_v = IN(29); const float* w_xo = IN(30);
        const float* w_up = IN(32); const float* w_gate = IN(33); const float* w_down = IN(35);
        LAS float* scr = (LAS float*)(lds + wave * 16384);
        constexpr int I_IN = 16 * 64, I_D = 16 * 32, I_GLU = 8 * 16, I_UP = 16 * 88, I_DN = 44 * 32;
        constexpr int NITEMS = I_IN + 5 * I_D + I_GLU + 2 * I_UP + I_DN;
        for (int it = gw; it < NITEMS; it += NGW) {
            int r = it;
            if (r < I_IN) { transpose_item(w_in, D, NZ, WIN, 0, scr, r, lane); continue; } r -= I_IN;
            if (r < I_D) { transpose_item(w_k, D, D, WKV, 0, scr, r, lane); continue; } r -= I_D;
            if (r < I_D) { transpose_item(w_v, D, D, WKV, D, scr, r, lane); continue; } r -= I_D;
            if (r < I_D) { transpose_item(w_out, D, D, WOUT, 0, scr, r, lane); continue; } r -= I_D;
            if (r < I_D) { transpose_item(w_q, D, D, WQ, 0, scr, r, lane); continue; } r -= I_D;
            if (r < I_D) { transpose_item(w_xo, D, D, WXO, 0, scr, r, lane); continue; } r -= I_D;
            if (r < I_GLU) { transpose_item(w_glu, MIX, MIX, WGLU, 0, scr, r, lane); continue; } r -= I_GLU;
            if (r < I_UP) { transpose_item(w_up, D, DFF, WUG, 0, scr, r, lane); continue; } r -= I_UP;
            if (r < I_UP) { transpose_item(w_gate, D, DFF, WUG, DFF, scr, r, lane); continue; } r -= I_UP;
            transpose_item(w_down, DFF, D, WDN, 0, scr, r, lane);
        }
        for (int m = gw; m < MT; m += NGW) rms_row_bf16(m < NP ? x_prompt + (size_t)m * D : x_sample + (size_t)(m - NP) * D, norm_mix, H + (size_t)m * D, lane);
        for (int m = gw; m < BP * NMEM; m += NGW) rms_row_bf16(mem_prompt + (size_t)m * D, norm_mem, MN + (size_t)m * D, lane);
        for (size_t i = (size_t)bx * NTHREADS + tid; i < (size_t)NS * D / 4; i += (size_t)G * NTHREADS) { ((f32x4*)(X + (size_t)NP * D))[i] = ((const f32x4*)x_sample)[i]; }
        for (int i = bx * NTHREADS + tid; i < 2 * NP; i += G * NTHREADS) SSQ[i] = 0.f;
        const int gt = bx * NTHREADS + tid;
        if (gt < SG * SN) {
            const int g = gt / SN;
            const float dt = expf(log_dt[g]), lr = A_re[gt], li = A_im[gt];
            const float mag = expf(dt * lr), ph = dt * li;
            double th = (double)ph * (1.0 / 1024.0), t2 = th * th;
            double c = 1.0 - t2 * (0.5 - t2 * (1.0 / 24.0 - t2 * (1.0 / 720.0)));
            double s = th * (1.0 - t2 * (1.0 / 6.0 - t2 * (1.0 / 120.0 - t2 * (1.0 / 5040.0))));
#pragma unroll 1
            for (int k = 0; k < 10; ++k) { const double c2 = c * c - s * s, s2 = 2.0 * c * s; c = c2; s = s2; }
            const float ar = mag * (float)c, ai = mag * (float)s;
            const float den = lr * lr + li * li;
            const float cr = ((ar - 1.0f) * lr + ai * li) / den, ci = (ai * lr - (ar - 1.0f) * li) / den;
#pragma unroll
            for (int p = 0; p < 16; ++p) { const float br = B_re[(size_t)gt * SP + p], bi = B_im[(size_t)gt * SP + p];
                const float bbr = cr * br - ci * bi, bbi = cr * bi + ci * br;
                BB[(size_t)gt * 32 + p] = bbr; BB[(size_t)gt * 32 + 16 + p] = bbi;
                BTR[(size_t)gt * 16 + p] = (bf16_t)(cvt_pk_bf16(bbr, 0.f) & 0xffff); BTI[(size_t)gt * 16 + p] = (bf16_t)(cvt_pk_bf16(bbi, 0.f) & 0xffff); }
            float pr = ar, pi = ai;
#pragma unroll 1
            for (int k = 0; k < 6; ++k) { const float r2 = pr * pr - pi * pi, i2 = 2.0f * pr * pi; pr = r2; pi = i2; }
            *(f32x4*)(AT + (size_t)gt * 4) = (f32x4){ar, ai, pr, pi};
        }
        if (gt < SG * SP * SN) {
            const float cre = C_re[gt], cim = C_im[gt];
            ((unsigned*)CT)[gt] = cvt_pk_bf16(cre, -cim);
        }
    }
    grid.sync();
    const XcdBarrier xb = xcd_barrier_post(barw, bst);

    if (PH(1)) {
        Sched2 S{G, bx, MT / 256, NZ / 256, 16, BP, 8, 16, 1, 0, (const char*)H, (const char*)WIN, (const char*)MN, (const char*)WKV, (size_t)256 * D * 2, (size_t)256 * D * 2};
        EpiP1 E{Z, out + O_MK, out + O_MV, KB, VT};
        pg8::gemm_phase(lds, D, D, S, E);
    }
    GSYNC();

    if (PH(2)) {
        const float* st_re = IN(5); const float* st_im = IN(6); const float* st_conv = IN(7); const float* C_re = IN(16); const float* C_im = IN(17); const float* Dssm = IN(18); const float* conv_w = IN(21); const float* norm_conv = IN(23);
        {
            SsmTab T; int gcur = -1;
            for (int task = gw; task < BP * SG * NCH; task += NGW) {
                const int c = task % NCH, g = (task / NCH) % SG, b = task / (NCH * SG);
                if (g != gcur) { ssm_load_tab(T, g, BTR, BTI, CT, AT, Dssm, lane, false); gcur = g; }
                float sr = 0.f, si = 0.f;
#ifdef OLD_PASS1
                ssm_tile<false>(Z + (size_t)(b * TP + c * LCH) * NZ + g * SP, LCH, sr, si, BB, AT, C_re, C_im, Dssm, g, nullptr, lane);
#else
                ssm_chunk<false>(lds + wave * 16384, Z + (size_t)(b * TP + c * LCH) * NZ + g * SP, sr, si, T, nullptr, lane);
#endif
                float* e = SE + ((size_t)(b * SG + g) * NCH + c) * 128; e[lane] = sr; e[64 + lane] = si;
            }
        }
        for (int task = gw; task < BS * SG; task += NGW) {
            const int b = task % BS, g = task / BS;
            float sr = st_re[(size_t)(b * SG + g) * SN + lane], si = st_im[(size_t)(b * SG + g) * SN + lane];
            ssm_tile<true>(Z + (size_t)(NP + b * TS) * NZ + g * SP, TS, sr, si, BB, AT, C_re, C_im, Dssm, g, YG + (size_t)(NP + b * TS) * MIX, lane);
            out[O_SRS + (size_t)(b * SG + g) * SN + lane] = sr; out[O_SIS + (size_t)(b * SG + g) * SN + lane] = si;
        }
        for (int r = gw; r < MT; r += NGW) {
            int b, t; const float* prev; float* cout; int T;
            if (r < NP) { b = r / TP; t = r % TP; prev = nullptr; cout = out + O_CP + (size_t)b * 2 * MIX; T = TP; }
            else { const int rs = r - NP; b = rs / TS; t = rs % TS; prev = st_conv + (size_t)b * 2 * MIX; cout = out + O_CS + (size_t)b * 2 * MIX; T = TS; }
            const int c0 = lane * 8;
            float p[3][8];
#pragma unroll
            for (int k = 0; k < 3; ++k) {
                const int tt = t - k;
                if (tt >= 0) { const bf16_t* zr = Z + (size_t)(r - k) * NZ; const u32x4 xi = *(const u32x4*)(zr + MIX + c0), cgv = *(const u32x4*)(zr + 3 * MIX + c0);
                    p[k][0] = bf_lo(xi.x) * bf_lo(cgv.x); p[k][1] = bf_hi(xi.x) * bf_hi(cgv.x); p[k][2] = bf_lo(xi.y) * bf_lo(cgv.y); p[k][3] = bf_hi(xi.y) * bf_hi(cgv.y);
                    p[k][4] = bf_lo(xi.z) * bf_lo(cgv.z); p[k][5] = bf_hi(xi.z) * bf_hi(cgv.z); p[k][6] = bf_lo(xi.w) * bf_lo(cgv.w); p[k][7] = bf_hi(xi.w) * bf_hi(cgv.w); }
                else if (prev) { const float* pp = prev + (size_t)(2 + tt) * MIX + c0; const f32x4 a = *(const f32x4*)pp, bq = *(const f32x4*)(pp + 4);
                    p[k][0] = a[0]; p[k][1] = a[1]; p[k][2] = a[2]; p[k][3] = a[3]; p[k][4] = bq[0]; p[k][5] = bq[1]; p[k][6] = bq[2]; p[k][7] = bq[3]; }
                else {
#pragma unroll
                    for (int j = 0; j < 8; ++j) p[k][j] = 0.f; }
            }
            const u32x4 bgv = *(const u32x4*)(Z + (size_t)r * NZ + 2 * MIX + c0);
            float bg[8] = {bf_lo(bgv.x), bf_hi(bgv.x), bf_lo(bgv.y), bf_hi(bgv.y), bf_lo(bgv.z), bf_hi(bgv.z), bf_lo(bgv.w), bf_hi(bgv.w)};
            float y[8]; float ss = 0.f;
#pragma unroll
            for (int j = 0; j < 8; ++j) { const float w0 = conv_w[c0 + j], w1 = conv_w[MIX + c0 + j], w2 = conv_w[2 * MIX + c0 + j];
                y[j] = bg[j] * (w0 * p[2][j] + w1 * p[1][j] + w2 * p[0][j]); ss += y[j] * y[j]; }
            const float rstd = 1.0f / sqrtf(wave_sum(ss) * (1.0f / MIX) + EPS);
            const f32x4 g0 = *(const f32x4*)(norm_conv + c0), g1 = *(const f32x4*)(norm_conv + c0 + 4);
            u32x4 w; w.x = cvt_pk_bf16(y[0] * rstd * g0[0], y[1] * rstd * g0[1]); w.y = cvt_pk_bf16(y[2] * rstd * g0[2], y[3] * rstd * g0[3]);
            w.z = cvt_pk_bf16(y[4] * rstd * g1[0], y[5] * rstd * g1[1]); w.w = cvt_pk_bf16(y[6] * rstd * g1[2], y[7] * rstd * g1[3]);
            *(u32x4*)(MIXN + (size_t)r * D + MIX + c0) = w;
            if (t >= T - 2) { float* co = cout + (size_t)(t - (T - 2)) * MIX + c0; *(f32x4*)co = (f32x4){p[0][0], p[0][1], p[0][2], p[0][3]}; *(f32x4*)(co + 4) = (f32x4){p[0][4], p[0][5], p[0][6], p[0][7]}; }
        }
    }
    GSYNC();

    if (PH(3)) {
        for (int task = gw; task < BP * SG; task += NGW) {
            const int g = task % SG, b = task / SG;
            const f32x4 at = *(const f32x4*)(AT + (size_t)(g * SN + lane) * 4); const float aLr = at[2], aLi = at[3];
            float sr = 0.f, si = 0.f;
            for (int c = 0; c < NCH; ++c) {
                float* sip = SI + ((size_t)(b * SG + g) * NCH + c) * 128; sip[lane] = sr; sip[64 + lane] = si;
                const float* e = SE + ((size_t)(b * SG + g) * NCH + c) * 128; const float er = e[lane], ei = e[64 + lane];
                const float nr = aLr * sr - aLi * si + er, ni = aLr * si + aLi * sr + ei; sr = nr; si = ni;
            }
            out[O_SRP + (size_t)(b * SG + g) * SN + lane] = sr; out[O_SIP + (size_t)(b * SG + g) * SN + lane] = si;
        }
    }
    GSYNC();

    if (PH(4)) {
        const float* C_re = IN(16); const float* C_im = IN(17); const float* Dssm = IN(18);
        SsmTab T; int gcur = -1;
        for (int task = gw; task < BP * SG * NCH; task += NGW) {
            const int c = task % NCH, g = (task / NCH) % SG, b = task / (NCH * SG);
            if (g != gcur) { ssm_load_tab(T, g, BTR, BTI, CT, AT, Dssm, lane, true); gcur = g; }
            const float* sip = SI + ((size_t)(b * SG + g) * NCH + c) * 128; float sr = sip[lane], si = sip[64 + lane];
#ifdef OLD_PASS2
            ssm_tile<true>(Z + (size_t)(b * TP + c * LCH) * NZ + g * SP, LCH, sr, si, BB, AT, C_re, C_im, Dssm, g, YG + (size_t)(b * TP + c * LCH) * MIX, lane);
#else
            ssm_chunk<true>(lds + wave * 16384, Z + (size_t)(b * TP + c * LCH) * NZ + g * SP, sr, si, T, YG + (size_t)(b * TP + c * LCH) * MIX + g * SP, lane);
#endif
        }
    }
    GSYNC();

    if (PH(5)) {
        const float* b_glu = IN(20);
        Sched2 S{G, bx, MT / 256, MIX / 256, 8, 0, 0, 4, 1, 0, (const char*)YG, (const char*)WGLU, nullptr, nullptr, (size_t)256 * MIX * 2, (size_t)256 * MIX * 2};
        EpiGlu E{YG, b_glu, YS};
        pg8::gemm_phase(lds, MIX, MIX, S, E);
    }
    GSYNC();

    if (PH(6)) {
        const float* norm_ssm = IN(22);
        for (int r = gw; r < MT; r += NGW) {
            const f32x4* yr = (const f32x4*)(YS + (size_t)r * MIX) + lane; const f32x4 a = yr[0], b = yr[64];
            const float ss = (a[0] * a[0] + a[1] * a[1]) + (a[2] * a[2] + a[3] * a[3]) + (b[0] * b[0] + b[1] * b[1]) + (b[2] * b[2] + b[3] * b[3]);
            const float rstd = 1.0f / sqrtf(wave_sum(ss) * (1.0f / MIX) + EPS);
            const f32x4 ga = ((const f32x4*)norm_ssm)[lane], gb = ((const f32x4*)norm_ssm)[lane + 64];
            u32x2 w0, w1; w0.x = cvt_pk_bf16(a[0] * rstd * ga[0], a[1] * rstd * ga[1]); w0.y = cvt_pk_bf16(a[2] * rstd * ga[2], a[3] * rstd * ga[3]);
            w1.x = cvt_pk_bf16(b[0] * rstd * gb[0], b[1] * rstd * gb[1]); w1.y = cvt_pk_bf16(b[2] * rstd * gb[2], b[3] * rstd * gb[3]);
            u32x2* o8 = (u32x2*)(MIXN + (size_t)r * D) + lane; o8[0] = w0; o8[64] = w1;
        }
    }
    GSYNC();

    if (PH(7)) {
        const float* x_prompt = IN(0);
        Sched2 S{G, bx, NP / 256, D / 256, 16, NS / 256, D / 256, 4, 4, NP / 256, (const char*)MIXN, (const char*)WOUT, (const char*)MIXN, (const char*)WOUT, (size_t)256 * D * 2, (size_t)256 * D * 2};
        EpiRes E{x_prompt, X, PART, 1, H, IN(25), SSQ};
        pg8::gemm_phase(lds, D, D, S, E);
    }
    GSYNC();

    if (PH(8)) for (int m = NP + gw; m < MT; m += NGW) { add_parts(X + (size_t)m * D, PART + (size_t)(m - NP) * D, 4, (size_t)NS * D, lane); rms_row_bf16(X + (size_t)m * D, IN(25), H + (size_t)m * D, lane); }
    GSYNC();

    if (PH(9)) {
        Sched2 S{G, bx, NP / 256, D / 256, 16, NS / 256, D / 256, 4, 4, NP / 256, (const char*)H, (const char*)WQ, (const char*)H, (const char*)WQ, (size_t)256 * D * 2, (size_t)256 * D * 2};
        EpiQ E{Q, PART, SSQ};
        pg8::gemm_phase(lds, D, D, S, E);
    }
    GSYNC();

    if (PH(10)) {
        const float* cache_k = IN(3); const float* cache_v = IN(4);
        struct SchedQK { int G, c; const char* Q; const char* KB;
            __device__ __forceinline__ bool next(int i, Unit& u) const { const int L = i * G + c; if (L >= 64 * NH) return false; pg8::order_map(L, 64, NH, u.pm, u.pn); u.kind = 0; u.nt = 4; u.ks = 0;
                u.A = Q + ((size_t)u.pm * 256 * D + (size_t)u.pn * HD) * 2; u.B = KB + ((size_t)(u.pm >> 3) * NMEM * D + (size_t)u.pn * HD) * 2; return true; } };
        SchedQK S{G, bx, (const char*)Q, (const char*)KB};
        EpiSoftmax E{PR, lds};
#ifndef NO_QK
        pg8::gemm_phase(lds, D, D, S, E);
#endif

#ifndef NO_SATT
        LAS float* sc = (LAS float*)lds;
        LAS float* pr = (LAS float*)(lds + 4096);
        LAS float* po = (LAS float*)(lds + 8192);
        for (int unit = bx; unit < BS * NH; unit += G) {
            const int b = unit / NH, h = unit % NH;
            float q[4][4];
#pragma unroll
            for (int qi = 0; qi < 4; ++qi) { const float* qp = PART + (size_t)(b * TS + qi) * D + h * HD + 4 * lane; const f32x4 w = (*(const f32x4*)qp + *(const f32x4*)(qp + (size_t)NS * D)) + (*(const f32x4*)(qp + (size_t)2 * NS * D) + *(const f32x4*)(qp + (size_t)3 * NS * D)); q[qi][0] = w[0]; q[qi][1] = w[1]; q[qi][2] = w[2]; q[qi][3] = w[3]; }
            const float* kbase = cache_k + ((size_t)(b * NMEM) * NH + h) * HD + 4 * lane;
            const float* vbase = cache_v + ((size_t)(b * NMEM) * NH + h) * HD + 4 * lane;
#pragma unroll 1
            for (int blk = 0; blk < 2; ++blk) {
                const int key0 = wave * 32 + blk * 16;
                float v[64];
#pragma unroll
                for (int k = 0; k < 16; ++k) { const f32x4 kv = *(const f32x4*)(kbase + (size_t)(key0 + k) * NH * HD);
#pragma unroll
                    for (int qi = 0; qi < 4; ++qi) v[k * 4 + qi] = (kv[0] * q[qi][0] + kv[1] * q[qi][1]) + (kv[2] * q[qi][2] + kv[3] * q[qi][3]); }
                const float s = treduce64(v, lane);
                sc[(lane & 3) * 256 + key0 + (lane >> 2)] = s;
            }
            __syncthreads();
            {
                const int qi = lane & 3, kb = lane >> 2; float sv[16]; float mx = -3.0e38f;
#pragma unroll
                for (int j = 0; j < 16; ++j) { sv[j] = sc[qi * 256 + kb + 16 * j]; mx = fmaxf(mx, sv[j]); }
                mx = fmaxf(mx, __shfl_xor(mx, 4)); mx = fmaxf(mx, __shfl_xor(mx, 8)); mx = fmaxf(mx, __shfl_xor(mx, 16)); mx = fmaxf(mx, __shfl_xor(mx, 32));
                float sum = 0.f;
#pragma unroll
                for (int j = 0; j < 16; ++j) { sv[j] = fast_exp(sv[j] - mx); sum += sv[j]; }
                sum += __shfl_xor(sum, 4); sum += __shfl_xor(sum, 8); sum += __shfl_xor(sum, 16); sum += __shfl_xor(sum, 32);
                const float inv = 1.0f / sum;
                if (wave == 0) {
#pragma unroll
                    for (int j = 0; j < 16; ++j) pr[qi * 256 + kb + 16 * j] = sv[j] * inv; }
            }
            __syncthreads();
            {
                float o[4][4];
#pragma unroll
                for (int qi = 0; qi < 4; ++qi) { o[qi][0] = 0.f; o[qi][1] = 0.f; o[qi][2] = 0.f; o[qi][3] = 0.f; }
#pragma unroll 8
                for (int k = 0; k < 32; ++k) { const int key = wave * 32 + k; const f32x4 vv = *(const f32x4*)(vbase + (size_t)key * NH * HD);
#pragma unroll
                    for (int qi = 0; qi < 4; ++qi) { const float pp = pr[qi * 256 + key]; o[qi][0] = fmaf(pp, vv[0], o[qi][0]); o[qi][1] = fmaf(pp, vv[1], o[qi][1]); o[qi][2] = fmaf(pp, vv[2], o[qi][2]); o[qi][3] = fmaf(pp, vv[3], o[qi][3]); } }
#pragma unroll
                for (int qi = 0; qi < 4; ++qi) *(LAS f32x4*)(po + (wave * 4 + qi) * 256 + 4 * lane) = (f32x4){o[qi][0], o[qi][1], o[qi][2], o[qi][3]};
            }
            __syncthreads();
            {
                const int idx = tid * 2, qi = idx >> 8, d = idx & 255; float a0 = 0.f, a1 = 0.f;
#pragma unroll
                for (int w = 0; w < 8; ++w) { const f32x2 t2 = *(LAS f32x2*)(po + (w * 4 + qi) * 256 + d); a0 += t2[0]; a1 += t2[1]; }
                *(unsigned*)(O + (size_t)(NP + b * TS + qi) * D + h * HD + d) = cvt_pk_bf16(a0, a1);
            }
        }
#endif
    }
    GSYNC();

    if (PH(11)) {
        struct SchedPV { int G, c; const char* PR; const char* VT;
            __device__ __forceinline__ bool next(int i, Unit& u) const { const int L = i * G + c; if (L >= 64 * NH) return false; pg8::order_map(L, 64, NH, u.pm, u.pn); u.kind = 0; u.nt = 4; u.ks = 0;
                u.A = PR + (size_t)(u.pm * NH + u.pn) * 256 * 256 * 2; u.B = VT + (size_t)((u.pm >> 3) * NH + u.pn) * HD * NMEM * 2; return true; } };
        SchedPV S{G, bx, (const char*)PR, (const char*)VT};
        EpiBf E{O, D, 1.0f, nullptr};
        pg8::gemm_phase(lds, NMEM, NMEM, S, E);
    }
    GSYNC();

    if (PH(12)) {
        Sched2 S{G, bx, NP / 256, D / 256, 16, NS / 256, D / 256, 4, 4, NP / 256, (const char*)O, (const char*)WXO, (const char*)O, (const char*)WXO, (size_t)256 * D * 2, (size_t)256 * D * 2};
        EpiRes E{nullptr, X, PART, 0, H, IN(31), SSQ + NP};
        pg8::gemm_phase(lds, D, D, S, E);
    }
    GSYNC();

    if (PH(13)) for (int m = NP + gw; m < MT; m += NGW) { add_parts(X + (size_t)m * D, PART + (size_t)(m - NP) * D, 4, (size_t)NS * D, lane); rms_row_bf16(X + (size_t)m * D, IN(31), H + (size_t)m * D, lane); }
    GSYNC();

    if (PH(14)) {
        Sched2 S{G, bx, MT / 256, NUG / 256, 16, 0, 0, 4, 1, 0, (const char*)H, (const char*)WUG, nullptr, nullptr, (size_t)256 * D * 2, (size_t)256 * D * 2};
        EpiBf E{UG, NUG, 1.0f, SSQ + NP};
        pg8::gemm_phase(lds, D, D, S, E);
    }
    GSYNC();

    if (PH(15)) {
        const float* st_ffn = IN(8); const float* ffn_conv_w = IN(34);
        constexpr int NV = DFF / 8;
        const size_t total = (size_t)MT * NV;
        for (size_t idx = (size_t)bx * NTHREADS + tid; idx < total; idx += (size_t)G * NTHREADS) {
            const int r = (int)(idx / NV), c0 = (int)(idx % NV) * 8;
            int b, t, T; const float* prev; float* fout;
            if (r < NP) { b = r / TP; t = r % TP; prev = nullptr; fout = out + O_FP + (size_t)b * 2 * DFF; T = TP; }
            else { const int rs = r - NP; b = rs / TS; t = rs % TS; prev = st_ffn + (size_t)b * 2 * DFF; fout = out + O_FS + (size_t)b * 2 * DFF; T = TS; }
            float p[3][8];
#pragma unroll
            for (int k = 0; k < 3; ++k) {
                const int tt = t - k;
                if (tt >= 0) { const u32x4 uw = *(const u32x4*)(UG + (size_t)(r - k) * NUG + c0);
                    p[k][0] = bf_lo(uw.x); p[k][1] = bf_hi(uw.x); p[k][2] = bf_lo(uw.y); p[k][3] = bf_hi(uw.y); p[k][4] = bf_lo(uw.z); p[k][5] = bf_hi(uw.z); p[k][6] = bf_lo(uw.w); p[k][7] = bf_hi(uw.w); }
                else if (prev) { const float* pp = prev + (size_t)(2 + tt) * DFF + c0; const f32x4 a = *(const f32x4*)pp, bq = *(const f32x4*)(pp + 4);
                    p[k][0] = a[0]; p[k][1] = a[1]; p[k][2] = a[2]; p[k][3] = a[3]; p[k][4] = bq[0]; p[k][5] = bq[1]; p[k][6] = bq[2]; p[k][7] = bq[3]; }
                else {
#pragma unroll
                    for (int j = 0; j < 8; ++j) p[k][j] = 0.f; }
            }
            const u32x4 gw4 = *(const u32x4*)(UG + (size_t)r * NUG + DFF + c0);
            const float gt8[8] = {bf_lo(gw4.x), bf_hi(gw4.x), bf_lo(gw4.y), bf_hi(gw4.y), bf_lo(gw4.z), bf_hi(gw4.z), bf_lo(gw4.w), bf_hi(gw4.w)};
            float a8[8];
#pragma unroll
            for (int j = 0; j < 8; ++j) { const float w0 = ffn_conv_w[c0 + j], w1 = ffn_conv_w[DFF + c0 + j], w2 = ffn_conv_w[2 * DFF + c0 + j];
                a8[j] = gelu_tanh(w0 * p[2][j] + w1 * p[1][j] + w2 * p[0][j]) * gt8[j]; }
            u32x4 w; w.x = cvt_pk_bf16(a8[0], a8[1]); w.y = cvt_pk_bf16(a8[2], a8[3]); w.z = cvt_pk_bf16(a8[4], a8[5]); w.w = cvt_pk_bf16(a8[6], a8[7]);
            *(u32x4*)(ACT + (size_t)r * DFF + c0) = w;
            if (t >= T - 2) { float* fo = fout + (size_t)(t - (T - 2)) * DFF + c0; *(f32x4*)fo = (f32x4){p[0][0], p[0][1], p[0][2], p[0][3]}; *(f32x4*)(fo + 4) = (f32x4){p[0][4], p[0][5], p[0][6], p[0][7]}; }
        }
    }
    GSYNC();

    if (PH(16)) {
        Sched2 S{G, bx, NP / 256, D / 256, DFF / 64, NS / 256, D / 256, 4, DFF / 256, NP / 256, (const char*)ACT, (const char*)WDN, (const char*)ACT, (const char*)WDN, (size_t)256 * DFF * 2, (size_t)256 * DFF * 2};
        EpiRes E{nullptr, X, PART, 0, nullptr, nullptr, nullptr};
        pg8::gemm_phase(lds, DFF, DFF, S, E);
    }
    GSYNC();

    if (PH(17)) for (int m = gw; m < MT; m += NGW) { if (m >= NP) add_parts(X + (size_t)m * D, PART + (size_t)(m - NP) * D, DFF / 256, (size_t)NS * D, lane); rms_row_f32(X + (size_t)m * D, IN(36), out + (size_t)m * D, lane); }
}

extern "C" void kernel_launch(void* const* d_in, const int* in_sizes, int n_in, void* d_out, int out_size, void* d_ws, size_t ws_size, hipStream_t stream) {
    static int grid = 0;
    if (grid == 0) {
        if (n_in != 37 || (size_t)out_size != O_END || ws_size < WS_END) { fprintf(stderr, "kernel_launch: unexpected sizes n_in %d out %d ws %zu\n", n_in, out_size, ws_size); grid = -1; return; }
        int dev = 0, cus = 0, per_cu = 0;
        (void)hipGetDevice(&dev); (void)hipDeviceGetAttribute(&cus, hipDeviceAttributeMultiprocessorCount, dev);
        (void)hipFuncSetAttribute((const void*)hymba_fwd, hipFuncAttributeMaxDynamicSharedMemorySize, LDS_BYTES);
        (void)hipOccupancyMaxActiveBlocksPerMultiprocessor(&per_cu, (const void*)hymba_fwd, NTHREADS, LDS_BYTES);
        if (per_cu < 1) { fprintf(stderr, "kernel_launch: occupancy query reports %d blocks per CU\n", per_cu); per_cu = 1; }
        (void)hipGetLastError();
        grid = cus;
        if (grid % 8) grid -= grid % 8;
    }
    if (grid < 0) return;
    Args a{};
    for (int i = 0; i < 37; ++i) a.in[i] = (const float*)d_in[i];
    a.out = (float*)d_out; a.ws = (unsigned char*)d_ws;
    void* kargs[] = {&a};
    hipError_t e = hipLaunchCooperativeKernel((const void*)hymba_fwd, dim3(grid), dim3(NTHREADS), kargs, LDS_BYTES, stream);
    if (e != hipSuccess) fprintf(stderr, "cooperative launch failed: %s (grid %d)\n", hipGetErrorString(e), grid);
}
```

```cpp
#include <hip/hip_runtime.h>
#include <hip/hip_cooperative_groups.h>
#include <cstdio>
#include <cstdint>
namespace cg = cooperative_groups;

#define LAS __attribute__((address_space(3)))
typedef unsigned short bf16_t;
typedef short bf16x8 __attribute__((ext_vector_type(8)));
typedef float f32x4 __attribute__((ext_vector_type(4)));
typedef float f32x2 __attribute__((ext_vector_type(2)));
typedef unsigned u32x4 __attribute__((ext_vector_type(4)));
typedef unsigned u32x2 __attribute__((ext_vector_type(2)));

constexpr int D = 1024, NP = 16384, NS = 512, MT = NP + NS;
constexpr int TP = 2048, TS = 4, BP = 8, BS = 128;
constexpr int NZ = 2048, MIX = 512, DFF = 2816, NUG = 2 * DFF;
constexpr int SG = 32, SP = 16, SN = 64, LCH = 64, NCH = TP / LCH;
constexpr int NMEM = 256, NH = 4, HD = 256;
constexpr float EPS = 1e-6f;
constexpr int NWAVES = 8, NTHREADS = 512;

constexpr size_t MiB = 1u << 20;
constexpr size_t WS_WIN = 0;
constexpr size_t WS_WKV = WS_WIN + 4 * MiB;
constexpr size_t WS_WGLU = WS_WKV + 4 * MiB;
constexpr size_t WS_WOUT = WS_WGLU + 1 * MiB;
constexpr size_t WS_WQ = WS_WOUT + 2 * MiB;
constexpr size_t WS_WXO = WS_WQ + 2 * MiB;
constexpr size_t WS_WUG = WS_WXO + 2 * MiB;
constexpr size_t WS_WDN = WS_WUG + 11 * MiB;
constexpr size_t WS_H = WS_WDN + 6 * MiB;
constexpr size_t WS_X = WS_H + 33 * MiB;
constexpr size_t WS_OV = WS_X + 66 * MiB;
constexpr size_t WS_Z = WS_OV;
constexpr size_t WS_YG = WS_Z + 66 * MiB;
constexpr size_t WS_YS = WS_YG + 17 * MiB;
constexpr size_t WS_MIXN = WS_YS + 33 * MiB;
constexpr size_t WS_Q = WS_MIXN + 33 * MiB;
constexpr size_t WS_PR = WS_Q + 33 * MiB;
constexpr size_t WS_O = WS_PR + 32 * MiB;
constexpr size_t WS_MN = WS_O + 33 * MiB;
constexpr size_t WS_KB = WS_MN + 4 * MiB;
constexpr size_t WS_VT = WS_KB + 4 * MiB;
constexpr size_t WS_SE = WS_VT + 4 * MiB;
constexpr size_t WS_SI = WS_SE + 4 * MiB;
constexpr size_t WS_BB = WS_SI + 4 * MiB;
constexpr size_t WS_AT = WS_BB + 1 * MiB;
constexpr size_t WS_BTR = WS_AT + 1 * MiB;
constexpr size_t WS_BTI = WS_BTR + 65536;
constexpr size_t WS_CT = WS_BTI + 65536;
constexpr size_t WS_OV_END1 = WS_CT + 131072;
constexpr size_t WS_UG = WS_OV;
constexpr size_t WS_ACT = WS_UG + 182 * MiB;
constexpr size_t WS_CTL = WS_ACT + 91 * MiB;
constexpr size_t WS_PART = WS_CTL + 1 * MiB;
constexpr size_t WS_SSQ = WS_PART + 22 * MiB;
constexpr size_t WS_END = WS_SSQ + 1 * MiB;
static_assert(WS_OV_END1 <= WS_CTL, "overlay");
static_assert(WS_END <= 512 * MiB, "workspace");

constexpr size_t O_YP = 0;
constexpr size_t O_YS = O_YP + (size_t)NP * D;
constexpr size_t O_MK = O_YS + (size_t)NS * D;
constexpr size_t O_MV = O_MK + (size_t)BP * NMEM * D;
constexpr size_t O_SRP = O_MV + (size_t)BP * NMEM * D;
constexpr size_t O_SIP = O_SRP + (size_t)BP * SG * SN;
constexpr size_t O_CP = O_SIP + (size_t)BP * SG * SN;
constexpr size_t O_FP = O_CP + (size_t)BP * 2 * MIX;
constexpr size_t O_SRS = O_FP + (size_t)BP * 2 * DFF;
constexpr size_t O_SIS = O_SRS + (size_t)BS * SG * SN;
constexpr size_t O_CS = O_SIS + (size_t)BS * SG * SN;
constexpr size_t O_FS = O_CS + (size_t)BS * 2 * MIX;
constexpr size_t O_END = O_FS + (size_t)BS * 2 * DFF;

constexpr int RING_BYTES = 131072, XCH_OFF = RING_BYTES, LDS_BYTES = 147456;

typedef __bf16 bf16x2_t __attribute__((ext_vector_type(2)));
__device__ __forceinline__ unsigned cvt_pk_bf16(float lo, float hi) { const f32x2 v = {lo, hi}; const bf16x2_t b = __builtin_convertvector(v, bf16x2_t); return __builtin_bit_cast(unsigned, b); }
__device__ __forceinline__ float bf_lo(unsigned w) { return __uint_as_float(w << 16); }
__device__ __forceinline__ float bf_hi(unsigned w) { return __uint_as_float(w & 0xffff0000u); }
__device__ __forceinline__ float wave_sum(float v) {
#pragma unroll
    for (int o = 1; o < 64; o <<= 1) v += __shfl_xor(v, o);
    return v;
}
__device__ __forceinline__ float fast_exp(float x) { return __builtin_amdgcn_exp2f(x * 1.4426950408889634f); }
__device__ __forceinline__ float gelu_tanh(float x) {
    const float z = 0.7978845608028654f * (x + 0.044715f * x * x * x);
    return x * __builtin_amdgcn_rcpf(1.0f + fast_exp(-2.0f * z));
}
__device__ __forceinline__ float sigmoidf(float a) { return __builtin_amdgcn_rcpf(1.0f + fast_exp(-a)); }

namespace pg8 {
constexpr int BM = 256, BK = 64, HALF = 128, HTB = HALF * BK * 2;
__host__ __device__ __forceinline__ int lds_byte(int r, int c) { const int st = (r >> 4) * 2 + (c >> 5), rr = r & 15, cc = c & 31, ob = rr * 64 + cc * 2; return st * 1024 + (ob ^ (((ob >> 9) & 1) << 5)); }
__host__ __device__ __forceinline__ void stage_rc(int b, int& R, int& C) { const int st = b / 1024, sb = b % 1024, swz = sb ^ (((sb >> 9) & 1) << 5); R = (st >> 1) * 16 + swz / 64; C = (st & 1) * 32 + (swz % 64) / 2; }
__host__ __device__ __forceinline__ int perm32(int rho) { const int n = rho >> 4, i = rho & 15; return 8 * (i >> 2) + 4 * n + (i & 3); }

struct Unit { int pm, pn, kind, nt, ks; const char* A; const char* B; };

__device__ __forceinline__ void order_map(int L, int nM, int nN, int& pm, int& pn) {
    const int nwg = nM * nN; int wgid = L;
    { const int q = nwg / 8, r = nwg % 8, xcd = wgid % 8, off = wgid / 8; wgid = (xcd < r ? xcd * (q + 1) : r * (q + 1) + (xcd - r) * q) + off; }
    const int nig = 8 * nN, gid = wgid / nig, fm = gid * 8, gsz = (nM - fm) < 8 ? (nM - fm) : 8;
    pm = fm + ((wgid % nig) % gsz); pn = (wgid % nig) / gsz;
}

template <class Epi, class Sched>
__device__ __forceinline__ void gemm_phase(LAS unsigned char* lds, const int lda, const int ldb, const Sched& S, Epi& E) {
    int tid_l = threadIdx.x; asm volatile("" : "+v"(tid_l));
    const int tid = tid_l, wid = __builtin_amdgcn_readfirstlane(tid >> 6), lane = tid & 63, wr = wid >> 2, wc = wid & 3, fr = lane & 15, fq = lane >> 4;
    unsigned voffA[2], voffB[2];
#pragma unroll
    for (int i = 0; i < 2; ++i) { int R, C; stage_rc(tid * 16 + i * 8192, R, C); const int Rb = (R & ~31) + perm32(R & 31);
        voffA[i] = (unsigned)(R * lda + C) * 2u; voffB[i] = (unsigned)(Rb * ldb + C) * 2u; }
    const size_t kstep = (size_t)(BK * 2);
    const size_t hstepA = (size_t)HALF * lda * 2, hstepB = (size_t)HALF * ldb * 2;
    const unsigned ldsw = (unsigned)wid * 1024u;
    const int aoff = lds_byte(wr * 64 + fr, fq * 8), boff = lds_byte(wc * 32 + fr, fq * 8);
#define PG8_SA(b, h) (((b) * 2 + (h)) * HTB)
#define PG8_SB(b, h) ((4 + (b) * 2 + (h)) * HTB)
#define PG8_STAGE(bufoff, gbase, voff) do { _Pragma("unroll") for (int _i = 0; _i < 2; ++_i) \
        __builtin_amdgcn_global_load_lds((const unsigned*)((const char*)(gbase) + (voff)[_i]), (LAS unsigned*)(lds + (bufoff) + ldsw + _i * 8192), 16, 0, 0); } while (0)
#define PG8_LDA(dst, b, h) do { _Pragma("unroll") for (int m = 0; m < 4; ++m) _Pragma("unroll") for (int k = 0; k < 2; ++k) dst[m][k] = *(const LAS bf16x8*)(lds + PG8_SA(b, h) + aoff + m * 2048 + k * 1024); } while (0)
#define PG8_LDB(dst, b, h) do { _Pragma("unroll") for (int n = 0; n < 2; ++n) _Pragma("unroll") for (int k = 0; k < 2; ++k) dst[n][k] = *(const LAS bf16x8*)(lds + PG8_SB(b, h) + boff + n * 2048 + k * 1024); } while (0)
#define PG8_MMA(ai, bj, At, Bt) do { __builtin_amdgcn_s_setprio(1); _Pragma("unroll") for (int m = 0; m < 4; ++m) _Pragma("unroll") for (int n = 0; n < 2; ++n) _Pragma("unroll") for (int k = 0; k < 2; ++k) \
        acc[ai][bj][m][n] = __builtin_amdgcn_mfma_f32_16x16x32_bf16(Bt[n][k], At[m][k], acc[ai][bj][m][n], 0, 0, 0); __builtin_amdgcn_s_setprio(0); } while (0)
#define PG8_WAIT_V(n) asm volatile("s_waitcnt vmcnt(" #n ")" ::: "memory")
#define PG8_WAIT_L(n) asm volatile("s_waitcnt lgkmcnt(" #n ")" ::: "memory")
#define PG8_BAR __builtin_amdgcn_s_barrier()
#define PG8_SCHED __builtin_amdgcn_sched_barrier(0)
    Unit cur, nxt; int ui = 0;
    if (!S.next(0, cur)) return;
    f32x4 acc[2][2][4][2];
#pragma unroll
    for (int a = 0; a < 2; ++a)
#pragma unroll
        for (int b = 0; b < 2; ++b)
#pragma unroll
            for (int m = 0; m < 4; ++m)
#pragma unroll
                for (int n = 0; n < 2; ++n) acc[a][b][m][n] = (f32x4){0.f, 0.f, 0.f, 0.f};
    bf16x8 At[4][2], B0[2][2], B1[2][2];
    const char* cA = cur.A; const char* cB = cur.B;
    PG8_STAGE(PG8_SB(0, 0), cB, voffB); PG8_STAGE(PG8_SB(0, 1), cB + hstepB, voffB); PG8_STAGE(PG8_SA(0, 0), cA, voffA); PG8_STAGE(PG8_SA(0, 1), cA + hstepA, voffA);
    if (wr == 1) PG8_BAR;
    PG8_WAIT_V(2); PG8_BAR;
    PG8_STAGE(PG8_SB(1, 0), cB + kstep, voffB); PG8_STAGE(PG8_SA(1, 0), cA + kstep, voffA); PG8_STAGE(PG8_SB(1, 1), cB + hstepB + kstep, voffB);
    PG8_WAIT_V(6); PG8_BAR;
    for (;;) {
        const bool has_next = S.next(ui + 1, nxt);
        const char* nA = has_next ? nxt.A : cA; const char* nB = has_next ? nxt.B : cB;
        const int nt = cur.nt;
#pragma unroll 1
        for (int t = 0; t < nt; t += 2) {
            const bool last = (t == nt - 2);
            const char* a1 = cA + (size_t)(t + 1) * kstep;
            const char* a2 = last ? nA : cA + (size_t)(t + 2) * kstep; const char* b2 = last ? nB : cB + (size_t)(t + 2) * kstep;
            const char* a3 = a2 + kstep; const char* b3 = b2 + kstep;
            PG8_LDB(B0, 0, 0); PG8_LDB(B1, 0, 1); PG8_SCHED; PG8_LDA(At, 0, 0); PG8_STAGE(PG8_SA(1, 1), a1 + hstepA, voffA);
            PG8_WAIT_V(8); PG8_WAIT_L(0); PG8_BAR; PG8_MMA(0, 0, At, B0); PG8_MMA(0, 1, At, B1); PG8_BAR; PG8_SCHED;
            PG8_LDA(At, 0, 1); PG8_STAGE(PG8_SB(0, 0), b2, voffB); PG8_STAGE(PG8_SB(0, 1), b2 + hstepB, voffB); PG8_STAGE(PG8_SA(0, 0), a2, voffA);
            PG8_WAIT_V(8); PG8_WAIT_L(0); PG8_BAR; PG8_MMA(1, 0, At, B0); PG8_MMA(1, 1, At, B1); PG8_BAR; PG8_SCHED;
            PG8_LDB(B0, 1, 0); PG8_LDB(B1, 1, 1); PG8_SCHED; PG8_LDA(At, 1, 0); PG8_STAGE(PG8_SA(0, 1), a2 + hstepA, voffA);
            PG8_WAIT_V(8); PG8_WAIT_L(0); PG8_BAR; PG8_MMA(0, 0, At, B0); PG8_MMA(0, 1, At, B1); PG8_BAR; PG8_SCHED;
            PG8_LDA(At, 1, 1); PG8_STAGE(PG8_SB(1, 0), b3, voffB); PG8_STAGE(PG8_SB(1, 1), b3 + hstepB, voffB); PG8_STAGE(PG8_SA(1, 0), a3, voffA);
            PG8_WAIT_V(8); PG8_WAIT_L(0); PG8_BAR; PG8_MMA(1, 0, At, B0); PG8_MMA(1, 1, At, B1); PG8_BAR; PG8_SCHED;
        }
        if (wr == 0) PG8_BAR;
        E(acc, cur, wr, wc, fr, fq);
        if (!has_next) break;
#pragma unroll
        for (int a = 0; a < 2; ++a)
#pragma unroll
            for (int b = 0; b < 2; ++b)
#pragma unroll
                for (int m = 0; m < 4; ++m)
#pragma unroll
                    for (int n = 0; n < 2; ++n) acc[a][b][m][n] = (f32x4){0.f, 0.f, 0.f, 0.f};
        cur = nxt; cA = nA; cB = nB; ++ui;
        if (wr == 1) PG8_BAR;
    }
    PG8_WAIT_V(0);
    PG8_BAR;
#undef PG8_SA
#undef PG8_SB
#undef PG8_STAGE
#undef PG8_LDA
#undef PG8_LDB
#undef PG8_MMA
#undef PG8_WAIT_V
#undef PG8_WAIT_L
#undef PG8_BAR
#undef PG8_SCHED
}
}
using pg8::Unit;
typedef f32x4 Acc[2][2][4][2];

struct Sched2 {
    int G, c; int nM0, nN0, nt0, nM1, nN1, nt1, ks1, pm1;
    const char* A0; const char* B0; const char* A1; const char* B1; size_t a_pm, b_pn;
    __device__ __forceinline__ bool next(int i, Unit& u) const {
        const int L = i * G + c, n0 = nM0 * nN0, n1 = nM1 * nN1 * ks1;
        if (L >= n0 + n1) return false;
        if (L < n0) { pg8::order_map(L, nM0, nN0, u.pm, u.pn); u.kind = 0; u.nt = nt0; u.ks = 0; u.A = A0 + (size_t)u.pm * a_pm; u.B = B0 + (size_t)u.pn * b_pn; }
        else { const int j = L - n0, ks = j % ks1, t = j / ks1; u.pm = pm1 + t % nM1; u.pn = t / nM1; u.kind = 1; u.nt = nt1; u.ks = ks;
               u.A = A1 + (size_t)u.pm * a_pm + (size_t)ks * nt1 * 128; u.B = B1 + (size_t)u.pn * b_pn + (size_t)ks * nt1 * 128; }
        return true;
    }
};

#define EPI_ROWS(...) _Pragma("unroll") for (int ai = 0; ai < 2; ++ai) _Pragma("unroll") for (int m = 0; m < 4; ++m) { const int row = u.pm * 256 + ai * 128 + wr * 64 + m * 16 + fr; \
    _Pragma("unroll") for (int bj = 0; bj < 2; ++bj) { const int col = u.pn * 256 + bj * 128 + wc * 32 + fq * 8; const f32x4 v0 = acc[ai][bj][m][0], v1 = acc[ai][bj][m][1]; __VA_ARGS__ } }

__device__ __forceinline__ u32x4 pack8(f32x4 v0, f32x4 v1) { u32x4 w; w.x = cvt_pk_bf16(v0[0], v0[1]); w.y = cvt_pk_bf16(v0[2], v0[3]); w.z = cvt_pk_bf16(v1[0], v1[1]); w.w = cvt_pk_bf16(v1[2], v1[3]); return w; }

struct EpiP1 {
    bf16_t* Z; float* outK; float* outV; bf16_t* KB; bf16_t* VT;
    __device__ __forceinline__ void operator()(Acc& acc, const Unit& u, int wr, int wc, int fr, int fq) const {
        if (u.kind == 0) {
            EPI_ROWS( *(u32x4*)(Z + (size_t)row * NZ + col) = pack8(v0, v1); )
        } else if (u.pn < 4) {
            EPI_ROWS( float* o = outK + (size_t)row * D + col; *(f32x4*)o = v0; *(f32x4*)(o + 4) = v1; *(u32x4*)(KB + (size_t)row * D + col) = pack8(v0, v1); )
        } else {
            EPI_ROWS( const int vc = col - 1024; float* o = outV + (size_t)row * D + vc; *(f32x4*)o = v0; *(f32x4*)(o + 4) = v1;
                      const int h = vc >> 8, d0 = vc & 255, key = row & 255; bf16_t* vt = VT + ((size_t)(u.pm * NH + h) * HD + d0) * NMEM + key;
                      const u32x4 w = pack8(v0, v1);
                      vt[0 * NMEM] = (bf16_t)(w.x & 0xffff); vt[1 * NMEM] = (bf16_t)(w.x >> 16); vt[2 * NMEM] = (bf16_t)(w.y & 0xffff); vt[3 * NMEM] = (bf16_t)(w.y >> 16);
                      vt[4 * NMEM] = (bf16_t)(w.z & 0xffff); vt[5 * NMEM] = (bf16_t)(w.z >> 16); vt[6 * NMEM] = (bf16_t)(w.w & 0xffff); vt[7 * NMEM] = (bf16_t)(w.w >> 16); )
        }
    }
};
struct EpiGlu {
    const bf16_t* YG; const float* bias; float* YS;
    __device__ __forceinline__ void operator()(Acc& acc, const Unit& u, int wr, int wc, int fr, int fq) const {
        EPI_ROWS( const u32x4 yw = *(const u32x4*)(YG + (size_t)row * MIX + col); const f32x4 b0 = *(const f32x4*)(bias + col), b1 = *(const f32x4*)(bias + col + 4);
                  f32x4 o0, o1;
                  o0[0] = bf_lo(yw.x) * sigmoidf(v0[0] + b0[0]); o0[1] = bf_hi(yw.x) * sigmoidf(v0[1] + b0[1]); o0[2] = bf_lo(yw.y) * sigmoidf(v0[2] + b0[2]); o0[3] = bf_hi(yw.y) * sigmoidf(v0[3] + b0[3]);
                  o1[0] = bf_lo(yw.z) * sigmoidf(v1[0] + b1[0]); o1[1] = bf_hi(yw.z) * sigmoidf(v1[1] + b1[1]); o1[2] = bf_lo(yw.w) * sigmoidf(v1[2] + b1[2]); o1[3] = bf_hi(yw.w) * sigmoidf(v1[3] + b1[3]);
                  float* o = YS + (size_t)row * MIX + col; *(f32x4*)o = o0; *(f32x4*)(o + 4) = o1; )
    }
};
struct EpiRes {
    const float* xp; float* X; float* PART; int first; bf16_t* Hn; const float* g; float* ssq;
    __device__ __forceinline__ void operator()(Acc& acc, const Unit& u, int wr, int wc, int fr, int fq) const {
        if (u.kind == 0) {
            f32x4 gv[2][2];
            if (Hn) {
#pragma unroll
                for (int bj = 0; bj < 2; ++bj) { const int col = u.pn * 256 + bj * 128 + wc * 32 + fq * 8; gv[bj][0] = *(const f32x4*)(g + col); gv[bj][1] = *(const f32x4*)(g + col + 4); }
            }
#pragma unroll
            for (int ai = 0; ai < 2; ++ai)
#pragma unroll
                for (int m = 0; m < 4; ++m) { const int row = u.pm * 256 + ai * 128 + wr * 64 + m * 16 + fr; float ss = 0.f;
#pragma unroll
                    for (int bj = 0; bj < 2; ++bj) { const int col = u.pn * 256 + bj * 128 + wc * 32 + fq * 8;
                        const float* b = first ? xp + (size_t)row * D : (const float*)(X + (size_t)row * D);
                        const f32x4 r0 = *(const f32x4*)(b + col) + acc[ai][bj][m][0], r1 = *(const f32x4*)(b + col + 4) + acc[ai][bj][m][1];
                        float* o = X + (size_t)row * D + col; *(f32x4*)o = r0; *(f32x4*)(o + 4) = r1;
                        if (Hn) { *(u32x4*)(Hn + (size_t)row * D + col) = pack8(r0 * gv[bj][0], r1 * gv[bj][1]);
                            ss += (r0[0] * r0[0] + r0[1] * r0[1]) + (r0[2] * r0[2] + r0[3] * r0[3]) + (r1[0] * r1[0] + r1[1] * r1[1]) + (r1[2] * r1[2] + r1[3] * r1[3]); } }
                    if (Hn) { ss += __shfl_xor(ss, 16); ss += __shfl_xor(ss, 32); if (fq == 0) unsafeAtomicAdd(ssq + row, ss); }
                    asm volatile("" ::: "memory"); }
        } else {
            EPI_ROWS( float* o = PART + ((size_t)u.ks * NS + (row - NP)) * D + col; *(f32x4*)o = v0; *(f32x4*)(o + 4) = v1; )
        }
    }
};
struct EpiQ {
    bf16_t* Q; float* PART; const float* ssq;
    __device__ __forceinline__ void operator()(Acc& acc, const Unit& u, int wr, int wc, int fr, int fq) const {
        if (u.kind == 0) {
#pragma unroll
            for (int ai = 0; ai < 2; ++ai)
#pragma unroll
                for (int m = 0; m < 4; ++m) { const int row = u.pm * 256 + ai * 128 + wr * 64 + m * 16 + fr; const float sc = 0.0625f / sqrtf(ssq[row] * (1.0f / D) + EPS);
#pragma unroll
                    for (int bj = 0; bj < 2; ++bj) { const int col = u.pn * 256 + bj * 128 + wc * 32 + fq * 8; *(u32x4*)(Q + (size_t)row * D + col) = pack8(acc[ai][bj][m][0] * sc, acc[ai][bj][m][1] * sc); } }
        } else {
            EPI_ROWS( float* o = PART + ((size_t)u.ks * NS + (row - NP)) * D + col; *(f32x4*)o = v0 * 0.0625f; *(f32x4*)(o + 4) = v1 * 0.0625f; )
        }
    }
};
struct EpiBf {
    bf16_t* O; int ld; float scale; const float* ssq;
    __device__ __forceinline__ void operator()(Acc& acc, const Unit& u, int wr, int wc, int fr, int fq) const {
#pragma unroll
        for (int ai = 0; ai < 2; ++ai)
#pragma unroll
            for (int m = 0; m < 4; ++m) { const int row = u.pm * 256 + ai * 128 + wr * 64 + m * 16 + fr;
                const float sc = (ssq && row < NP) ? scale / sqrtf(ssq[row] * (1.0f / D) + EPS) : scale;
#pragma unroll
                for (int bj = 0; bj < 2; ++bj) { const int col = u.pn * 256 + bj * 128 + wc * 32 + fq * 8; *(u32x4*)(O + (size_t)row * ld + col) = pack8(acc[ai][bj][m][0] * sc, acc[ai][bj][m][1] * sc); } }
    }
};
struct EpiSoftmax {
    bf16_t* PR; LAS unsigned char* lds;
    __device__ __forceinline__ void operator()(Acc& acc, const Unit& u, int wr, int wc, int fr, int fq) const {
        LAS f32x2* X = (LAS f32x2*)(lds + XCH_OFF);
#pragma unroll
        for (int ai = 0; ai < 2; ++ai)
#pragma unroll
            for (int m = 0; m < 4; ++m) {
                float mx = -3.0e38f;
#pragma unroll
                for (int bj = 0; bj < 2; ++bj)
#pragma unroll
                    for (int n = 0; n < 2; ++n) { const f32x4 x = acc[ai][bj][m][n]; mx = fmaxf(mx, fmaxf(fmaxf(x[0], x[1]), fmaxf(x[2], x[3]))); }
                mx = fmaxf(mx, __shfl_xor(mx, 16)); mx = fmaxf(mx, __shfl_xor(mx, 32));
                float s = 0.f;
#pragma unroll
                for (int bj = 0; bj < 2; ++bj)
#pragma unroll
                    for (int n = 0; n < 2; ++n) { f32x4 x = acc[ai][bj][m][n];
                        x[0] = fast_exp(x[0] - mx); x[1] = fast_exp(x[1] - mx); x[2] = fast_exp(x[2] - mx); x[3] = fast_exp(x[3] - mx);
                        s += (x[0] + x[1]) + (x[2] + x[3]); acc[ai][bj][m][n] = x; }
                s += __shfl_xor(s, 16); s += __shfl_xor(s, 32);
                if (fq == 0) X[(ai * 128 + wr * 64 + m * 16 + fr) * 4 + wc] = (f32x2){mx, s};
            }
        asm volatile("s_waitcnt lgkmcnt(0)" ::: "memory"); __builtin_amdgcn_s_barrier(); asm volatile("" ::: "memory");
#pragma unroll
        for (int ai = 0; ai < 2; ++ai)
#pragma unroll
            for (int m = 0; m < 4; ++m) {
                const int rl = ai * 128 + wr * 64 + m * 16 + fr;
                const f32x2 a = X[rl * 4 + 0], b = X[rl * 4 + 1], c = X[rl * 4 + 2], d = X[rl * 4 + 3];
                const float M = fmaxf(fmaxf(a.x, b.x), fmaxf(c.x, d.x));
                const float tot = a.y * fast_exp(a.x - M) + b.y * fast_exp(b.x - M) + c.y * fast_exp(c.x - M) + d.y * fast_exp(d.x - M);
                const float own = wc == 0 ? a.x : (wc == 1 ? b.x : (wc == 2 ? c.x : d.x));
                const float f = fast_exp(own - M) / tot;
                bf16_t* prow = PR + ((size_t)(u.pm * NH + u.pn) * 256 + rl) * 256;
#pragma unroll
                for (int bj = 0; bj < 2; ++bj) { const int col = bj * 128 + wc * 32 + fq * 8; *(u32x4*)(prow + col) = pack8(acc[ai][bj][m][0] * f, acc[ai][bj][m][1] * f); }
                asm volatile("" ::: "memory");
            }
    }
};


template <int CTRL> __device__ __forceinline__ float dppf(float v) { return __builtin_bit_cast(float, __builtin_amdgcn_update_dpp(0, __builtin_bit_cast(int, v), CTRL, 0xF, 0xF, true)); }
template <int CTRL> __device__ __forceinline__ float dppf_old(float old, float v) { return __builtin_bit_cast(float, __builtin_amdgcn_update_dpp(__builtin_bit_cast(int, old), __builtin_bit_cast(int, v), CTRL, 0xF, 0xF, false)); }
__device__ __forceinline__ float prev_row1(float cur, float pf) { float o = dppf<0x10F>(pf); asm volatile("" : "+v"(o)); float r = dppf_old<0x111>(o, cur); asm volatile("" : "+v"(r)); return r; }
__device__ __forceinline__ float prev_row2(float cur, float pf) { float o = dppf<0x10E>(pf); asm volatile("" : "+v"(o)); float r = dppf_old<0x112>(o, cur); asm volatile("" : "+v"(r)); return r; }
struct EpiFfn {
    bf16_t* ACT; const bf16_t* H; const bf16_t* WUG; const float* cw; const float* st_ffn; float* outFP; float* outFS; const float* ssq; LAS unsigned char* lds;
    __device__ __forceinline__ void operator()(Acc& acc, const Unit& u, int wr, int wc, int fr, int fq) const {
        const int lane = fq * 16 + fr, wid = wr * 4 + wc;
        LAS float* HB = (LAS float*)(lds + XCH_OFF);
        const bool sample = u.pm >= NP / 256;
        const int cl0 = wc * 32 + fq * 8, ch0 = u.pn * 128 + cl0;
        if (!sample) {
#pragma unroll
            for (int ai = 0; ai < 2; ++ai)
#pragma unroll
                for (int m = 0; m < 4; ++m) { const int row = u.pm * 256 + ai * 128 + wr * 64 + m * 16 + fr; const float rs = 1.0f / sqrtf(ssq[row] * (1.0f / D) + EPS);
#pragma unroll
                    for (int bj = 0; bj < 2; ++bj) { acc[ai][bj][m][0] *= rs; acc[ai][bj][m][1] *= rs; } }
            if ((u.pm & 7) != 0) {
                f32x4 hacc = (f32x4){0.f, 0.f, 0.f, 0.f};
                const bf16_t* ap = H + (size_t)(u.pm * 256 - 2 + (fr < 2 ? fr : 0)) * D + fq * 8;
                const bf16_t* bp = WUG + (size_t)(u.pn * 256 + wid * 16 + fr) * D + fq * 8;
#pragma unroll 8
                for (int kb = 0; kb < 32; ++kb) { const bf16x8 a = *(const bf16x8*)(ap + kb * 32), b = *(const bf16x8*)(bp + kb * 32); hacc = __builtin_amdgcn_mfma_f32_16x16x32_bf16(a, b, hacc, 0, 0, 0); }
                if (fq == 0) { const int r0 = u.pm * 256 - 2; const float s0 = 1.0f / sqrtf(ssq[r0] * (1.0f / D) + EPS), s1 = 1.0f / sqrtf(ssq[r0 + 1] * (1.0f / D) + EPS);
                    HB[0 * 128 + wid * 16 + fr] = hacc[0] * s0; HB[1 * 128 + wid * 16 + fr] = hacc[1] * s1; }
            } else if (wid < 4) HB[wid * 64 + lane] = 0.f;
            if (fr >= 14) {
#pragma unroll
                for (int ai = 0; ai < 2; ++ai) { LAS float* d = HB + ((1 + ai * 2 + wr) * 2 + (fr - 14)) * 128 + cl0; *(LAS f32x4*)d = acc[ai][0][3][0]; *(LAS f32x4*)(d + 4) = acc[ai][0][3][1]; }
            }
        }
        asm volatile("s_waitcnt lgkmcnt(0)" ::: "memory"); __builtin_amdgcn_s_barrier(); asm volatile("" ::: "memory");
        const f32x4 w0a = *(const f32x4*)(cw + ch0), w0b = *(const f32x4*)(cw + ch0 + 4), w1a = *(const f32x4*)(cw + DFF + ch0), w1b = *(const f32x4*)(cw + DFF + ch0 + 4),
                    w2a = *(const f32x4*)(cw + 2 * DFF + ch0), w2b = *(const f32x4*)(cw + 2 * DFF + ch0 + 4);
#pragma unroll
        for (int ai = 0; ai < 2; ++ai) {
            f32x4 pva = (f32x4){0.f, 0.f, 0.f, 0.f}, pvb = pva;
            if (!sample) { const int slot = ai == 0 ? (wr == 0 ? 0 : 1) : (wr == 0 ? 2 : 3);
                const LAS float* hp = HB + (slot * 2 + (fr >= 14 ? fr - 14 : 0)) * 128 + cl0; pva = *(const LAS f32x4*)hp; pvb = *(const LAS f32x4*)(hp + 4); }
#pragma unroll
            for (int m = 0; m < 4; ++m) {
                const int row = u.pm * 256 + ai * 128 + wr * 64 + m * 16 + fr;
                const f32x4 ca = acc[ai][0][m][0], cb = acc[ai][0][m][1];
                const f32x4 fa = m ? acc[ai][0][m ? m - 1 : 0][0] : pva, fb = m ? acc[ai][0][m ? m - 1 : 0][1] : pvb;
                f32x4 p1a, p1b, p2a, p2b;
                if (!sample) {
#pragma unroll
                    for (int e = 0; e < 4; ++e) {
                        p1a[e] = prev_row1(ca[e], fa[e]); p1b[e] = prev_row1(cb[e], fb[e]);
                        p2a[e] = prev_row2(ca[e], fa[e]); p2b[e] = prev_row2(cb[e], fb[e]); }
                } else {
                    const int t = fr & 3; const float* sp = st_ffn + (size_t)((row - NP) >> 2) * 2 * DFF + ch0;
                    const f32x4 s0a = *(const f32x4*)sp, s0b = *(const f32x4*)(sp + 4), s1a = *(const f32x4*)(sp + DFF), s1b = *(const f32x4*)(sp + DFF + 4);
#pragma unroll
                    for (int e = 0; e < 4; ++e) {
                        float r1a = dppf<0x111>(ca[e]), r1b = dppf<0x111>(cb[e]), r2a = dppf<0x112>(ca[e]), r2b = dppf<0x112>(cb[e]);
                        asm volatile("" : "+v"(r1a), "+v"(r1b), "+v"(r2a), "+v"(r2b));
                        p1a[e] = t >= 1 ? r1a : s1a[e]; p1b[e] = t >= 1 ? r1b : s1b[e];
                        p2a[e] = t >= 2 ? r2a : (t == 0 ? s0a[e] : s1a[e]); p2b[e] = t >= 2 ? r2b : (t == 0 ? s0b[e] : s1b[e]); }
                }
                const f32x4 ga = acc[ai][1][m][0], gb = acc[ai][1][m][1];
                f32x4 oa, ob;
#pragma unroll
                for (int e = 0; e < 4; ++e) { oa[e] = gelu_tanh(w0a[e] * p2a[e] + w1a[e] * p1a[e] + w2a[e] * ca[e]) * ga[e]; ob[e] = gelu_tanh(w0b[e] * p2b[e] + w1b[e] * p1b[e] + w2b[e] * cb[e]) * gb[e]; }
                *(u32x4*)(ACT + (size_t)row * DFF + ch0) = pack8(oa, ob);
                if (!sample) {
                    if ((u.pm & 7) == 7 && ai == 1 && wr == 1 && m == 3 && fr >= 14) { float* o = outFP + ((size_t)(u.pm >> 3) * 2 + (fr - 14)) * DFF + ch0; *(f32x4*)o = ca; *(f32x4*)(o + 4) = cb; }
                } else if ((fr & 3) >= 2) { float* o = outFS + ((size_t)((row - NP) >> 2) * 2 + ((fr & 3) - 2)) * DFF + ch0; *(f32x4*)o = ca; *(f32x4*)(o + 4) = cb; }
            }
        }
    }
};

#ifndef ONLY
#define ONLY -1
#endif
#define PH(k) (ONLY < 0 || ONLY == (k))
#define GSYNC() xcd_barrier(xb)
struct Args { const float* in[37]; float* out; unsigned char* ws; };

__device__ __forceinline__ void transpose_item(const float* W, int K, int N, bf16_t* WT, int row_off, LAS float* scr, int item, int lane, int remap = 0) {
    const int nblk = N / 32, kb = item / nblk, nb = item % nblk, k0 = 64 * kb, n0 = 32 * nb;
    if (remap) row_off = (n0 >> 7) * 256 + (n0 & 127) + (remap == 2 ? 128 : 0) - n0;
#pragma unroll 8
    for (int i = 0; i < 32; ++i) { const int kk = 2 * i + (lane >> 5); scr[kk * 33 + (lane & 31)] = W[(size_t)(k0 + kk) * N + n0 + (lane & 31)]; }
    asm volatile("s_waitcnt lgkmcnt(0)" ::: "memory");
    const int c = lane & 7;
#pragma unroll
    for (int j = 0; j < 4; ++j) { const int n = (lane >> 3) + 8 * j; const LAS float* s = scr + (8 * c) * 33 + n;
        u32x4 o; o.x = cvt_pk_bf16(s[0 * 33], s[1 * 33]); o.y = cvt_pk_bf16(s[2 * 33], s[3 * 33]); o.z = cvt_pk_bf16(s[4 * 33], s[5 * 33]); o.w = cvt_pk_bf16(s[6 * 33], s[7 * 33]);
        *(u32x4*)(WT + (size_t)(row_off + n0 + n) * K + k0 + 8 * c) = o; }
    asm volatile("s_waitcnt lgkmcnt(0)" ::: "memory");
}

__device__ __forceinline__ void add_parts(float* xrow, const float* part, int nparts, size_t pstride, int lane) {
    f32x4* xr = (f32x4*)xrow + lane; f32x4 v[4];
#pragma unroll
    for (int j = 0; j < 4; ++j) v[j] = xr[64 * j];
    for (int k = 0; k < nparts; ++k) { const f32x4* pr = (const f32x4*)(part + (size_t)k * pstride) + lane;
#pragma unroll
        for (int j = 0; j < 4; ++j) v[j] += pr[64 * j]; }
#pragma unroll
    for (int j = 0; j < 4; ++j) xr[64 * j] = v[j];
}
__device__ __forceinline__ void rms_row_bf16(const float* xrow, const float* g, bf16_t* orow, int lane) {
    const f32x4* xr = (const f32x4*)xrow + lane; f32x4 v[4]; float s = 0.f;
#pragma unroll
    for (int j = 0; j < 4; ++j) { v[j] = xr[64 * j]; s += (v[j][0] * v[j][0] + v[j][1] * v[j][1]) + (v[j][2] * v[j][2] + v[j][3] * v[j][3]); }
    const float rstd = 1.0f / sqrtf(wave_sum(s) * (1.0f / D) + EPS);
    u32x2* o8 = (u32x2*)orow + lane;
#pragma unroll
    for (int j = 0; j < 4; ++j) { const f32x4 gg = ((const f32x4*)g)[lane + 64 * j]; u32x2 w; w.x = cvt_pk_bf16(v[j][0] * rstd * gg[0], v[j][1] * rstd * gg[1]); w.y = cvt_pk_bf16(v[j][2] * rstd * gg[2], v[j][3] * rstd * gg[3]); o8[64 * j] = w; }
}
__device__ __forceinline__ void rms_row_f32(const float* xrow, const float* g, float* orow, int lane) {
    const f32x4* xr = (const f32x4*)xrow + lane; f32x4 v[4]; float s = 0.f;
#pragma unroll
    for (int j = 0; j < 4; ++j) { v[j] = xr[64 * j]; s += (v[j][0] * v[j][0] + v[j][1] * v[j][1]) + (v[j][2] * v[j][2] + v[j][3] * v[j][3]); }
    const float rstd = 1.0f / sqrtf(wave_sum(s) * (1.0f / D) + EPS);
#pragma unroll
    for (int j = 0; j < 4; ++j) { const f32x4 gg = ((const f32x4*)g)[lane + 64 * j]; ((f32x4*)orow)[lane + 64 * j] = v[j] * rstd * gg; }
}

__device__ __forceinline__ float treduce16(float (&v)[16], int lane) {
    { const bool hi = lane & 32;
#pragma unroll
      for (int i = 0; i < 8; ++i) { const float send = hi ? v[i] : v[i + 8], keep = hi ? v[i + 8] : v[i]; v[i] = keep + __shfl_xor(send, 32); } }
    { const bool hi = lane & 16;
#pragma unroll
      for (int i = 0; i < 4; ++i) { const float send = hi ? v[i] : v[i + 4], keep = hi ? v[i + 4] : v[i]; v[i] = keep + __shfl_xor(send, 16); } }
    { const bool hi = lane & 8;
#pragma unroll
      for (int i = 0; i < 2; ++i) { const float send = hi ? v[i] : v[i + 2], keep = hi ? v[i + 2] : v[i]; v[i] = keep + __shfl_xor(send, 8); } }
    { const bool hi = lane & 4; const float send = hi ? v[0] : v[1], keep = hi ? v[1] : v[0]; v[0] = keep + __shfl_xor(send, 4); }
    v[0] += __shfl_xor(v[0], 2); v[0] += __shfl_xor(v[0], 1);
    return v[0];
}
template <int W> __device__ __forceinline__ void tr_step(float (&v)[64], int lane) {
    const bool hi = lane & W;
#pragma unroll
    for (int i = 0; i < W; ++i) { const float send = hi ? v[i] : v[i + W], keep = hi ? v[i + W] : v[i]; v[i] = keep + __shfl_xor(send, W); }
}
__device__ __forceinline__ float treduce64(float (&v)[64], int lane) {
    tr_step<32>(v, lane); tr_step<16>(v, lane); tr_step<8>(v, lane); tr_step<4>(v, lane); tr_step<2>(v, lane); tr_step<1>(v, lane);
    return v[0];
}

template <bool WITH_Y>
__device__ __forceinline__ void ssm_tile(const bf16_t* zu, int nsteps, float& sr, float& si, const float* BB, const float* AT, const float* Cre, const float* Cim, const float* Dv,
                                         int g, bf16_t* yg, int lane) {
    float Br[16], Bi[16];
    { const f32x4* bp = (const f32x4*)(BB + (size_t)(g * SN + lane) * 32);
#pragma unroll
      for (int j = 0; j < 4; ++j) { const f32x4 a = bp[j], b = bp[4 + j]; Br[4 * j] = a[0]; Br[4 * j + 1] = a[1]; Br[4 * j + 2] = a[2]; Br[4 * j + 3] = a[3]; Bi[4 * j] = b[0]; Bi[4 * j + 1] = b[1]; Bi[4 * j + 2] = b[2]; Bi[4 * j + 3] = b[3]; } }
    const f32x4 at = *(const f32x4*)(AT + (size_t)(g * SN + lane) * 4); const float ar = at[0], ai = at[1];
    float Cr[16], Ci[16], Dm[16];
    if (WITH_Y) {
#pragma unroll
        for (int p = 0; p < 16; ++p) { Cr[p] = Cre[(size_t)(g * SP + p) * SN + lane]; Ci[p] = Cim[(size_t)(g * SP + p) * SN + lane]; Dm[p] = (lane == 0) ? Dv[g * SP + p] : 0.f; }
    }
    u32x4 u0 = (u32x4){0, 0, 0, 0}, u1 = (u32x4){0, 0, 0, 0};
    if (lane < nsteps) { const u32x4* up = (const u32x4*)(zu + (size_t)lane * NZ); u0 = up[0]; u1 = up[1]; }
    const int p_own = ((lane >> 5) & 1) * 8 + ((lane >> 4) & 1) * 4 + ((lane >> 3) & 1) * 2 + ((lane >> 2) & 1);
    for (int t = 0; t < nsteps; ++t) {
        float uu[16];
        { unsigned w;
          w = __builtin_amdgcn_readlane(u0.x, t); uu[0] = bf_lo(w); uu[1] = bf_hi(w);
          w = __builtin_amdgcn_readlane(u0.y, t); uu[2] = bf_lo(w); uu[3] = bf_hi(w);
          w = __builtin_amdgcn_readlane(u0.z, t); uu[4] = bf_lo(w); uu[5] = bf_hi(w);
          w = __builtin_amdgcn_readlane(u0.w, t); uu[6] = bf_lo(w); uu[7] = bf_hi(w);
          w = __builtin_amdgcn_readlane(u1.x, t); uu[8] = bf_lo(w); uu[9] = bf_hi(w);
          w = __builtin_amdgcn_readlane(u1.y, t); uu[10] = bf_lo(w); uu[11] = bf_hi(w);
          w = __builtin_amdgcn_readlane(u1.z, t); uu[12] = bf_lo(w); uu[13] = bf_hi(w);
          w = __builtin_amdgcn_readlane(u1.w, t); uu[14] = bf_lo(w); uu[15] = bf_hi(w); }
        float br = 0.f, bi = 0.f;
#pragma unroll
        for (int p = 0; p < 16; ++p) { br = fmaf(Br[p], uu[p], br); bi = fmaf(Bi[p], uu[p], bi); }
        const float nr = ar * sr - ai * si + br, ni = ar * si + ai * sr + bi;
        sr = nr; si = ni;
        if (WITH_Y) {
            float v[16];
#pragma unroll
            for (int p = 0; p < 16; ++p) v[p] = fmaf(Dm[p], uu[p], Cr[p] * sr - Ci[p] * si);
            const float y = treduce16(v, lane);
            const float gy = gelu_tanh(y);
            if ((lane & 3) == 0) yg[(size_t)t * MIX + g * SP + p_own] = (bf16_t)(cvt_pk_bf16(gy, 0.f) & 0xffff);
        }
    }
}


typedef short bf16x4 __attribute__((ext_vector_type(4)));
struct SsmTab { bf16x4 Bre[4], Bim[4]; bf16x8 Ct[4]; float dp; float ar, ai; };
__device__ __forceinline__ void ssm_load_tab(SsmTab& T, int g, const bf16_t* BTR, const bf16_t* BTI, const bf16_t* CT, const float* AT, const float* Dv, int lane, bool with_y) {
    const int li = lane & 15, lq = lane >> 4;
#pragma unroll
    for (int nt = 0; nt < 4; ++nt) { T.Bre[nt] = *(const bf16x4*)(BTR + ((size_t)(g * SN + 16 * nt + li)) * 16 + 4 * lq); T.Bim[nt] = *(const bf16x4*)(BTI + ((size_t)(g * SN + 16 * nt + li)) * 16 + 4 * lq); }
    const f32x4 at = *(const f32x4*)(AT + (size_t)(g * SN + lane) * 4); T.ar = at[0]; T.ai = at[1];
    if (with_y) {
#pragma unroll
        for (int kb = 0; kb < 4; ++kb) T.Ct[kb] = *(const bf16x8*)(CT + ((size_t)(g * SP + li)) * 128 + kb * 32 + 8 * lq);
        T.dp = Dv[g * SP + li];
    }
}
template <bool WITH_Y>
__device__ __forceinline__ void ssm_chunk(LAS unsigned char* wl, const bf16_t* zu, float& sr, float& si, const SsmTab& T, bf16_t* yg, int lane) {
    const int li = lane & 15, lq = lane >> 4;
    bf16x4 U[4];
#pragma unroll
    for (int mt = 0; mt < 4; ++mt) U[mt] = *(const bf16x4*)(zu + (size_t)(16 * mt + li) * NZ + 4 * lq);
    {
        int rofs[4], nofs[4];
#pragma unroll
        for (int r = 0; r < 4; ++r) { rofs[r] = lq * 1024 + (li & 3) * 4 + r * 256 + (((li >> 2) ^ r) << 4); nofs[r] = ((r ^ lq) << 6); }
#pragma unroll 1
        for (int mt = 0; mt < 4; ++mt) {
            LAS unsigned char* pm = wl + mt * 4096;
            const bf16x4 um = mt == 0 ? U[0] : (mt == 1 ? U[1] : (mt == 2 ? U[2] : U[3]));
#pragma unroll
            for (int nt = 0; nt < 4; ++nt) {
                const f32x4 dre = __builtin_amdgcn_mfma_f32_16x16x16bf16_1k(um, T.Bre[nt], (f32x4){0.f, 0.f, 0.f, 0.f}, 0, 0, 0);
                const f32x4 dim = __builtin_amdgcn_mfma_f32_16x16x16bf16_1k(um, T.Bim[nt], (f32x4){0.f, 0.f, 0.f, 0.f}, 0, 0, 0);
#pragma unroll
                for (int r = 0; r < 4; ++r) *(LAS unsigned*)(pm + rofs[r] + nofs[nt]) = cvt_pk_bf16(dre[r], dim[r]);
            }
        }
    }
    asm volatile("s_waitcnt lgkmcnt(0)" ::: "memory");
    {
        const float ar = T.ar, ai = T.ai;
        int xj[16];
#pragma unroll
        for (int j = 0; j < 16; ++j) xj[j] = (((lane >> 2) ^ j) << 4) + (lane & 3) * 4 + j * 256;
#pragma unroll 1
        for (int tb = 0; tb < 4; ++tb) {
            LAS unsigned char* pb = wl + tb * 4096;
            unsigned w[16];
#pragma unroll
            for (int j = 0; j < 16; ++j) w[j] = *(const LAS unsigned*)(pb + xj[j]);
#pragma unroll
            for (int j = 0; j < 16; ++j) {
                const float nr = ar * sr - ai * si + bf_lo(w[j]), ni = ar * si + ai * sr + bf_hi(w[j]);
                sr = nr; si = ni;
                if (WITH_Y) *(LAS unsigned*)(pb + xj[j]) = cvt_pk_bf16(sr, si);
            }
        }
    }
    if (WITH_Y) {
        asm volatile("s_waitcnt lgkmcnt(0)" ::: "memory");
        int kofs[4];
#pragma unroll
        for (int kb = 0; kb < 4; ++kb) kofs[kb] = li * 256 + ((((kb * 4 + lq) ^ li)) << 4);
#pragma unroll 1
        for (int mt = 0; mt < 4; ++mt) {
            const LAS unsigned char* pm = wl + mt * 4096;
            f32x4 acc = (f32x4){0.f, 0.f, 0.f, 0.f};
#pragma unroll
            for (int kb = 0; kb < 4; ++kb) { const bf16x8 a = *(const LAS bf16x8*)(pm + kofs[kb]); acc = __builtin_amdgcn_mfma_f32_16x16x32_bf16(a, T.Ct[kb], acc, 0, 0, 0); }
            bf16_t* yp = yg + (size_t)(16 * mt + 4 * lq) * MIX + li;
            const bf16_t* up = zu + (size_t)(16 * mt + 4 * lq) * NZ + li;
#pragma unroll
            for (int r = 0; r < 4; ++r) { const float uv = __uint_as_float(((unsigned)up[(size_t)r * NZ]) << 16);
                yp[(size_t)r * MIX] = (bf16_t)(cvt_pk_bf16(gelu_tanh(fmaf(T.dp, uv, acc[r])), 0.f) & 0xffff); }
        }
        asm volatile("s_waitcnt lgkmcnt(0)" ::: "memory");
    }
}

#define XB_TMO      128
#define XB_XCNT(j)  (256  + 64 * (j))
#define XB_XSUB(j)  (1280 + 64 * (j))
#define XB_XGEN(j)  (2304 + 64 * (j))
#define XB_TOP      3328
#define XB_TOPGEN   3392
#define XCD_BAR_WORDS 3456
#define XB_SPIN_CAP (1u << 18)
__device__ __forceinline__ unsigned xb_ld(unsigned* p)              { return __hip_atomic_load(p, __ATOMIC_RELAXED, __HIP_MEMORY_SCOPE_AGENT); }
__device__ __forceinline__ unsigned xb_add(unsigned* p, unsigned v) { return __hip_atomic_fetch_add(p, v, __ATOMIC_RELAXED, __HIP_MEMORY_SCOPE_AGENT); }
__device__ __forceinline__ unsigned xb_xcc_id() { return (unsigned)__builtin_amdgcn_s_getreg((3 << 11) | 20) & 0xFu; }
#define XB_SPIN(cond, bar) do { unsigned _sp = 0; while (cond) { __builtin_amdgcn_s_sleep(1); \
    if ((++_sp & 255u) == 0u) { if (xb_ld(&(bar)[XB_TMO])) break; if (_sp > XB_SPIN_CAP) { atomicAdd(&(bar)[XB_TMO], 1u); break; } } } } while (0)
struct XcdBarrier { unsigned* bar; unsigned x; volatile LAS unsigned* st; };
__device__ __forceinline__ XcdBarrier xcd_barrier_post(unsigned* bar, volatile LAS unsigned* st) {
    XcdBarrier b; b.bar = bar; b.x = xb_xcc_id(); b.st = st;
    if (threadIdx.x == 0) (void)xb_add(&bar[XB_XCNT(b.x)], 1u);
    return b;
}
__device__ __forceinline__ void xcd_barrier_complete(unsigned* bar, unsigned x, unsigned& nloc, unsigned& nx) {
    const unsigned G = gridDim.x * gridDim.y * gridDim.z;
    unsigned sum, cnt, mine, sp = 0u;
    for (;;) {
        sum = 0u; cnt = 0u; mine = 0u;
#pragma unroll
        for (unsigned j = 0; j < 16; ++j) { const unsigned c = xb_ld(&bar[XB_XCNT(j)]); sum += c; cnt += (c > 0u) ? 1u : 0u; mine = (j == x) ? c : mine; }
        if (sum == G) break;
        __builtin_amdgcn_s_sleep(1);
        if ((++sp & 255u) == 0u) { if (xb_ld(&bar[XB_TMO])) break; if (sp > XB_SPIN_CAP) { atomicAdd(&bar[XB_TMO], 1u); break; } }
    }
    nloc = mine > 0u ? mine : 1u; nx = cnt > 0u ? cnt : 1u;
}
__device__ __forceinline__ void xcd_barrier(const XcdBarrier& b) {
    asm volatile("s_waitcnt vmcnt(0)" ::: "memory");
    __syncthreads();
    if (threadIdx.x == 0) {
        unsigned* bar = b.bar;
        __builtin_amdgcn_s_waitcnt(0);
        unsigned nloc = b.st[0], nx = b.st[1];
        if (nloc == 0u) { xcd_barrier_complete(bar, b.x, nloc, nx); b.st[0] = nloc; b.st[1] = nx; }
        const unsigned old = xb_add(&bar[XB_XSUB(b.x)], 1u);
        const unsigned gen = old / nloc;
        if (old + 1u == (gen + 1u) * nloc) {
            __builtin_amdgcn_fence(__ATOMIC_RELEASE, "agent");
            asm volatile("s_waitcnt vmcnt(0)" ::: "memory");
            const unsigned og = xb_add(&bar[XB_TOP], 1u);
            const unsigned tg = og / nx;
            if (og + 1u == (tg + 1u) * nx) xb_add(&bar[XB_TOPGEN], 1u);
            else XB_SPIN(xb_ld(&bar[XB_TOPGEN]) == tg, bar);
            __builtin_amdgcn_fence(__ATOMIC_ACQUIRE, "agent");
            xb_add(&bar[XB_XGEN(b.x)], 1u);
            asm volatile("s_waitcnt vmcnt(0)" ::: "memory");
        } else {
            XB_SPIN(xb_ld(&bar[XB_XGEN(b.x)]) == gen, bar);
            __builtin_amdgcn_fence(__ATOMIC_ACQUIRE, "agent");
            asm volatile("s_waitcnt vmcnt(0)" ::: "memory");
        }
    }
    __syncthreads();
}

__device__ __forceinline__ const float* ld_in(int k) {
    const __attribute__((address_space(4))) unsigned long long* t = (const __attribute__((address_space(4))) unsigned long long*)__builtin_amdgcn_kernarg_segment_ptr();
    asm volatile("" : "+s"(t));
    return (const float*)t[k];
}
__global__ void __launch_bounds__(NTHREADS, 2) hymba_fwd(Args args) {
    extern __shared__ __attribute__((aligned(16))) unsigned char lds_raw[];
    LAS unsigned char* lds = (LAS unsigned char*)lds_raw;
    cg::grid_group grid = cg::this_grid();
    const int tid = threadIdx.x, lane = tid & 63, wave = __builtin_amdgcn_readfirstlane(tid >> 6);
    const int G = gridDim.x, bx = blockIdx.x;
    const int gw = bx * NWAVES + wave, NGW = G * NWAVES;
#define IN(k) ld_in(k)
    unsigned char* ws = (unsigned char*)ld_in(38); float* out = (float*)ld_in(37);
    unsigned* barw = (unsigned*)(ws + WS_CTL);
    volatile LAS unsigned* bst = (volatile LAS unsigned*)(lds + XCH_OFF + 8192);
    if (bx == 0) for (int i = tid; i < XCD_BAR_WORDS; i += NTHREADS) barw[i] = 0u;
    if (tid < 2) bst[tid] = 0u;
    bf16_t* WIN = (bf16_t*)(ws + WS_WIN); bf16_t* WKV = (bf16_t*)(ws + WS_WKV); bf16_t* WGLU = (bf16_t*)(ws + WS_WGLU); bf16_t* WOUT = (bf16_t*)(ws + WS_WOUT);
    bf16_t* WQ = (bf16_t*)(ws + WS_WQ); bf16_t* WXO = (bf16_t*)(ws + WS_WXO); bf16_t* WUG = (bf16_t*)(ws + WS_WUG); bf16_t* WDN = (bf16_t*)(ws + WS_WDN);
    bf16_t* H = (bf16_t*)(ws + WS_H); float* X = (float*)(ws + WS_X);
    bf16_t* Z = (bf16_t*)(ws + WS_Z); bf16_t* YG = (bf16_t*)(ws + WS_YG); float* YS = (float*)(ws + WS_YS); bf16_t* MIXN = (bf16_t*)(ws + WS_MIXN);
    bf16_t* Q = (bf16_t*)(ws + WS_Q); bf16_t* PR = (bf16_t*)(ws + WS_PR); bf16_t* O = (bf16_t*)(ws + WS_O);
    bf16_t* MN = (bf16_t*)(ws + WS_MN); bf16_t* KB = (bf16_t*)(ws + WS_KB); bf16_t* VT = (bf16_t*)(ws + WS_VT);
    float* SE = (float*)(ws + WS_SE); float* SI = (float*)(ws + WS_SI); float* BB = (float*)(ws + WS_BB); float* AT = (float*)(ws + WS_AT);
    float* PART = (float*)(ws + WS_PART); float* SSQ = (float*)(ws + WS_SSQ);
    bf16_t* BTR = (bf16_t*)(ws + WS_BTR); bf16_t* BTI = (bf16_t*)(ws + WS_BTI); bf16_t* CT = (bf16_t*)(ws + WS_CT);
    bf16_t* UG = (bf16_t*)(ws + WS_UG); bf16_t* ACT = (bf16_t*)(ws + WS_ACT);

    if (PH(0)) {
        const float* x_prompt = IN(0); const float* x_sample = IN(1); const float* mem_prompt = IN(2); const float* norm_mix = IN(9); const float* w_in = IN(10);
        const float* C_re = IN(16); const float* C_im = IN(17);
        const float* A_re = IN(11); const float* A_im = IN(12); const float* log_dt = IN(13); const float* B_re = IN(14); const float* B_im = IN(15);
        const float* w_glu = IN(19); const float* w_out = IN(24); const float* norm_mem = IN(26); const float* w_q = IN(27); const float* w_k = IN(28); const float* w_v = IN(29); const float* w_xo = IN(30);
        const float* w_up = IN(32); const float* w_gate = IN(33); const float* w_down = IN(35);
        LAS float* scr = (LAS float*)(lds + wave * 16384);
        constexpr int I_IN = 16 * 64, I_D = 16 * 32, I_GLU = 8 * 16, I_UP = 16 * 88, I_DN = 44 * 32;
        constexpr int NITEMS = I_IN + 5 * I_D + I_GLU + 2 * I_UP + I_DN;
        for (int it = gw; it < NITEMS; it += NGW) {
            int r = it;
            if (r < I_IN) { transpose_item(w_in, D, NZ, WIN, 0, scr, r, lane); continue; } r -= I_IN;
            if (r < I_D) { transpose_item(w_k, D, D, WKV, 0, scr, r, lane); continue; } r -= I_D;
            if (r < I_D) { transpose_item(w_v, D, D, WKV, D, scr, r, lane); continue; } r -= I_D;
            if (r < I_D) { transpose_item(w_out, D, D, WOUT, 0, scr, r, lane); continue; } r -= I_D;
            if (r < I_D) { transpose_item(w_q, D, D, WQ, 0, scr, r, lane); continue; } r -= I_D;
            if (r < I_D) { transpose_item(w_xo, D, D, WXO, 0, scr, r, lane); continue; } r -= I_D;
            if (r < I_GLU) { transpose_item(w_glu, MIX, MIX, WGLU, 0, scr, r, lane); continue; } r -= I_GLU;
            if (r < I_UP) { transpose_item(w_up, D, DFF, WUG, 0, scr, r, lane, 1); continue; } r -= I_UP;
            if (r < I_UP) { transpose_item(w_gate, D, DFF, WUG, 0, scr, r, lane, 2); continue; } r -= I_UP;
            transpose_item(w_down, DFF, D, WDN, 0, scr, r, lane);
        }
        for (int m = gw; m < MT; m += NGW) rms_row_bf16(m < NP ? x_prompt + (size_t)m * D : x_sample + (size_t)(m - NP) * D, norm_mix, H + (size_t)m * D, lane);
        for (int m = gw; m < BP * NMEM; m += NGW) rms_row_bf16(mem_prompt + (size_t)m * D, norm_mem, MN + (size_t)m * D, lane);
        for (size_t i = (size_t)bx * NTHREADS + tid; i < (size_t)NS * D / 4; i += (size_t)G * NTHREADS) { ((f32x4*)(X + (size_t)NP * D))[i] = ((const f32x4*)x_sample)[i]; }
        for (int i = bx * NTHREADS + tid; i < 2 * NP; i += G * NTHREADS) SSQ[i] = 0.f;
        const int gt = bx * NTHREADS + tid;
        if (gt < SG * SN) {
            const int g = gt / SN;
            const float dt = expf(log_dt[g]), lr = A_re[gt], li = A_im[gt];
            const float mag = expf(dt * lr), ph = dt * li;
            double th = (double)ph * (1.0 / 1024.0), t2 = th * th;
            double c = 1.0 - t2 * (0.5 - t2 * (1.0 / 24.0 - t2 * (1.0 / 720.0)));
            double s = th * (1.0 - t2 * (1.0 / 6.0 - t2 * (1.0 / 120.0 - t2 * (1.0 / 5040.0))));
#pragma unroll 1
            for (int k = 0; k < 10; ++k) { const double c2 = c * c - s * s, s2 = 2.0 * c * s; c = c2; s = s2; }
            const float ar = mag * (float)c, ai = mag * (float)s;
            const float den = lr * lr + li * li;
            const float cr = ((ar - 1.0f) * lr + ai * li) / den, ci = (ai * lr - (ar - 1.0f) * li) / den;
#pragma unroll
            for (int p = 0; p < 16; ++p) { const float br = B_re[(size_t)gt * SP + p], bi = B_im[(size_t)gt * SP + p];
                const float bbr = cr * br - ci * bi, bbi = cr * bi + ci * br;
                BB[(size_t)gt * 32 + p] = bbr; BB[(size_t)gt * 32 + 16 + p] = bbi;
                BTR[(size_t)gt * 16 + p] = (bf16_t)(cvt_pk_bf16(bbr, 0.f) & 0xffff); BTI[(size_t)gt * 16 + p] = (bf16_t)(cvt_pk_bf16(bbi, 0.f) & 0xffff); }
            float pr = ar, pi = ai;
#pragma unroll 1
            for (int k = 0; k < 6; ++k) { const float r2 = pr * pr - pi * pi, i2 = 2.0f * pr * pi; pr = r2; pi = i2; }
            *(f32x4*)(AT + (size_t)gt * 4) = (f32x4){ar, ai, pr, pi};
        }
        if (gt < SG * SP * SN) {
            const float cre = C_re[gt], cim = C_im[gt];
            ((unsigned*)CT)[gt] = cvt_pk_bf16(cre, -cim);
        }
    }
    grid.sync();
    const XcdBarrier xb = xcd_barrier_post(barw, bst);

    if (PH(1)) {
        Sched2 S{G, bx, MT / 256, NZ / 256, 16, BP, 8, 16, 1, 0, (const char*)H, (const char*)WIN, (const char*)MN, (const char*)WKV, (size_t)256 * D * 2, (size_t)256 * D * 2};
        EpiP1 E{Z, out + O_MK, out + O_MV, KB, VT};
        pg8::gemm_phase(lds, D, D, S, E);
    }
    GSYNC();

    if (PH(2)) {
        const float* st_re = IN(5); const float* st_im = IN(6); const float* st_conv = IN(7); const float* C_re = IN(16); const float* C_im = IN(17); const float* Dssm = IN(18); const float* conv_w = IN(21); const float* norm_conv = IN(23);
        {
            SsmTab T; int gcur = -1;
            for (int task = gw; task < BP * SG * NCH; task += NGW) {
                const int c = task % NCH, g = (task / NCH) % SG, b = task / (NCH * SG);
                if (g != gcur) { ssm_load_tab(T, g, BTR, BTI, CT, AT, Dssm, lane, false); gcur = g; }
                float sr = 0.f, si = 0.f;
#ifdef OLD_PASS1
                ssm_tile<false>(Z + (size_t)(b * TP + c * LCH) * NZ + g * SP, LCH, sr, si, BB, AT, C_re, C_im, Dssm, g, nullptr, lane);
#else
                ssm_chunk<false>(lds + wave * 16384, Z + (size_t)(b * TP + c * LCH) * NZ + g * SP, sr, si, T, nullptr, lane);
#endif
                float* e = SE + ((size_t)(b * SG + g) * NCH + c) * 128; e[lane] = sr; e[64 + lane] = si;
            }
        }
        for (int task = gw; task < BS * SG; task += NGW) {
            const int b = task % BS, g = task / BS;
            float sr = st_re[(size_t)(b * SG + g) * SN + lane], si = st_im[(size_t)(b * SG + g) * SN + lane];
            ssm_tile<true>(Z + (size_t)(NP + b * TS) * NZ + g * SP, TS, sr, si, BB, AT, C_re, C_im, Dssm, g, YG + (size_t)(NP + b * TS) * MIX, lane);
            out[O_SRS + (size_t)(b * SG + g) * SN + lane] = sr; out[O_SIS + (size_t)(b * SG + g) * SN + lane] = si;
        }
        for (int r = gw; r < MT; r += NGW) {
            int b, t; const float* prev; float* cout; int T;
            if (r < NP) { b = r / TP; t = r % TP; prev = nullptr; cout = out + O_CP + (size_t)b * 2 * MIX; T = TP; }
            else { const int rs = r - NP; b = rs / TS; t = rs % TS; prev = st_conv + (size_t)b * 2 * MIX; cout = out + O_CS + (size_t)b * 2 * MIX; T = TS; }
            const int c0 = lane * 8;
            float p[3][8];
#pragma unroll
            for (int k = 0; k < 3; ++k) {
                const int tt = t - k;
                if (tt >= 0) { const bf16_t* zr = Z + (size_t)(r - k) * NZ; const u32x4 xi = *(const u32x4*)(zr + MIX + c0), cgv = *(const u32x4*)(zr + 3 * MIX + c0);
                    p[k][0] = bf_lo(xi.x) * bf_lo(cgv.x); p[k][1] = bf_hi(xi.x) * bf_hi(cgv.x); p[k][2] = bf_lo(xi.y) * bf_lo(cgv.y); p[k][3] = bf_hi(xi.y) * bf_hi(cgv.y);
                    p[k][4] = bf_lo(xi.z) * bf_lo(cgv.z); p[k][5] = bf_hi(xi.z) * bf_hi(cgv.z); p[k][6] = bf_lo(xi.w) * bf_lo(cgv.w); p[k][7] = bf_hi(xi.w) * bf_hi(cgv.w); }
                else if (prev) { const float* pp = prev + (size_t)(2 + tt) * MIX + c0; const f32x4 a = *(const f32x4*)pp, bq = *(const f32x4*)(pp + 4);
                    p[k][0] = a[0]; p[k][1] = a[1]; p[k][2] = a[2]; p[k][3] = a[3]; p[k][4] = bq[0]; p[k][5] = bq[1]; p[k][6] = bq[2]; p[k][7] = bq[3]; }
                else {
#pragma unroll
                    for (int j = 0; j < 8; ++j) p[k][j] = 0.f; }
            }
            const u32x4 bgv = *(const u32x4*)(Z + (size_t)r * NZ + 2 * MIX + c0);
            float bg[8] = {bf_lo(bgv.x), bf_hi(bgv.x), bf_lo(bgv.y), bf_hi(bgv.y), bf_lo(bgv.z), bf_hi(bgv.z), bf_lo(bgv.w), bf_hi(bgv.w)};
            float y[8]; float ss = 0.f;
#pragma unroll
            for (int j = 0; j < 8; ++j) { const float w0 = conv_w[c0 + j], w1 = conv_w[MIX + c0 + j], w2 = conv_w[2 * MIX + c0 + j];
                y[j] = bg[j] * (w0 * p[2][j] + w1 * p[1][j] + w2 * p[0][j]); ss += y[j] * y[j]; }
            const float rstd = 1.0f / sqrtf(wave_sum(ss) * (1.0f / MIX) + EPS);
            const f32x4 g0 = *(const f32x4*)(norm_conv + c0), g1 = *(const f32x4*)(norm_conv + c0 + 4);
            u32x4 w; w.x = cvt_pk_bf16(y[0] * rstd * g0[0], y[1] * rstd * g0[1]); w.y = cvt_pk_bf16(y[2] * rstd * g0[2], y[3] * rstd * g0[3]);
            w.z = cvt_pk_bf16(y[4] * rstd * g1[0], y[5] * rstd * g1[1]); w.w = cvt_pk_bf16(y[6] * rstd * g1[2], y[7] * rstd * g1[3]);
            *(u32x4*)(MIXN + (size_t)r * D + MIX + c0) = w;
            if (t >= T - 2) { float* co = cout + (size_t)(t - (T - 2)) * MIX + c0; *(f32x4*)co = (f32x4){p[0][0], p[0][1], p[0][2], p[0][3]}; *(f32x4*)(co + 4) = (f32x4){p[0][4], p[0][5], p[0][6], p[0][7]}; }
        }
    }
    GSYNC();

    if (PH(3)) {
        for (int task = gw; task < BP * SG; task += NGW) {
            const int g = task % SG, b = task / SG;
            const f32x4 at = *(const f32x4*)(AT + (size_t)(g * SN + lane) * 4); const float aLr = at[2], aLi = at[3];
            float sr = 0.f, si = 0.f;
            for (int c = 0; c < NCH; ++c) {
                float* sip = SI + ((size_t)(b * SG + g) * NCH + c) * 128; sip[lane] = sr; sip[64 + lane] = si;
                const float* e = SE + ((size_t)(b * SG + g) * NCH + c) * 128; const float er = e[lane], ei = e[64 + lane];
                const float nr = aLr * sr - aLi * si + er, ni = aLr * si + aLi * sr + ei; sr = nr; si = ni;
            }
            out[O_SRP + (size_t)(b * SG + g) * SN + lane] = sr; out[O_SIP + (size_t)(b * SG + g) * SN + lane] = si;
        }
    }
    GSYNC();

    if (PH(4)) {
        const float* C_re = IN(16); const float* C_im = IN(17); const float* Dssm = IN(18);
        SsmTab T; int gcur = -1;
        for (int task = gw; task < BP * SG * NCH; task += NGW) {
            const int c = task % NCH, g = (task / NCH) % SG, b = task / (NCH * SG);
            if (g != gcur) { ssm_load_tab(T, g, BTR, BTI, CT, AT, Dssm, lane, true); gcur = g; }
            const float* sip = SI + ((size_t)(b * SG + g) * NCH + c) * 128; float sr = sip[lane], si = sip[64 + lane];
#ifdef OLD_PASS2
            ssm_tile<true>(Z + (size_t)(b * TP + c * LCH) * NZ + g * SP, LCH, sr, si, BB, AT, C_re, C_im, Dssm, g, YG + (size_t)(b * TP + c * LCH) * MIX, lane);
#else
            ssm_chunk<true>(lds + wave * 16384, Z + (size_t)(b * TP + c * LCH) * NZ + g * SP, sr, si, T, YG + (size_t)(b * TP + c * LCH) * MIX + g * SP, lane);
#endif
        }
    }
    GSYNC();

    if (PH(5)) {
        const float* b_glu = IN(20);
        Sched2 S{G, bx, MT / 256, MIX / 256, 8, 0, 0, 4, 1, 0, (const char*)YG, (const char*)WGLU, nullptr, nullptr, (size_t)256 * MIX * 2, (size_t)256 * MIX * 2};
        EpiGlu E{YG, b_glu, YS};
        pg8::gemm_phase(lds, MIX, MIX, S, E);
    }
    GSYNC();

    if (PH(6)) {
        const float* norm_ssm = IN(22);
        for (int r = gw; r < MT; r += NGW) {
            const f32x4* yr = (const f32x4*)(YS + (size_t)r * MIX) + lane; const f32x4 a = yr[0], b = yr[64];
            const float ss = (a[0] * a[0] + a[1] * a[1]) + (a[2] * a[2] + a[3] * a[3]) + (b[0] * b[0] + b[1] * b[1]) + (b[2] * b[2] + b[3] * b[3]);
            const float rstd = 1.0f / sqrtf(wave_sum(ss) * (1.0f / MIX) + EPS);
            const f32x4 ga = ((const f32x4*)norm_ssm)[lane], gb = ((const f32x4*)norm_ssm)[lane + 64];
            u32x2 w0, w1; w0.x = cvt_pk_bf16(a[0] * rstd * ga[0], a[1] * rstd * ga[1]); w0.y = cvt_pk_bf16(a[2] * rstd * ga[2], a[3] * rstd * ga[3]);
            w1.x = cvt_pk_bf16(b[0] * rstd * gb[0], b[1] * rstd * gb[1]); w1.y = cvt_pk_bf16(b[2] * rstd * gb[2], b[3] * rstd * gb[3]);
            u32x2* o8 = (u32x2*)(MIXN + (size_t)r * D) + lane; o8[0] = w0; o8[64] = w1;
        }
    }
    GSYNC();

    if (PH(7)) {
        const float* x_prompt = IN(0);
        Sched2 S{G, bx, NP / 256, D / 256, 16, NS / 256, D / 256, 4, 4, NP / 256, (const char*)MIXN, (const char*)WOUT, (const char*)MIXN, (const char*)WOUT, (size_t)256 * D * 2, (size_t)256 * D * 2};
        EpiRes E{x_prompt, X, PART, 1, H, IN(25), SSQ};
        pg8::gemm_phase(lds, D, D, S, E);
    }
    GSYNC();

    if (PH(8)) for (int m = NP + gw; m < MT; m += NGW) { add_parts(X + (size_t)m * D, PART + (size_t)(m - NP) * D, 4, (size_t)NS * D, lane); rms_row_bf16(X + (size_t)m * D, IN(25), H + (size_t)m * D, lane); }
    GSYNC();

    if (PH(9)) {
        Sched2 S{G, bx, NP / 256, D / 256, 16, NS / 256, D / 256, 4, 4, NP / 256, (const char*)H, (const char*)WQ, (const char*)H, (const char*)WQ, (size_t)256 * D * 2, (size_t)256 * D * 2};
        EpiQ E{Q, PART, SSQ};
        pg8::gemm_phase(lds, D, D, S, E);
    }
    GSYNC();

    if (PH(10)) {
        const float* cache_k = IN(3); const float* cache_v = IN(4);
        struct SchedQK { int G, c; const char* Q; const char* KB;
            __device__ __forceinline__ bool next(int i, Unit& u) const { const int L = i * G + c; if (L >= 64 * NH) return false; pg8::order_map(L, 64, NH, u.pm, u.pn); u.kind = 0; u.nt = 4; u.ks = 0;
                u.A = Q + ((size_t)u.pm * 256 * D + (size_t)u.pn * HD) * 2; u.B = KB + ((size_t)(u.pm >> 3) * NMEM * D + (size_t)u.pn * HD) * 2; return true; } };
        SchedQK S{G, bx, (const char*)Q, (const char*)KB};
        EpiSoftmax E{PR, lds};
#ifndef NO_QK
        pg8::gemm_phase(lds, D, D, S, E);
#endif

#ifndef NO_SATT
        LAS float* sc = (LAS float*)lds;
        LAS float* pr = (LAS float*)(lds + 4096);
        LAS float* po = (LAS float*)(lds + 8192);
        for (int unit = bx; unit < BS * NH; unit += G) {
            const int b = unit / NH, h = unit % NH;
            float q[4][4];
#pragma unroll
            for (int qi = 0; qi < 4; ++qi) { const float* qp = PART + (size_t)(b * TS + qi) * D + h * HD + 4 * lane; const f32x4 w = (*(const f32x4*)qp + *(const f32x4*)(qp + (size_t)NS * D)) + (*(const f32x4*)(qp + (size_t)2 * NS * D) + *(const f32x4*)(qp + (size_t)3 * NS * D)); q[qi][0] = w[0]; q[qi][1] = w[1]; q[qi][2] = w[2]; q[qi][3] = w[3]; }
            const float* kbase = cache_k + ((size_t)(b * NMEM) * NH + h) * HD + 4 * lane;
            const float* vbase = cache_v + ((size_t)(b * NMEM) * NH + h) * HD + 4 * lane;
#pragma unroll 1
            for (int blk = 0; blk < 2; ++blk) {
                const int key0 = wave * 32 + blk * 16;
                float v[64];
#pragma unroll
                for (int k = 0; k < 16; ++k) { const f32x4 kv = *(const f32x4*)(kbase + (size_t)(key0 + k) * NH * HD);
#pragma unroll
                    for (int qi = 0; qi < 4; ++qi) v[k * 4 + qi] = (kv[0] * q[qi][0] + kv[1] * q[qi][1]) + (kv[2] * q[qi][2] + kv[3] * q[qi][3]); }
                const float s = treduce64(v, lane);
                sc[(lane & 3) * 256 + key0 + (lane >> 2)] = s;
            }
            __syncthreads();
            {
                const int qi = lane & 3, kb = lane >> 2; float sv[16]; float mx = -3.0e38f;
#pragma unroll
                for (int j = 0; j < 16; ++j) { sv[j] = sc[qi * 256 + kb + 16 * j]; mx = fmaxf(mx, sv[j]); }
                mx = fmaxf(mx, __shfl_xor(mx, 4)); mx = fmaxf(mx, __shfl_xor(mx, 8)); mx = fmaxf(mx, __shfl_xor(mx, 16)); mx = fmaxf(mx, __shfl_xor(mx, 32));
                float sum = 0.f;
#pragma unroll
                for (int j = 0; j < 16; ++j) { sv[j] = fast_exp(sv[j] - mx); sum += sv[j]; }
                sum += __shfl_xor(sum, 4); sum += __shfl_xor(sum, 8); sum += __shfl_xor(sum, 16); sum += __shfl_xor(sum, 32);
                const float inv = 1.0f / sum;
                if (wave == 0) {
#pragma unroll
                    for (int j = 0; j < 16; ++j) pr[qi * 256 + kb + 16 * j] = sv[j] * inv; }
            }
            __syncthreads();
            {
                float o[4][4];
#pragma unroll
                for (int qi = 0; qi < 4; ++qi) { o[qi][0] = 0.f; o[qi][1] = 0.f; o[qi][2] = 0.f; o[qi][3] = 0.f; }
#pragma unroll 8
                for (int k = 0; k < 32; ++k) { const int key = wave * 32 + k; const f32x4 vv = *(const f32x4*)(vbase + (size_t)key * NH * HD);
#pragma unroll
                    for (int qi = 0; qi < 4; ++qi) { const float pp = pr[qi * 256 + key]; o[qi][0] = fmaf(pp, vv[0], o[qi][0]); o[qi][1] = fmaf(pp, vv[1], o[qi][1]); o[qi][2] = fmaf(pp, vv[2], o[qi][2]); o[qi][3] = fmaf(pp, vv[3], o[qi][3]); } }
#pragma unroll
                for (int qi = 0; qi < 4; ++qi) *(LAS f32x4*)(po + (wave * 4 + qi) * 256 + 4 * lane) = (f32x4){o[qi][0], o[qi][1], o[qi][2], o[qi][3]};
            }
            __syncthreads();
            {
                const int idx = tid * 2, qi = idx >> 8, d = idx & 255; float a0 = 0.f, a1 = 0.f;
#pragma unroll
                for (int w = 0; w < 8; ++w) { const f32x2 t2 = *(LAS f32x2*)(po + (w * 4 + qi) * 256 + d); a0 += t2[0]; a1 += t2[1]; }
                *(unsigned*)(O + (size_t)(NP + b * TS + qi) * D + h * HD + d) = cvt_pk_bf16(a0, a1);
            }
        }
#endif
    }
    GSYNC();

    if (PH(11)) {
        struct SchedPV { int G, c; const char* PR; const char* VT;
            __device__ __forceinline__ bool next(int i, Unit& u) const { const int L = i * G + c; if (L >= 64 * NH) return false; pg8::order_map(L, 64, NH, u.pm, u.pn); u.kind = 0; u.nt = 4; u.ks = 0;
                u.A = PR + (size_t)(u.pm * NH + u.pn) * 256 * 256 * 2; u.B = VT + (size_t)((u.pm >> 3) * NH + u.pn) * HD * NMEM * 2; return true; } };
        SchedPV S{G, bx, (const char*)PR, (const char*)VT};
        EpiBf E{O, D, 1.0f, nullptr};
        pg8::gemm_phase(lds, NMEM, NMEM, S, E);
    }
    GSYNC();

    if (PH(12)) {
        Sched2 S{G, bx, NP / 256, D / 256, 16, NS / 256, D / 256, 4, 4, NP / 256, (const char*)O, (const char*)WXO, (const char*)O, (const char*)WXO, (size_t)256 * D * 2, (size_t)256 * D * 2};
        EpiRes E{nullptr, X, PART, 0, H, IN(31), SSQ + NP};
        pg8::gemm_phase(lds, D, D, S, E);
    }
    GSYNC();

    if (PH(13)) for (int m = NP + gw; m < MT; m += NGW) { add_parts(X + (size_t)m * D, PART + (size_t)(m - NP) * D, 4, (size_t)NS * D, lane); rms_row_bf16(X + (size_t)m * D, IN(31), H + (size_t)m * D, lane); }
    GSYNC();

    if (PH(14)) {
        Sched2 S{G, bx, MT / 256, NUG / 256, 16, 0, 0, 4, 1, 0, (const char*)H, (const char*)WUG, nullptr, nullptr, (size_t)256 * D * 2, (size_t)256 * D * 2};
        EpiFfn E{ACT, H, WUG, IN(34), IN(8), out + O_FP, out + O_FS, SSQ + NP, lds};
        pg8::gemm_phase(lds, D, D, S, E);
    }
    GSYNC();

    if (PH(16)) {
        Sched2 S{G, bx, NP / 256, D / 256, DFF / 64, NS / 256, D / 256, 4, DFF / 256, NP / 256, (const char*)ACT, (const char*)WDN, (const char*)ACT, (const char*)WDN, (size_t)256 * DFF * 2, (size_t)256 * DFF * 2};
        EpiRes E{nullptr, X, PART, 0, nullptr, nullptr, nullptr};
        pg8::gemm_phase(lds, DFF, DFF, S, E);
    }
    GSYNC();

    if (PH(17)) for (int m = gw; m < MT; m += NGW) { if (m >= NP) add_parts(X + (size_t)m * D, PART + (size_t)(m - NP) * D, DFF / 256, (size_t)NS * D, lane); rms_row_f32(X + (size_t)m * D, IN(36), out + (size_t)m * D, lane); }
}

extern "C" void kernel_launch(void* const* d_in, const int* in_sizes, int n_in, void* d_out, int out_size, void* d_ws, size_t ws_size, hipStream_t stream) {
    static int grid = 0;
    if (grid == 0) {
        if (n_in != 37 || (size_t)out_size != O_END || ws_size < WS_END) { fprintf(stderr, "kernel_launch: unexpected sizes n_in %d out %d ws %zu\n", n_in, out_size, ws_size); grid = -1; return; }
        int dev = 0, cus = 0, per_cu = 0;
        (void)hipGetDevice(&dev); (void)hipDeviceGetAttribute(&cus, hipDeviceAttributeMultiprocessorCount, dev);
        (void)hipFuncSetAttribute((const void*)hymba_fwd, hipFuncAttributeMaxDynamicSharedMemorySize, LDS_BYTES);
        (void)hipOccupancyMaxActiveBlocksPerMultiprocessor(&per_cu, (const void*)hymba_fwd, NTHREADS, LDS_BYTES);
        if (per_cu < 1) { fprintf(stderr, "kernel_launch: occupancy query reports %d blocks per CU\n", per_cu); per_cu = 1; }
        (void)hipGetLastError();
        grid = cus;
        if (grid % 8) grid -= grid % 8;
    }
    if (grid < 0) return;
    Args a{};
    for (int i = 0; i < 37; ++i) a.in[i] = (const float*)d_in[i];
    a.out = (float*)d_out; a.ws = (unsigned char*)d_ws;
    void* kargs[] = {&a};
    hipError_t e = hipLaunchCooperativeKernel((const void*)hymba_fwd, dim3(grid), dim3(NTHREADS), kargs, LDS_BYTES, stream);
    if (e != hipSuccess) fprintf(stderr, "cooperative launch failed: %s (grid %d)\n", hipGetErrorString(e), grid);
}
```

```cpp
#include <hip/hip_runtime.h>
#include <hip/hip_cooperative_groups.h>
#include <cstdio>
#include <cstdint>
namespace cg = cooperative_groups;

#define LAS __attribute__((address_space(3)))
typedef unsigned short bf16_t;
typedef short bf16x8 __attribute__((ext_vector_type(8)));
typedef float f32x4 __attribute__((ext_vector_type(4)));
typedef float f32x2 __attribute__((ext_vector_type(2)));
typedef unsigned u32x4 __attribute__((ext_vector_type(4)));
typedef unsigned u32x2 __attribute__((ext_vector_type(2)));

constexpr int D = 1024, NP = 16384, NS = 512, MT = NP + NS;
constexpr int TP = 2048, TS = 4, BP = 8, BS = 128;
constexpr int NZ = 2048, MIX = 512, DFF = 2816, NUG = 2 * DFF;
constexpr int SG = 32, SP = 16, SN = 64, LCH = 64, NCH = TP / LCH;
constexpr int NMEM = 256, NH = 4, HD = 256;
constexpr float EPS = 1e-6f;
constexpr int NWAVES = 8, NTHREADS = 512;

constexpr size_t MiB = 1u << 20;
constexpr size_t WS_WIN = 0;
constexpr size_t WS_WKV = WS_WIN + 4 * MiB;
constexpr size_t WS_WGLU = WS_WKV + 4 * MiB;
constexpr size_t WS_WOUT = WS_WGLU + 1 * MiB;
constexpr size_t WS_WQ = WS_WOUT + 2 * MiB;
constexpr size_t WS_WXO = WS_WQ + 2 * MiB;
constexpr size_t WS_WUG = WS_WXO + 2 * MiB;
constexpr size_t WS_WDN = WS_WUG + 11 * MiB;
constexpr size_t WS_H = WS_WDN + 6 * MiB;
constexpr size_t WS_X = WS_H + 33 * MiB;
constexpr size_t WS_OV = WS_X + 66 * MiB;
constexpr size_t WS_Z = WS_OV;
constexpr size_t WS_YG = WS_Z + 66 * MiB;
constexpr size_t WS_YS = WS_YG + 17 * MiB;
constexpr size_t WS_MIXN = WS_YS + 33 * MiB;
constexpr size_t WS_Q = WS_MIXN + 33 * MiB;
constexpr size_t WS_PR = WS_Q + 33 * MiB;
constexpr size_t WS_O = WS_PR + 32 * MiB;
constexpr size_t WS_MN = WS_O + 33 * MiB;
constexpr size_t WS_KB = WS_MN + 4 * MiB;
constexpr size_t WS_VT = WS_KB + 4 * MiB;
constexpr size_t WS_SE = WS_VT + 4 * MiB;
constexpr size_t WS_SI = WS_SE + 4 * MiB;
constexpr size_t WS_BB = WS_SI + 4 * MiB;
constexpr size_t WS_AT = WS_BB + 1 * MiB;
constexpr size_t WS_BTR = WS_AT + 1 * MiB;
constexpr size_t WS_BTI = WS_BTR + 65536;
constexpr size_t WS_CT = WS_BTI + 65536;
constexpr size_t WS_OV_END1 = WS_CT + 131072;
constexpr size_t WS_UG = WS_OV;
constexpr size_t WS_ACT = WS_UG + 182 * MiB;
constexpr size_t WS_CTL = WS_ACT + 91 * MiB;
constexpr size_t WS_PART = WS_CTL + 1 * MiB;
constexpr size_t WS_SSQ = WS_PART + 22 * MiB;
constexpr size_t WS_END = WS_SSQ + 1 * MiB;
static_assert(WS_OV_END1 <= WS_CTL, "overlay");
static_assert(WS_END <= 512 * MiB, "workspace");

constexpr size_t O_YP = 0;
constexpr size_t O_YS = O_YP + (size_t)NP * D;
constexpr size_t O_MK = O_YS + (size_t)NS * D;
constexpr size_t O_MV = O_MK + (size_t)BP * NMEM * D;
constexpr size_t O_SRP = O_MV + (size_t)BP * NMEM * D;
constexpr size_t O_SIP = O_SRP + (size_t)BP * SG * SN;
constexpr size_t O_CP = O_SIP + (size_t)BP * SG * SN;
constexpr size_t O_FP = O_CP + (size_t)BP * 2 * MIX;
constexpr size_t O_SRS = O_FP + (size_t)BP * 2 * DFF;
constexpr size_t O_SIS = O_SRS + (size_t)BS * SG * SN;
constexpr size_t O_CS = O_SIS + (size_t)BS * SG * SN;
constexpr size_t O_FS = O_CS + (size_t)BS * 2 * MIX;
constexpr size_t O_END = O_FS + (size_t)BS * 2 * DFF;

constexpr int RING_BYTES = 131072, XCH_OFF = RING_BYTES, LDS_BYTES = 147456;

typedef __bf16 bf16x2_t __attribute__((ext_vector_type(2)));
__device__ __forceinline__ unsigned cvt_pk_bf16(float lo, float hi) { const f32x2 v = {lo, hi}; const bf16x2_t b = __builtin_convertvector(v, bf16x2_t); return __builtin_bit_cast(unsigned, b); }
__device__ __forceinline__ float bf_lo(unsigned w) { return __uint_as_float(w << 16); }
__device__ __forceinline__ float bf_hi(unsigned w) { return __uint_as_float(w & 0xffff0000u); }
__device__ __forceinline__ float wave_sum(float v) {
#pragma unroll
    for (int o = 1; o < 64; o <<= 1) v += __shfl_xor(v, o);
    return v;
}
__device__ __forceinline__ float fast_exp(float x) { return __builtin_amdgcn_exp2f(x * 1.4426950408889634f); }
__device__ __forceinline__ float gelu_tanh(float x) {
    const float z = 0.7978845608028654f * (x + 0.044715f * x * x * x);
    return x * __builtin_amdgcn_rcpf(1.0f + fast_exp(-2.0f * z));
}
__device__ __forceinline__ float sigmoidf(float a) { return __builtin_amdgcn_rcpf(1.0f + fast_exp(-a)); }

namespace pg8 {
constexpr int BM = 256, BK = 64, HALF = 128, HTB = HALF * BK * 2;
__host__ __device__ __forceinline__ int lds_byte(int r, int c) { const int st = (r >> 4) * 2 + (c >> 5), rr = r & 15, cc = c & 31, ob = rr * 64 + cc * 2; return st * 1024 + (ob ^ (((ob >> 9) & 1) << 5)); }
__host__ __device__ __forceinline__ void stage_rc(int b, int& R, int& C) { const int st = b / 1024, sb = b % 1024, swz = sb ^ (((sb >> 9) & 1) << 5); R = (st >> 1) * 16 + swz / 64; C = (st & 1) * 32 + (swz % 64) / 2; }
__host__ __device__ __forceinline__ int perm32(int rho) { const int n = rho >> 4, i = rho & 15; return 8 * (i >> 2) + 4 * n + (i & 3); }

struct Unit { int pm, pn, kind, nt, ks; const char* A; const char* B; };

__device__ __forceinline__ void order_map(int L, int nM, int nN, int& pm, int& pn) {
    const int nwg = nM * nN; int wgid = L;
    { const int q = nwg / 8, r = nwg % 8, xcd = wgid % 8, off = wgid / 8; wgid = (xcd < r ? xcd * (q + 1) : r * (q + 1) + (xcd - r) * q) + off; }
    const int nig = 8 * nN, gid = wgid / nig, fm = gid * 8, gsz = (nM - fm) < 8 ? (nM - fm) : 8;
    pm = fm + ((wgid % nig) % gsz); pn = (wgid % nig) / gsz;
}

template <class Epi, class Sched>
__device__ __forceinline__ void gemm_phase(LAS unsigned char* lds, const int lda, const int ldb, const Sched& S, Epi& E) {
    int tid_l = threadIdx.x; asm volatile("" : "+v"(tid_l));
    const int tid = tid_l, wid = __builtin_amdgcn_readfirstlane(tid >> 6), lane = tid & 63, wr = wid >> 2, wc = wid & 3, fr = lane & 15, fq = lane >> 4;
    unsigned voffA[2], voffB[2];
#pragma unroll
    for (int i = 0; i < 2; ++i) { int R, C; stage_rc(tid * 16 + i * 8192, R, C); const int Rb = (R & ~31) + perm32(R & 31);
        voffA[i] = (unsigned)(R * lda + C) * 2u; voffB[i] = (unsigned)(Rb * ldb + C) * 2u; }
    const size_t kstep = (size_t)(BK * 2);
    const size_t hstepA = (size_t)HALF * lda * 2, hstepB = (size_t)HALF * ldb * 2;
    const unsigned ldsw = (unsigned)wid * 1024u;
    const int aoff = lds_byte(wr * 64 + fr, fq * 8), boff = lds_byte(wc * 32 + fr, fq * 8);
#define PG8_SA(b, h) (((b) * 2 + (h)) * HTB)
#define PG8_SB(b, h) ((4 + (b) * 2 + (h)) * HTB)
#define PG8_STAGE(bufoff, gbase, voff) do { _Pragma("unroll") for (int _i = 0; _i < 2; ++_i) \
        __builtin_amdgcn_global_load_lds((const unsigned*)((const char*)(gbase) + (voff)[_i]), (LAS unsigned*)(lds + (bufoff) + ldsw + _i * 8192), 16, 0, 0); } while (0)
#define PG8_LDA(dst, b, h) do { _Pragma("unroll") for (int m = 0; m < 4; ++m) _Pragma("unroll") for (int k = 0; k < 2; ++k) dst[m][k] = *(const LAS bf16x8*)(lds + PG8_SA(b, h) + aoff + m * 2048 + k * 1024); } while (0)
#define PG8_LDB(dst, b, h) do { _Pragma("unroll") for (int n = 0; n < 2; ++n) _Pragma("unroll") for (int k = 0; k < 2; ++k) dst[n][k] = *(const LAS bf16x8*)(lds + PG8_SB(b, h) + boff + n * 2048 + k * 1024); } while (0)
#define PG8_MMA(ai, bj, At, Bt) do { __builtin_amdgcn_s_setprio(1); _Pragma("unroll") for (int m = 0; m < 4; ++m) _Pragma("unroll") for (int n = 0; n < 2; ++n) _Pragma("unroll") for (int k = 0; k < 2; ++k) \
        acc[ai][bj][m][n] = __builtin_amdgcn_mfma_f32_16x16x32_bf16(Bt[n][k], At[m][k], acc[ai][bj][m][n], 0, 0, 0); __builtin_amdgcn_s_setprio(0); } while (0)
#define PG8_WAIT_V(n) asm volatile("s_waitcnt vmcnt(" #n ")" ::: "memory")
#define PG8_WAIT_L(n) asm volatile("s_waitcnt lgkmcnt(" #n ")" ::: "memory")
#define PG8_BAR __builtin_amdgcn_s_barrier()
#define PG8_SCHED __builtin_amdgcn_sched_barrier(0)
    Unit cur, nxt; int ui = 0;
    if (!S.next(0, cur)) return;
    f32x4 acc[2][2][4][2];
#pragma unroll
    for (int a = 0; a < 2; ++a)
#pragma unroll
        for (int b = 0; b < 2; ++b)
#pragma unroll
            for (int m = 0; m < 4; ++m)
#pragma unroll
                for (int n = 0; n < 2; ++n) acc[a][b][m][n] = (f32x4){0.f, 0.f, 0.f, 0.f};
    bf16x8 At[4][2], B0[2][2], B1[2][2];
    const char* cA = cur.A; const char* cB = cur.B;
    PG8_STAGE(PG8_SB(0, 0), cB, voffB); PG8_STAGE(PG8_SB(0, 1), cB + hstepB, voffB); PG8_STAGE(PG8_SA(0, 0), cA, voffA); PG8_STAGE(PG8_SA(0, 1), cA + hstepA, voffA);
    if (wr == 1) PG8_BAR;
    PG8_WAIT_V(2); PG8_BAR;
    PG8_STAGE(PG8_SB(1, 0), cB + kstep, voffB); PG8_STAGE(PG8_SA(1, 0), cA + kstep, voffA); PG8_STAGE(PG8_SB(1, 1), cB + hstepB + kstep, voffB);
    PG8_WAIT_V(6); PG8_BAR;
    for (;;) {
        const bool has_next = S.next(ui + 1, nxt);
        const char* nA = has_next ? nxt.A : cA; const char* nB = has_next ? nxt.B : cB;
        const int nt = cur.nt;
#pragma unroll 1
        for (int t = 0; t < nt; t += 2) {
            const bool last = (t == nt - 2);
            const char* a1 = cA + (size_t)(t + 1) * kstep;
            const char* a2 = last ? nA : cA + (size_t)(t + 2) * kstep; const char* b2 = last ? nB : cB + (size_t)(t + 2) * kstep;
            const char* a3 = a2 + kstep; const char* b3 = b2 + kstep;
            PG8_LDB(B0, 0, 0); PG8_LDB(B1, 0, 1); PG8_SCHED; PG8_LDA(At, 0, 0); PG8_STAGE(PG8_SA(1, 1), a1 + hstepA, voffA);
            PG8_WAIT_V(8); PG8_WAIT_L(0); PG8_BAR; PG8_MMA(0, 0, At, B0); PG8_MMA(0, 1, At, B1); PG8_BAR; PG8_SCHED;
            PG8_LDA(At, 0, 1); PG8_STAGE(PG8_SB(0, 0), b2, voffB); PG8_STAGE(PG8_SB(0, 1), b2 + hstepB, voffB); PG8_STAGE(PG8_SA(0, 0), a2, voffA);
            PG8_WAIT_V(8); PG8_WAIT_L(0); PG8_BAR; PG8_MMA(1, 0, At, B0); PG8_MMA(1, 1, At, B1); PG8_BAR; PG8_SCHED;
            PG8_LDB(B0, 1, 0); PG8_LDB(B1, 1, 1); PG8_SCHED; PG8_LDA(At, 1, 0); PG8_STAGE(PG8_SA(0, 1), a2 + hstepA, voffA);
            PG8_WAIT_V(8); PG8_WAIT_L(0); PG8_BAR; PG8_MMA(0, 0, At, B0); PG8_MMA(0, 1, At, B1); PG8_BAR; PG8_SCHED;
            PG8_LDA(At, 1, 1); PG8_STAGE(PG8_SB(1, 0), b3, voffB); PG8_STAGE(PG8_SB(1, 1), b3 + hstepB, voffB); PG8_STAGE(PG8_SA(1, 0), a3, voffA);
            PG8_WAIT_V(8); PG8_WAIT_L(0); PG8_BAR; PG8_MMA(1, 0, At, B0); PG8_MMA(1, 1, At, B1); PG8_BAR; PG8_SCHED;
        }
        if (wr == 0) PG8_BAR;
        E(acc, cur, wr, wc, fr, fq);
        if (!has_next) break;
#pragma unroll
        for (int a = 0; a < 2; ++a)
#pragma unroll
            for (int b = 0; b < 2; ++b)
#pragma unroll
                for (int m = 0; m < 4; ++m)
#pragma unroll
                    for (int n = 0; n < 2; ++n) acc[a][b][m][n] = (f32x4){0.f, 0.f, 0.f, 0.f};
        cur = nxt; cA = nA; cB = nB; ++ui;
        if (wr == 1) PG8_BAR;
    }
    PG8_WAIT_V(0);
    PG8_BAR;
#undef PG8_SA
#undef PG8_SB
#undef PG8_STAGE
#undef PG8_LDA
#undef PG8_LDB
#undef PG8_MMA
#undef PG8_WAIT_V
#undef PG8_WAIT_L
#undef PG8_BAR
#undef PG8_SCHED
}
}
using pg8::Unit;
typedef f32x4 Acc[2][2][4][2];

struct Sched2 {
    int G, c; int nM0, nN0, nt0, nM1, nN1, nt1, ks1, pm1;
    const char* A0; const char* B0; const char* A1; const char* B1; size_t a_pm, b_pn;
    __device__ __forceinline__ bool next(int i, Unit& u) const {
        const int L = i * G + c, n0 = nM0 * nN0, n1 = nM1 * nN1 * ks1;
        if (L >= n0 + n1) return false;
        if (L < n0) { pg8::order_map(L, nM0, nN0, u.pm, u.pn); u.kind = 0; u.nt = nt0; u.ks = 0; u.A = A0 + (size_t)u.pm * a_pm; u.B = B0 + (size_t)u.pn * b_pn; }
        else { const int j = L - n0, ks = j % ks1, t = j / ks1; u.pm = pm1 + t % nM1; u.pn = t / nM1; u.kind = 1; u.nt = nt1; u.ks = ks;
               u.A = A1 + (size_t)u.pm * a_pm + (size_t)ks * nt1 * 128; u.B = B1 + (size_t)u.pn * b_pn + (size_t)ks * nt1 * 128; }
        return true;
    }
};

#define EPI_ROWS(...) _Pragma("unroll") for (int ai = 0; ai < 2; ++ai) _Pragma("unroll") for (int m = 0; m < 4; ++m) { const int row = u.pm * 256 + ai * 128 + wr * 64 + m * 16 + fr; \
    _Pragma("unroll") for (int bj = 0; bj < 2; ++bj) { const int col = u.pn * 256 + bj * 128 + wc * 32 + fq * 8; const f32x4 v0 = acc[ai][bj][m][0], v1 = acc[ai][bj][m][1]; __VA_ARGS__ } }

__device__ __forceinline__ u32x4 pack8(f32x4 v0, f32x4 v1) { u32x4 w; w.x = cvt_pk_bf16(v0[0], v0[1]); w.y = cvt_pk_bf16(v0[2], v0[3]); w.z = cvt_pk_bf16(v1[0], v1[1]); w.w = cvt_pk_bf16(v1[2], v1[3]); return w; }

struct EpiP1 {
    bf16_t* Z; float* outK; float* outV; bf16_t* KB; bf16_t* VT;
    __device__ __forceinline__ void operator()(Acc& acc, const Unit& u, int wr, int wc, int fr, int fq) const {
        if (u.kind == 0) {
            EPI_ROWS( *(u32x4*)(Z + (size_t)row * NZ + col) = pack8(v0, v1); )
        } else if (u.pn < 4) {
            EPI_ROWS( float* o = outK + (size_t)row * D + col; *(f32x4*)o = v0; *(f32x4*)(o + 4) = v1; *(u32x4*)(KB + (size_t)row * D + col) = pack8(v0, v1); )
        } else {
            EPI_ROWS( const int vc = col - 1024; float* o = outV + (size_t)row * D + vc; *(f32x4*)o = v0; *(f32x4*)(o + 4) = v1;
                      const int h = vc >> 8, d0 = vc & 255, key = row & 255; bf16_t* vt = VT + ((size_t)(u.pm * NH + h) * HD + d0) * NMEM + key;
                      const u32x4 w = pack8(v0, v1);
                      vt[0 * NMEM] = (bf16_t)(w.x & 0xffff); vt[1 * NMEM] = (bf16_t)(w.x >> 16); vt[2 * NMEM] = (bf16_t)(w.y & 0xffff); vt[3 * NMEM] = (bf16_t)(w.y >> 16);
                      vt[4 * NMEM] = (bf16_t)(w.z & 0xffff); vt[5 * NMEM] = (bf16_t)(w.z >> 16); vt[6 * NMEM] = (bf16_t)(w.w & 0xffff); vt[7 * NMEM] = (bf16_t)(w.w >> 16); )
        }
    }
};
struct EpiGlu {
    const bf16_t* YG; const float* bias; float* YS;
    __device__ __forceinline__ void operator()(Acc& acc, const Unit& u, int wr, int wc, int fr, int fq) const {
        EPI_ROWS( const u32x4 yw = *(const u32x4*)(YG + (size_t)row * MIX + col); const f32x4 b0 = *(const f32x4*)(bias + col), b1 = *(const f32x4*)(bias + col + 4);
                  f32x4 o0, o1;
                  o0[0] = bf_lo(yw.x) * sigmoidf(v0[0] + b0[0]); o0[1] = bf_hi(yw.x) * sigmoidf(v0[1] + b0[1]); o0[2] = bf_lo(yw.y) * sigmoidf(v0[2] + b0[2]); o0[3] = bf_hi(yw.y) * sigmoidf(v0[3] + b0[3]);
                  o1[0] = bf_lo(yw.z) * sigmoidf(v1[0] + b1[0]); o1[1] = bf_hi(yw.z) * sigmoidf(v1[1] + b1[1]); o1[2] = bf_lo(yw.w) * sigmoidf(v1[2] + b1[2]); o1[3] = bf_hi(yw.w) * sigmoidf(v1[3] + b1[3]);
                  float* o = YS + (size_t)row * MIX + col; *(f32x4*)o = o0; *(f32x4*)(o + 4) = o1; )
    }
};
struct EpiRes {
    const float* xp; float* X; float* PART; int first; bf16_t* Hn; const float* g; float* ssq;
    __device__ __forceinline__ void operator()(Acc& acc, const Unit& u, int wr, int wc, int fr, int fq) const {
        if (u.kind == 0) {
            f32x4 gv[2][2];
            if (Hn) {
#pragma unroll
                for (int bj = 0; bj < 2; ++bj) { const int col = u.pn * 256 + bj * 128 + wc * 32 + fq * 8; gv[bj][0] = *(const f32x4*)(g + col); gv[bj][1] = *(const f32x4*)(g + col + 4); }
            }
#pragma unroll
            for (int ai = 0; ai < 2; ++ai)
#pragma unroll
                for (int m = 0; m < 4; ++m) { const int row = u.pm * 256 + ai * 128 + wr * 64 + m * 16 + fr; float ss = 0.f;
#pragma unroll
                    for (int bj = 0; bj < 2; ++bj) { const int col = u.pn * 256 + bj * 128 + wc * 32 + fq * 8;
                        const float* b = first ? xp + (size_t)row * D : (const float*)(X + (size_t)row * D);
                        const f32x4 r0 = *(const f32x4*)(b + col) + acc[ai][bj][m][0], r1 = *(const f32x4*)(b + col + 4) + acc[ai][bj][m][1];
                        float* o = X + (size_t)row * D + col; *(f32x4*)o = r0; *(f32x4*)(o + 4) = r1;
                        if (Hn) { *(u32x4*)(Hn + (size_t)row * D + col) = pack8(r0 * gv[bj][0], r1 * gv[bj][1]);
                            ss += (r0[0] * r0[0] + r0[1] * r0[1]) + (r0[2] * r0[2] + r0[3] * r0[3]) + (r1[0] * r1[0] + r1[1] * r1[1]) + (r1[2] * r1[2] + r1[3] * r1[3]); } }
                    if (Hn) { ss += __shfl_xor(ss, 16); ss += __shfl_xor(ss, 32); if (fq == 0) unsafeAtomicAdd(ssq + row, ss); }
                    asm volatile("" ::: "memory"); }
        } else {
            EPI_ROWS( float* o = PART + ((size_t)u.ks * NS + (row - NP)) * D + col; *(f32x4*)o = v0; *(f32x4*)(o + 4) = v1; )
        }
    }
};
struct EpiQ {
    bf16_t* Q; float* PART; const float* ssq;
    __device__ __forceinline__ void operator()(Acc& acc, const Unit& u, int wr, int wc, int fr, int fq) const {
        if (u.kind == 0) {
#pragma unroll
            for (int ai = 0; ai < 2; ++ai)
#pragma unroll
                for (int m = 0; m < 4; ++m) { const int row = u.pm * 256 + ai * 128 + wr * 64 + m * 16 + fr; const float sc = 0.0625f / sqrtf(ssq[row] * (1.0f / D) + EPS);
#pragma unroll
                    for (int bj = 0; bj < 2; ++bj) { const int col = u.pn * 256 + bj * 128 + wc * 32 + fq * 8; *(u32x4*)(Q + (size_t)row * D + col) = pack8(acc[ai][bj][m][0] * sc, acc[ai][bj][m][1] * sc); } }
        } else {
            EPI_ROWS( float* o = PART + ((size_t)u.ks * NS + (row - NP)) * D + col; *(f32x4*)o = v0 * 0.0625f; *(f32x4*)(o + 4) = v1 * 0.0625f; )
        }
    }
};
struct EpiBf {
    bf16_t* O; int ld; float scale; const float* ssq;
    __device__ __forceinline__ void operator()(Acc& acc, const Unit& u, int wr, int wc, int fr, int fq) const {
#pragma unroll
        for (int ai = 0; ai < 2; ++ai)
#pragma unroll
            for (int m = 0; m < 4; ++m) { const int row = u.pm * 256 + ai * 128 + wr * 64 + m * 16 + fr;
                const float sc = (ssq && row < NP) ? scale / sqrtf(ssq[row] * (1.0f / D) + EPS) : scale;
#pragma unroll
                for (int bj = 0; bj < 2; ++bj) { const int col = u.pn * 256 + bj * 128 + wc * 32 + fq * 8; *(u32x4*)(O + (size_t)row * ld + col) = pack8(acc[ai][bj][m][0] * sc, acc[ai][bj][m][1] * sc); } }
    }
};
struct EpiSoftmax {
    bf16_t* PR; LAS unsigned char* lds;
    __device__ __forceinline__ void operator()(Acc& acc, const Unit& u, int wr, int wc, int fr, int fq) const {
        LAS f32x2* X = (LAS f32x2*)(lds + XCH_OFF);
#pragma unroll
        for (int ai = 0; ai < 2; ++ai)
#pragma unroll
            for (int m = 0; m < 4; ++m) {
                float mx = -3.0e38f;
#pragma unroll
                for (int bj = 0; bj < 2; ++bj)
#pragma unroll
                    for (int n = 0; n < 2; ++n) { const f32x4 x = acc[ai][bj][m][n]; mx = fmaxf(mx, fmaxf(fmaxf(x[0], x[1]), fmaxf(x[2], x[3]))); }
                mx = fmaxf(mx, __shfl_xor(mx, 16)); mx = fmaxf(mx, __shfl_xor(mx, 32));
                float s = 0.f;
#pragma unroll
                for (int bj = 0; bj < 2; ++bj)
#pragma unroll
                    for (int n = 0; n < 2; ++n) { f32x4 x = acc[ai][bj][m][n];
                        x[0] = fast_exp(x[0] - mx); x[1] = fast_exp(x[1] - mx); x[2] = fast_exp(x[2] - mx); x[3] = fast_exp(x[3] - mx);
                        s += (x[0] + x[1]) + (x[2] + x[3]); acc[ai][bj][m][n] = x; }
                s += __shfl_xor(s, 16); s += __shfl_xor(s, 32);
                if (fq == 0) X[(ai * 128 + wr * 64 + m * 16 + fr) * 4 + wc] = (f32x2){mx, s};
            }
        asm volatile("s_waitcnt lgkmcnt(0)" ::: "memory"); __builtin_amdgcn_s_barrier(); asm volatile("" ::: "memory");
#pragma unroll
        for (int ai = 0; ai < 2; ++ai)
#pragma unroll
            for (int m = 0; m < 4; ++m) {
                const int rl = ai * 128 + wr * 64 + m * 16 + fr;
                const f32x2 a = X[rl * 4 + 0], b = X[rl * 4 + 1], c = X[rl * 4 + 2], d = X[rl * 4 + 3];
                const float M = fmaxf(fmaxf(a.x, b.x), fmaxf(c.x, d.x));
                const float tot = a.y * fast_exp(a.x - M) + b.y * fast_exp(b.x - M) + c.y * fast_exp(c.x - M) + d.y * fast_exp(d.x - M);
                const float own = wc == 0 ? a.x : (wc == 1 ? b.x : (wc == 2 ? c.x : d.x));
                const float f = fast_exp(own - M) / tot;
                bf16_t* prow = PR + ((size_t)(u.pm * NH + u.pn) * 256 + rl) * 256;
#pragma unroll
                for (int bj = 0; bj < 2; ++bj) { const int col = bj * 128 + wc * 32 + fq * 8; *(u32x4*)(prow + col) = pack8(acc[ai][bj][m][0] * f, acc[ai][bj][m][1] * f); }
                asm volatile("" ::: "memory");
            }
    }
};


template <int CTRL> __device__ __forceinline__ float dppf(float v) { return __builtin_bit_cast(float, __builtin_amdgcn_update_dpp(0, __builtin_bit_cast(int, v), CTRL, 0xF, 0xF, true)); }
template <int CTRL> __device__ __forceinline__ float dppf_old(float old, float v) { return __builtin_bit_cast(float, __builtin_amdgcn_update_dpp(__builtin_bit_cast(int, old), __builtin_bit_cast(int, v), CTRL, 0xF, 0xF, false)); }
__device__ __forceinline__ float prev_row1(float cur, float pf) { float o = dppf<0x10F>(pf); asm volatile("" : "+v"(o)); float r = dppf_old<0x111>(o, cur); asm volatile("" : "+v"(r)); return r; }
__device__ __forceinline__ float prev_row2(float cur, float pf) { float o = dppf<0x10E>(pf); asm volatile("" : "+v"(o)); float r = dppf_old<0x112>(o, cur); asm volatile("" : "+v"(r)); return r; }
struct EpiFfn {
    bf16_t* ACT; const bf16_t* H; const bf16_t* WUG; const float* cw; const float* st_ffn; float* outFP; float* outFS; const float* ssq; LAS unsigned char* lds;
    __device__ __forceinline__ void operator()(Acc& acc, const Unit& u, int wr, int wc, int fr, int fq) const {
        const int lane = fq * 16 + fr, wid = wr * 4 + wc;
        LAS float* HB = (LAS float*)(lds + XCH_OFF);
        const bool sample = u.pm >= NP / 256;
        const int cl0 = wc * 32 + fq * 8, ch0 = u.pn * 128 + cl0;
        if (!sample) {
#pragma unroll
            for (int ai = 0; ai < 2; ++ai)
#pragma unroll
                for (int m = 0; m < 4; ++m) { const int row = u.pm * 256 + ai * 128 + wr * 64 + m * 16 + fr; const float rs = 1.0f / sqrtf(ssq[row] * (1.0f / D) + EPS);
#pragma unroll
                    for (int bj = 0; bj < 2; ++bj) { acc[ai][bj][m][0] *= rs; acc[ai][bj][m][1] *= rs; } }
            if ((u.pm & 7) != 0) {
                f32x4 hacc = (f32x4){0.f, 0.f, 0.f, 0.f};
                const bf16_t* ap = H + (size_t)(u.pm * 256 - 2 + (fr < 2 ? fr : 0)) * D + fq * 8;
                const bf16_t* bp = WUG + (size_t)(u.pn * 256 + wid * 16 + fr) * D + fq * 8;
#pragma unroll 8
                for (int kb = 0; kb < 32; ++kb) { const bf16x8 a = *(const bf16x8*)(ap + kb * 32), b = *(const bf16x8*)(bp + kb * 32); hacc = __builtin_amdgcn_mfma_f32_16x16x32_bf16(a, b, hacc, 0, 0, 0); }
                if (fq == 0) { const int r0 = u.pm * 256 - 2; const float s0 = 1.0f / sqrtf(ssq[r0] * (1.0f / D) + EPS), s1 = 1.0f / sqrtf(ssq[r0 + 1] * (1.0f / D) + EPS);
                    HB[0 * 128 + wid * 16 + fr] = hacc[0] * s0; HB[1 * 128 + wid * 16 + fr] = hacc[1] * s1; }
            } else if (wid < 4) HB[wid * 64 + lane] = 0.f;
            if (fr >= 14) {
#pragma unroll
                for (int ai = 0; ai < 2; ++ai) { LAS float* d = HB + ((1 + ai * 2 + wr) * 2 + (fr - 14)) * 128 + cl0; *(LAS f32x4*)d = acc[ai][0][3][0]; *(LAS f32x4*)(d + 4) = acc[ai][0][3][1]; }
            }
        }
        asm volatile("s_waitcnt lgkmcnt(0)" ::: "memory"); __builtin_amdgcn_s_barrier(); asm volatile("" ::: "memory");
        const f32x4 w0a = *(const f32x4*)(cw + ch0), w0b = *(const f32x4*)(cw + ch0 + 4), w1a = *(const f32x4*)(cw + DFF + ch0), w1b = *(const f32x4*)(cw + DFF + ch0 + 4),
                    w2a = *(const f32x4*)(cw + 2 * DFF + ch0), w2b = *(const f32x4*)(cw + 2 * DFF + ch0 + 4);
#pragma unroll
        for (int ai = 0; ai < 2; ++ai) {
            f32x4 pva = (f32x4){0.f, 0.f, 0.f, 0.f}, pvb = pva;
            if (!sample) { const int slot = ai == 0 ? (wr == 0 ? 0 : 1) : (wr == 0 ? 2 : 3);
                const LAS float* hp = HB + (slot * 2 + (fr >= 14 ? fr - 14 : 0)) * 128 + cl0; pva = *(const LAS f32x4*)hp; pvb = *(const LAS f32x4*)(hp + 4); }
#pragma unroll
            for (int m = 0; m < 4; ++m) {
                const int row = u.pm * 256 + ai * 128 + wr * 64 + m * 16 + fr;
                const f32x4 ca = acc[ai][0][m][0], cb = acc[ai][0][m][1];
                const f32x4 fa = m ? acc[ai][0][m ? m - 1 : 0][0] : pva, fb = m ? acc[ai][0][m ? m - 1 : 0][1] : pvb;
                f32x4 p1a, p1b, p2a, p2b;
                if (!sample) {
#pragma unroll
                    for (int e = 0; e < 4; ++e) {
                        p1a[e] = prev_row1(ca[e], fa[e]); p1b[e] = prev_row1(cb[e], fb[e]);
                        p2a[e] = prev_row2(ca[e], fa[e]); p2b[e] = prev_row2(cb[e], fb[e]); }
                } else {
                    const int t = fr & 3; const float* sp = st_ffn + (size_t)((row - NP) >> 2) * 2 * DFF + ch0;
                    const f32x4 s0a = *(const f32x4*)sp, s0b = *(const f32x4*)(sp + 4), s1a = *(const f32x4*)(sp + DFF), s1b = *(const f32x4*)(sp + DFF + 4);
#pragma unroll
                    for (int e = 0; e < 4; ++e) {
                        float r1a = dppf<0x111>(ca[e]), r1b = dppf<0x111>(cb[e]), r2a = dppf<0x112>(ca[e]), r2b = dppf<0x112>(cb[e]);
                        asm volatile("" : "+v"(r1a), "+v"(r1b), "+v"(r2a), "+v"(r2b));
                        p1a[e] = t >= 1 ? r1a : s1a[e]; p1b[e] = t >= 1 ? r1b : s1b[e];
                        p2a[e] = t >= 2 ? r2a : (t == 0 ? s0a[e] : s1a[e]); p2b[e] = t >= 2 ? r2b : (t == 0 ? s0b[e] : s1b[e]); }
                }
                const f32x4 ga = acc[ai][1][m][0], gb = acc[ai][1][m][1];
                f32x4 oa, ob;
#pragma unroll
                for (int e = 0; e < 4; ++e) { oa[e] = gelu_tanh(w0a[e] * p2a[e] + w1a[e] * p1a[e] + w2a[e] * ca[e]) * ga[e]; ob[e] = gelu_tanh(w0b[e] * p2b[e] + w1b[e] * p1b[e] + w2b[e] * cb[e]) * gb[e]; }
                *(u32x4*)(ACT + (size_t)row * DFF + ch0) = pack8(oa, ob);
                if (!sample) {
                    if ((u.pm & 7) == 7 && ai == 1 && wr == 1 && m == 3 && fr >= 14) { float* o = outFP + ((size_t)(u.pm >> 3) * 2 + (fr - 14)) * DFF + ch0; *(f32x4*)o = ca; *(f32x4*)(o + 4) = cb; }
                } else if ((fr & 3) >= 2) { float* o = outFS + ((size_t)((row - NP) >> 2) * 2 + ((fr & 3) - 2)) * DFF + ch0; *(f32x4*)o = ca; *(f32x4*)(o + 4) = cb; }
            }
        }
    }
};

#ifndef ONLY
#define ONLY -1
#endif
#define PH(k) (ONLY < 0 || ONLY == (k))
#define GSYNC() xcd_barrier(xb)
struct Args { const float* in[37]; float* out; unsigned char* ws; };

__device__ __forceinline__ void transpose_item(const float* W, int K, int N, bf16_t* WT, int row_off, LAS float* scr, int item, int lane, int remap = 0) {
    const int nblk = N / 32, kb = item / nblk, nb = item % nblk, k0 = 64 * kb, n0 = 32 * nb;
    if (remap) row_off = (n0 >> 7) * 256 + (n0 & 127) + (remap == 2 ? 128 : 0) - n0;
#pragma unroll 8
    for (int i = 0; i < 32; ++i) { const int kk = 2 * i + (lane >> 5); scr[kk * 33 + (lane & 31)] = W[(size_t)(k0 + kk) * N + n0 + (lane & 31)]; }
    asm volatile("s_waitcnt lgkmcnt(0)" ::: "memory");
    const int c = lane & 7;
#pragma unroll
    for (int j = 0; j < 4; ++j) { const int n = (lane >> 3) + 8 * j; const LAS float* s = scr + (8 * c) * 33 + n;
        u32x4 o; o.x = cvt_pk_bf16(s[0 * 33], s[1 * 33]); o.y = cvt_pk_bf16(s[2 * 33], s[3 * 33]); o.z = cvt_pk_bf16(s[4 * 33], s[5 * 33]); o.w = cvt_pk_bf16(s[6 * 33], s[7 * 33]);
        *(u32x4*)(WT + (size_t)(row_off + n0 + n) * K + k0 + 8 * c) = o; }
    asm volatile("s_waitcnt lgkmcnt(0)" ::: "memory");
}


__device__ __forceinline__ void transpose_item2(const float* W, int K, int N, bf16_t* WT, int row_off, int item, int lane, int remap) {
    const int nblk = N / 256, kb = item / nblk, nb = item % nblk, k0 = 32 * kb, n = 256 * nb + 4 * lane;
    const int rowb = remap ? ((n >> 7) * 256 + (n & 127) + (remap == 2 ? 128 : 0)) : (row_off + n);
    const float* src = W + (size_t)k0 * N + n;
    bf16_t* dst = WT + (size_t)rowb * K + k0;
#pragma unroll
    for (int sblk = 0; sblk < 4; ++sblk) {
        f32x4 v[8];
#pragma unroll
        for (int i = 0; i < 8; ++i) v[i] = *(const f32x4*)(src + (size_t)(8 * sblk + i) * N);
#pragma unroll
        for (int j = 0; j < 4; ++j) { u32x4 o; o.x = cvt_pk_bf16(v[0][j], v[1][j]); o.y = cvt_pk_bf16(v[2][j], v[3][j]); o.z = cvt_pk_bf16(v[4][j], v[5][j]); o.w = cvt_pk_bf16(v[6][j], v[7][j]);
            *(u32x4*)(dst + (size_t)j * K + 8 * sblk) = o; }
    }
}
__device__ __forceinline__ void rms_row2_bf16(const float* xa, const float* xb, const float* g, bf16_t* oa, bf16_t* ob, int lane) {
    const f32x4* pa = (const f32x4*)xa + lane; const f32x4* pb = (const f32x4*)xb + lane; f32x4 va[4], vb[4]; float sa = 0.f, sb = 0.f;
#pragma unroll
    for (int j = 0; j < 4; ++j) { va[j] = pa[64 * j]; vb[j] = pb[64 * j]; }
#pragma unroll
    for (int j = 0; j < 4; ++j) { sa += (va[j][0] * va[j][0] + va[j][1] * va[j][1]) + (va[j][2] * va[j][2] + va[j][3] * va[j][3]); sb += (vb[j][0] * vb[j][0] + vb[j][1] * vb[j][1]) + (vb[j][2] * vb[j][2] + vb[j][3] * vb[j][3]); }
#pragma unroll
    for (int o = 1; o < 64; o <<= 1) { sa += __shfl_xor(sa, o); sb += __shfl_xor(sb, o); }
    const float ra = 1.0f / sqrtf(sa * (1.0f / D) + EPS), rb = 1.0f / sqrtf(sb * (1.0f / D) + EPS);
    u32x2* qa = (u32x2*)oa + lane; u32x2* qb = (u32x2*)ob + lane;
#pragma unroll
    for (int j = 0; j < 4; ++j) { const f32x4 gg = ((const f32x4*)g)[lane + 64 * j]; u32x2 w;
        w.x = cvt_pk_bf16(va[j][0] * ra * gg[0], va[j][1] * ra * gg[1]); w.y = cvt_pk_bf16(va[j][2] * ra * gg[2], va[j][3] * ra * gg[3]); qa[64 * j] = w;
        w.x = cvt_pk_bf16(vb[j][0] * rb * gg[0], vb[j][1] * rb * gg[1]); w.y = cvt_pk_bf16(vb[j][2] * rb * gg[2], vb[j][3] * rb * gg[3]); qb[64 * j] = w; }
}

__device__ __forceinline__ void add_parts(float* xrow, const float* part, int nparts, size_t pstride, int lane) {
    f32x4* xr = (f32x4*)xrow + lane; f32x4 v[4];
#pragma unroll
    for (int j = 0; j < 4; ++j) v[j] = xr[64 * j];
    for (int k = 0; k < nparts; ++k) { const f32x4* pr = (const f32x4*)(part + (size_t)k * pstride) + lane;
#pragma unroll
        for (int j = 0; j < 4; ++j) v[j] += pr[64 * j]; }
#pragma unroll
    for (int j = 0; j < 4; ++j) xr[64 * j] = v[j];
}
__device__ __forceinline__ void rms_row_bf16(const float* xrow, const float* g, bf16_t* orow, int lane) {
    const f32x4* xr = (const f32x4*)xrow + lane; f32x4 v[4]; float s = 0.f;
#pragma unroll
    for (int j = 0; j < 4; ++j) { v[j] = xr[64 * j]; s += (v[j][0] * v[j][0] + v[j][1] * v[j][1]) + (v[j][2] * v[j][2] + v[j][3] * v[j][3]); }
    const float rstd = 1.0f / sqrtf(wave_sum(s) * (1.0f / D) + EPS);
    u32x2* o8 = (u32x2*)orow + lane;
#pragma unroll
    for (int j = 0; j < 4; ++j) { const f32x4 gg = ((const f32x4*)g)[lane + 64 * j]; u32x2 w; w.x = cvt_pk_bf16(v[j][0] * rstd * gg[0], v[j][1] * rstd * gg[1]); w.y = cvt_pk_bf16(v[j][2] * rstd * gg[2], v[j][3] * rstd * gg[3]); o8[64 * j] = w; }
}
__device__ __forceinline__ void rms_row_f32(const float* xrow, const float* g, float* orow, int lane) {
    const f32x4* xr = (const f32x4*)xrow + lane; f32x4 v[4]; float s = 0.f;
#pragma unroll
    for (int j = 0; j < 4; ++j) { v[j] = xr[64 * j]; s += (v[j][0] * v[j][0] + v[j][1] * v[j][1]) + (v[j][2] * v[j][2] + v[j][3] * v[j][3]); }
    const float rstd = 1.0f / sqrtf(wave_sum(s) * (1.0f / D) + EPS);
#pragma unroll
    for (int j = 0; j < 4; ++j) { const f32x4 gg = ((const f32x4*)g)[lane + 64 * j]; ((f32x4*)orow)[lane + 64 * j] = v[j] * rstd * gg; }
}

__device__ __forceinline__ float treduce16(float (&v)[16], int lane) {
    { const bool hi = lane & 32;
#pragma unroll
      for (int i = 0; i < 8; ++i) { const float send = hi ? v[i] : v[i + 8], keep = hi ? v[i + 8] : v[i]; v[i] = keep + __shfl_xor(send, 32); } }
    { const bool hi = lane & 16;
#pragma unroll
      for (int i = 0; i < 4; ++i) { const float send = hi ? v[i] : v[i + 4], keep = hi ? v[i + 4] : v[i]; v[i] = keep + __shfl_xor(send, 16); } }
    { const bool hi = lane & 8;
#pragma unroll
      for (int i = 0; i < 2; ++i) { const float send = hi ? v[i] : v[i + 2], keep = hi ? v[i + 2] : v[i]; v[i] = keep + __shfl_xor(send, 8); } }
    { const bool hi = lane & 4; const float send = hi ? v[0] : v[1], keep = hi ? v[1] : v[0]; v[0] = keep + __shfl_xor(send, 4); }
    v[0] += __shfl_xor(v[0], 2); v[0] += __shfl_xor(v[0], 1);
    return v[0];
}
template <int W> __device__ __forceinline__ void tr_step(float (&v)[64], int lane) {
    const bool hi = lane & W;
#pragma unroll
    for (int i = 0; i < W; ++i) { const float send = hi ? v[i] : v[i + W], keep = hi ? v[i + W] : v[i]; v[i] = keep + __shfl_xor(send, W); }
}
__device__ __forceinline__ float treduce64(float (&v)[64], int lane) {
    tr_step<32>(v, lane); tr_step<16>(v, lane); tr_step<8>(v, lane); tr_step<4>(v, lane); tr_step<2>(v, lane); tr_step<1>(v, lane);
    return v[0];
}

template <bool WITH_Y>
__device__ __forceinline__ void ssm_tile(const bf16_t* zu, int nsteps, float& sr, float& si, const float* BB, const float* AT, const float* Cre, const float* Cim, const float* Dv,
                                         int g, bf16_t* yg, int lane) {
    float Br[16], Bi[16];
    { const f32x4* bp = (const f32x4*)(BB + (size_t)(g * SN + lane) * 32);
#pragma unroll
      for (int j = 0; j < 4; ++j) { const f32x4 a = bp[j], b = bp[4 + j]; Br[4 * j] = a[0]; Br[4 * j + 1] = a[1]; Br[4 * j + 2] = a[2]; Br[4 * j + 3] = a[3]; Bi[4 * j] = b[0]; Bi[4 * j + 1] = b[1]; Bi[4 * j + 2] = b[2]; Bi[4 * j + 3] = b[3]; } }
    const f32x4 at = *(const f32x4*)(AT + (size_t)(g * SN + lane) * 4); const float ar = at[0], ai = at[1];
    float Cr[16], Ci[16], Dm[16];
    if (WITH_Y) {
#pragma unroll
        for (int p = 0; p < 16; ++p) { Cr[p] = Cre[(size_t)(g * SP + p) * SN + lane]; Ci[p] = Cim[(size_t)(g * SP + p) * SN + lane]; Dm[p] = (lane == 0) ? Dv[g * SP + p] : 0.f; }
    }
    u32x4 u0 = (u32x4){0, 0, 0, 0}, u1 = (u32x4){0, 0, 0, 0};
    if (lane < nsteps) { const u32x4* up = (const u32x4*)(zu + (size_t)lane * NZ); u0 = up[0]; u1 = up[1]; }
    const int p_own = ((lane >> 5) & 1) * 8 + ((lane >> 4) & 1) * 4 + ((lane >> 3) & 1) * 2 + ((lane >> 2) & 1);
    for (int t = 0; t < nsteps; ++t) {
        float uu[16];
        { unsigned w;
          w = __builtin_amdgcn_readlane(u0.x, t); uu[0] = bf_lo(w); uu[1] = bf_hi(w);
          w = __builtin_amdgcn_readlane(u0.y, t); uu[2] = bf_lo(w); uu[3] = bf_hi(w);
          w = __builtin_amdgcn_readlane(u0.z, t); uu[4] = bf_lo(w); uu[5] = bf_hi(w);
          w = __builtin_amdgcn_readlane(u0.w, t); uu[6] = bf_lo(w); uu[7] = bf_hi(w);
          w = __builtin_amdgcn_readlane(u1.x, t); uu[8] = bf_lo(w); uu[9] = bf_hi(w);
          w = __builtin_amdgcn_readlane(u1.y, t); uu[10] = bf_lo(w); uu[11] = bf_hi(w);
          w = __builtin_amdgcn_readlane(u1.z, t); uu[12] = bf_lo(w); uu[13] = bf_hi(w);
          w = __builtin_amdgcn_readlane(u1.w, t); uu[14] = bf_lo(w); uu[15] = bf_hi(w); }
        float br = 0.f, bi = 0.f;
#pragma unroll
        for (int p = 0; p < 16; ++p) { br = fmaf(Br[p], uu[p], br); bi = fmaf(Bi[p], uu[p], bi); }
        const float nr = ar * sr - ai * si + br, ni = ar * si + ai * sr + bi;
        sr = nr; si = ni;
        if (WITH_Y) {
            float v[16];
#pragma unroll
            for (int p = 0; p < 16; ++p) v[p] = fmaf(Dm[p], uu[p], Cr[p] * sr - Ci[p] * si);
            const float y = treduce16(v, lane);
            const float gy = gelu_tanh(y);
            if ((lane & 3) == 0) yg[(size_t)t * MIX + g * SP + p_own] = (bf16_t)(cvt_pk_bf16(gy, 0.f) & 0xffff);
        }
    }
}


typedef short bf16x4 __attribute__((ext_vector_type(4)));
struct SsmTab { bf16x4 Bre[4], Bim[4]; bf16x8 Ct[4]; float dp; float ar, ai; };
__device__ __forceinline__ void ssm_load_tab(SsmTab& T, int g, const bf16_t* BTR, const bf16_t* BTI, const bf16_t* CT, const float* AT, const float* Dv, int lane, bool with_y) {
    const int li = lane & 15, lq = lane >> 4;
#pragma unroll
    for (int nt = 0; nt < 4; ++nt) { T.Bre[nt] = *(const bf16x4*)(BTR + ((size_t)(g * SN + 16 * nt + li)) * 16 + 4 * lq); T.Bim[nt] = *(const bf16x4*)(BTI + ((size_t)(g * SN + 16 * nt + li)) * 16 + 4 * lq); }
    const f32x4 at = *(const f32x4*)(AT + (size_t)(g * SN + lane) * 4); T.ar = at[0]; T.ai = at[1];
    if (with_y) {
#pragma unroll
        for (int kb = 0; kb < 4; ++kb) T.Ct[kb] = *(const bf16x8*)(CT + ((size_t)(g * SP + li)) * 128 + kb * 32 + 8 * lq);
        T.dp = Dv[g * SP + li];
    }
}
template <bool WITH_Y>
__device__ __forceinline__ void ssm_chunk(LAS unsigned char* wl, const bf16_t* zu, float& sr, float& si, const SsmTab& T, bf16_t* yg, int lane) {
    const int li = lane & 15, lq = lane >> 4;
    bf16x4 U[4];
#pragma unroll
    for (int mt = 0; mt < 4; ++mt) U[mt] = *(const bf16x4*)(zu + (size_t)(16 * mt + li) * NZ + 4 * lq);
    {
        int rofs[4], nofs[4];
#pragma unroll
        for (int r = 0; r < 4; ++r) { rofs[r] = lq * 1024 + (li & 3) * 4 + r * 256 + (((li >> 2) ^ r) << 4); nofs[r] = ((r ^ lq) << 6); }
#pragma unroll 1
        for (int mt = 0; mt < 4; ++mt) {
            LAS unsigned char* pm = wl + mt * 4096;
            const bf16x4 um = mt == 0 ? U[0] : (mt == 1 ? U[1] : (mt == 2 ? U[2] : U[3]));
#pragma unroll
            for (int nt = 0; nt < 4; ++nt) {
                const f32x4 dre = __builtin_amdgcn_mfma_f32_16x16x16bf16_1k(um, T.Bre[nt], (f32x4){0.f, 0.f, 0.f, 0.f}, 0, 0, 0);
                const f32x4 dim = __builtin_amdgcn_mfma_f32_16x16x16bf16_1k(um, T.Bim[nt], (f32x4){0.f, 0.f, 0.f, 0.f}, 0, 0, 0);
#pragma unroll
                for (int r = 0; r < 4; ++r) *(LAS unsigned*)(pm + rofs[r] + nofs[nt]) = cvt_pk_bf16(dre[r], dim[r]);
            }
        }
    }
    asm volatile("s_waitcnt lgkmcnt(0)" ::: "memory");
    {
        const float ar = T.ar, ai = T.ai;
        int xj[16];
#pragma unroll
        for (int j = 0; j < 16; ++j) xj[j] = (((lane >> 2) ^ j) << 4) + (lane & 3) * 4 + j * 256;
#pragma unroll 1
        for (int tb = 0; tb < 4; ++tb) {
            LAS unsigned char* pb = wl + tb * 4096;
            unsigned w[16];
#pragma unroll
            for (int j = 0; j < 16; ++j) w[j] = *(const LAS unsigned*)(pb + xj[j]);
#pragma unroll
            for (int j = 0; j < 16; ++j) {
                const float nr = ar * sr - ai * si + bf_lo(w[j]), ni = ar * si + ai * sr + bf_hi(w[j]);
                sr = nr; si = ni;
                if (WITH_Y) *(LAS unsigned*)(pb + xj[j]) = cvt_pk_bf16(sr, si);
            }
        }
    }
    if (WITH_Y) {
        asm volatile("s_waitcnt lgkmcnt(0)" ::: "memory");
        int kofs[4];
#pragma unroll
        for (int kb = 0; kb < 4; ++kb) kofs[kb] = li * 256 + ((((kb * 4 + lq) ^ li)) << 4);
#pragma unroll 1
        for (int mt = 0; mt < 4; ++mt) {
            const LAS unsigned char* pm = wl + mt * 4096;
            f32x4 acc = (f32x4){0.f, 0.f, 0.f, 0.f};
#pragma unroll
            for (int kb = 0; kb < 4; ++kb) { const bf16x8 a = *(const LAS bf16x8*)(pm + kofs[kb]); acc = __builtin_amdgcn_mfma_f32_16x16x32_bf16(a, T.Ct[kb], acc, 0, 0, 0); }
            bf16_t* yp = yg + (size_t)(16 * mt + 4 * lq) * MIX + li;
            const bf16_t* up = zu + (size_t)(16 * mt + 4 * lq) * NZ + li;
#pragma unroll
            for (int r = 0; r < 4; ++r) { const float uv = __uint_as_float(((unsigned)up[(size_t)r * NZ]) << 16);
                yp[(size_t)r * MIX] = (bf16_t)(cvt_pk_bf16(gelu_tanh(fmaf(T.dp, uv, acc[r])), 0.f) & 0xffff); }
        }
        asm volatile("s_waitcnt lgkmcnt(0)" ::: "memory");
    }
}

#define XB_TMO      128
#define XB_XCNT(j)  (256  + 64 * (j))
#define XB_XSUB(j)  (1280 + 64 * (j))
#define XB_XGEN(j)  (2304 + 64 * (j))
#define XB_TOP      3328
#define XB_TOPGEN   3392
#define XCD_BAR_WORDS 3456
#define XB_SPIN_CAP (1u << 18)
__device__ __forceinline__ unsigned xb_ld(unsigned* p)              { return __hip_atomic_load(p, __ATOMIC_RELAXED, __HIP_MEMORY_SCOPE_AGENT); }
__device__ __forceinline__ unsigned xb_add(unsigned* p, unsigned v) { return __hip_atomic_fetch_add(p, v, __ATOMIC_RELAXED, __HIP_MEMORY_SCOPE_AGENT); }
__device__ __forceinline__ unsigned xb_xcc_id() { return (unsigned)__builtin_amdgcn_s_getreg((3 << 11) | 20) & 0xFu; }
#define XB_SPIN(cond, bar) do { unsigned _sp = 0; while (cond) { __builtin_amdgcn_s_sleep(1); \
    if ((++_sp & 255u) == 0u) { if (xb_ld(&(bar)[XB_TMO])) break; if (_sp > XB_SPIN_CAP) { atomicAdd(&(bar)[XB_TMO], 1u); break; } } } } while (0)
struct XcdBarrier { unsigned* bar; unsigned x; volatile LAS unsigned* st; };
__device__ __forceinline__ XcdBarrier xcd_barrier_post(unsigned* bar, volatile LAS unsigned* st) {
    XcdBarrier b; b.bar = bar; b.x = xb_xcc_id(); b.st = st;
    if (threadIdx.x == 0) (void)xb_add(&bar[XB_XCNT(b.x)], 1u);
    return b;
}
__device__ __forceinline__ void xcd_barrier_complete(unsigned* bar, unsigned x, unsigned& nloc, unsigned& nx) {
    const unsigned G = gridDim.x * gridDim.y * gridDim.z;
    unsigned sum, cnt, mine, sp = 0u;
    for (;;) {
        sum = 0u; cnt = 0u; mine = 0u;
#pragma unroll
        for (unsigned j = 0; j < 16; ++j) { const unsigned c = xb_ld(&bar[XB_XCNT(j)]); sum += c; cnt += (c > 0u) ? 1u : 0u; mine = (j == x) ? c : mine; }
        if (sum == G) break;
        __builtin_amdgcn_s_sleep(1);
        if ((++sp & 255u) == 0u) { if (xb_ld(&bar[XB_TMO])) break; if (sp > XB_SPIN_CAP) { atomicAdd(&bar[XB_TMO], 1u); break; } }
    }
    nloc = mine > 0u ? mine : 1u; nx = cnt > 0u ? cnt : 1u;
}
__device__ __forceinline__ void xcd_barrier(const XcdBarrier& b) {
    asm volatile("s_waitcnt vmcnt(0)" ::: "memory");
    __syncthreads();
    if (threadIdx.x == 0) {
        unsigned* bar = b.bar;
        __builtin_amdgcn_s_waitcnt(0);
        unsigned nloc = b.st[0], nx = b.st[1];
        if (nloc == 0u) { xcd_barrier_complete(bar, b.x, nloc, nx); b.st[0] = nloc; b.st[1] = nx; }
        const unsigned old = xb_add(&bar[XB_XSUB(b.x)], 1u);
        const unsigned gen = old / nloc;
        if (old + 1u == (gen + 1u) * nloc) {
            __builtin_amdgcn_fence(__ATOMIC_RELEASE, "agent");
            asm volatile("s_waitcnt vmcnt(0)" ::: "memory");
            const unsigned og = xb_add(&bar[XB_TOP], 1u);
            const unsigned tg = og / nx;
            if (og + 1u == (tg + 1u) * nx) xb_add(&bar[XB_TOPGEN], 1u);
            else XB_SPIN(xb_ld(&bar[XB_TOPGEN]) == tg, bar);
            __builtin_amdgcn_fence(__ATOMIC_ACQUIRE, "agent");
            xb_add(&bar[XB_XGEN(b.x)], 1u);
            asm volatile("s_waitcnt vmcnt(0)" ::: "memory");
        } else {
            XB_SPIN(xb_ld(&bar[XB_XGEN(b.x)]) == gen, bar);
            __builtin_amdgcn_fence(__ATOMIC_ACQUIRE, "agent");
            asm volatile("s_waitcnt vmcnt(0)" ::: "memory");
        }
    }
    __syncthreads();
}

__device__ __forceinline__ const float* ld_in(int k) {
    const __attribute__((address_space(4))) unsigned long long* t = (const __attribute__((address_space(4))) unsigned long long*)__builtin_amdgcn_kernarg_segment_ptr();
    asm volatile("" : "+s"(t));
    return (const float*)t[k];
}
__global__ void __launch_bounds__(NTHREADS, 2) hymba_fwd(Args args) {
    extern __shared__ __attribute__((aligned(16))) unsigned char lds_raw[];
    LAS unsigned char* lds = (LAS unsigned char*)lds_raw;
    cg::grid_group grid = cg::this_grid();
    const int tid = threadIdx.x, lane = tid & 63, wave = __builtin_amdgcn_readfirstlane(tid >> 6);
    const int G = gridDim.x, bx = blockIdx.x;
    const int gw = bx * NWAVES + wave, NGW = G * NWAVES;
#define IN(k) ld_in(k)
    unsigned char* ws = (unsigned char*)ld_in(38); float* out = (float*)ld_in(37);
    unsigned* barw = (unsigned*)(ws + WS_CTL);
    volatile LAS unsigned* bst = (volatile LAS unsigned*)(lds + XCH_OFF + 8192);
    if (bx == 0) for (int i = tid; i < XCD_BAR_WORDS; i += NTHREADS) barw[i] = 0u;
    if (tid < 2) bst[tid] = 0u;
    bf16_t* WIN = (bf16_t*)(ws + WS_WIN); bf16_t* WKV = (bf16_t*)(ws + WS_WKV); bf16_t* WGLU = (bf16_t*)(ws + WS_WGLU); bf16_t* WOUT = (bf16_t*)(ws + WS_WOUT);
    bf16_t* WQ = (bf16_t*)(ws + WS_WQ); bf16_t* WXO = (bf16_t*)(ws + WS_WXO); bf16_t* WUG = (bf16_t*)(ws + WS_WUG); bf16_t* WDN = (bf16_t*)(ws + WS_WDN);
    bf16_t* H = (bf16_t*)(ws + WS_H); float* X = (float*)(ws + WS_X);
    bf16_t* Z = (bf16_t*)(ws + WS_Z); bf16_t* YG = (bf16_t*)(ws + WS_YG); float* YS = (float*)(ws + WS_YS); bf16_t* MIXN = (bf16_t*)(ws + WS_MIXN);
    bf16_t* Q = (bf16_t*)(ws + WS_Q); bf16_t* PR = (bf16_t*)(ws + WS_PR); bf16_t* O = (bf16_t*)(ws + WS_O);
    bf16_t* MN = (bf16_t*)(ws + WS_MN); bf16_t* KB = (bf16_t*)(ws + WS_KB); bf16_t* VT = (bf16_t*)(ws + WS_VT);
    float* SE = (float*)(ws + WS_SE); float* SI = (float*)(ws + WS_SI); float* BB = (float*)(ws + WS_BB); float* AT = (float*)(ws + WS_AT);
    float* PART = (float*)(ws + WS_PART); float* SSQ = (float*)(ws + WS_SSQ);
    bf16_t* BTR = (bf16_t*)(ws + WS_BTR); bf16_t* BTI = (bf16_t*)(ws + WS_BTI); bf16_t* CT = (bf16_t*)(ws + WS_CT);
    bf16_t* UG = (bf16_t*)(ws + WS_UG); bf16_t* ACT = (bf16_t*)(ws + WS_ACT);

    if (PH(0)) {
        const float* x_prompt = IN(0); const float* x_sample = IN(1); const float* mem_prompt = IN(2); const float* norm_mix = IN(9); const float* w_in = IN(10);
        const float* C_re = IN(16); const float* C_im = IN(17);
        const float* A_re = IN(11); const float* A_im = IN(12); const float* log_dt = IN(13); const float* B_re = IN(14); const float* B_im = IN(15);
        const float* w_glu = IN(19); const float* w_out = IN(24); const float* norm_mem = IN(26); const float* w_q = IN(27); const float* w_k = IN(28); const float* w_v = IN(29); const float* w_xo = IN(30);
        const float* w_up = IN(32); const float* w_gate = IN(33); const float* w_down = IN(35);
        constexpr int J_IN = 32 * 8, J_D = 32 * 4, J_GLU = 16 * 2, J_UP = 32 * 11, J_DN = 88 * 4;
        constexpr int NITEMS = J_IN + 5 * J_D + J_GLU + 2 * J_UP + J_DN;
        for (int it = gw; it < NITEMS; it += NGW) {
            int r = it;
            if (r < J_UP) { transpose_item2(w_up, D, DFF, WUG, 0, r, lane, 1); continue; } r -= J_UP;
            if (r < J_UP) { transpose_item2(w_gate, D, DFF, WUG, 0, r, lane, 2); continue; } r -= J_UP;
            if (r < J_DN) { transpose_item2(w_down, DFF, D, WDN, 0, r, lane, 0); continue; } r -= J_DN;
            if (r < J_IN) { transpose_item2(w_in, D, NZ, WIN, 0, r, lane, 0); continue; } r -= J_IN;
            if (r < J_D) { transpose_item2(w_k, D, D, WKV, 0, r, lane, 0); continue; } r -= J_D;
            if (r < J_D) { transpose_item2(w_v, D, D, WKV, D, r, lane, 0); continue; } r -= J_D;
            if (r < J_D) { transpose_item2(w_out, D, D, WOUT, 0, r, lane, 0); continue; } r -= J_D;
            if (r < J_D) { transpose_item2(w_q, D, D, WQ, 0, r, lane, 0); continue; } r -= J_D;
            if (r < J_D) { transpose_item2(w_xo, D, D, WXO, 0, r, lane, 0); continue; } r -= J_D;
            transpose_item2(w_glu, MIX, MIX, WGLU, 0, r, lane, 0);
        }
        for (int m = 2 * gw; m < MT; m += 2 * NGW) {
            const float* xa = m < NP ? x_prompt + (size_t)m * D : x_sample + (size_t)(m - NP) * D;
            rms_row2_bf16(xa, xa + D, norm_mix, H + (size_t)m * D, H + (size_t)(m + 1) * D, lane);
        }
        for (int m = 2 * gw; m < BP * NMEM; m += 2 * NGW) rms_row2_bf16(mem_prompt + (size_t)m * D, mem_prompt + (size_t)(m + 1) * D, norm_mem, MN + (size_t)m * D, MN + (size_t)(m + 1) * D, lane);
        for (size_t i = (size_t)bx * NTHREADS + tid; i < (size_t)NS * D / 4; i += (size_t)G * NTHREADS) { ((f32x4*)(X + (size_t)NP * D))[i] = ((const f32x4*)x_sample)[i]; }
        for (int i = bx * NTHREADS + tid; i < 2 * NP; i += G * NTHREADS) SSQ[i] = 0.f;
        const int gt = bx * NTHREADS + tid;
        if (gt < SG * SN) {
            const int g = gt / SN;
            const float dt = expf(log_dt[g]), lr = A_re[gt], li = A_im[gt];
            const float mag = expf(dt * lr), ph = dt * li;
            double th = (double)ph * (1.0 / 1024.0), t2 = th * th;
            double c = 1.0 - t2 * (0.5 - t2 * (1.0 / 24.0 - t2 * (1.0 / 720.0)));
            double s = th * (1.0 - t2 * (1.0 / 6.0 - t2 * (1.0 / 120.0 - t2 * (1.0 / 5040.0))));
#pragma unroll 1
            for (int k = 0; k < 10; ++k) { const double c2 = c * c - s * s, s2 = 2.0 * c * s; c = c2; s = s2; }
            const float ar = mag * (float)c, ai = mag * (float)s;
            const float den = lr * lr + li * li;
            const float cr = ((ar - 1.0f) * lr + ai * li) / den, ci = (ai * lr - (ar - 1.0f) * li) / den;
#pragma unroll
            for (int p = 0; p < 16; ++p) { const float br = B_re[(size_t)gt * SP + p], bi = B_im[(size_t)gt * SP + p];
                const float bbr = cr * br - ci * bi, bbi = cr * bi + ci * br;
                BB[(size_t)gt * 32 + p] = bbr; BB[(size_t)gt * 32 + 16 + p] = bbi;
                BTR[(size_t)gt * 16 + p] = (bf16_t)(cvt_pk_bf16(bbr, 0.f) & 0xffff); BTI[(size_t)gt * 16 + p] = (bf16_t)(cvt_pk_bf16(bbi, 0.f) & 0xffff); }
            float pr = ar, pi = ai;
#pragma unroll 1
            for (int k = 0; k < 6; ++k) { const float r2 = pr * pr - pi * pi, i2 = 2.0f * pr * pi; pr = r2; pi = i2; }
            *(f32x4*)(AT + (size_t)gt * 4) = (f32x4){ar, ai, pr, pi};
        }
        if (gt < SG * SP * SN) {
            const float cre = C_re[gt], cim = C_im[gt];
            ((unsigned*)CT)[gt] = cvt_pk_bf16(cre, -cim);
        }
    }
    grid.sync();
    const XcdBarrier xb = xcd_barrier_post(barw, bst);

    if (PH(1)) {
        Sched2 S{G, bx, MT / 256, NZ / 256, 16, BP, 8, 16, 1, 0, (const char*)H, (const char*)WIN, (const char*)MN, (const char*)WKV, (size_t)256 * D * 2, (size_t)256 * D * 2};
        EpiP1 E{Z, out + O_MK, out + O_MV, KB, VT};
        pg8::gemm_phase(lds, D, D, S, E);
    }
    GSYNC();

    if (PH(2)) {
        const float* st_re = IN(5); const float* st_im = IN(6); const float* st_conv = IN(7); const float* C_re = IN(16); const float* C_im = IN(17); const float* Dssm = IN(18); const float* conv_w = IN(21); const float* norm_conv = IN(23);
        {
            SsmTab T; int gcur = -1;
            for (int task = gw; task < BP * SG * NCH; task += NGW) {
                const int c = task % NCH, g = (task / NCH) % SG, b = task / (NCH * SG);
                if (g != gcur) { ssm_load_tab(T, g, BTR, BTI, CT, AT, Dssm, lane, false); gcur = g; }
                float sr = 0.f, si = 0.f;
#ifdef OLD_PASS1
                ssm_tile<false>(Z + (size_t)(b * TP + c * LCH) * NZ + g * SP, LCH, sr, si, BB, AT, C_re, C_im, Dssm, g, nullptr, lane);
#else
                ssm_chunk<false>(lds + wave * 16384, Z + (size_t)(b * TP + c * LCH) * NZ + g * SP, sr, si, T, nullptr, lane);
#endif
                float* e = SE + ((size_t)(b * SG + g) * NCH + c) * 128; e[lane] = sr; e[64 + lane] = si;
            }
        }
        for (int task = gw; task < BS * SG; task += NGW) {
            const int b = task % BS, g = task / BS;
            float sr = st_re[(size_t)(b * SG + g) * SN + lane], si = st_im[(size_t)(b * SG + g) * SN + lane];
            ssm_tile<true>(Z + (size_t)(NP + b * TS) * NZ + g * SP, TS, sr, si, BB, AT, C_re, C_im, Dssm, g, YG + (size_t)(NP + b * TS) * MIX, lane);
            out[O_SRS + (size_t)(b * SG + g) * SN + lane] = sr; out[O_SIS + (size_t)(b * SG + g) * SN + lane] = si;
        }
        {
            constexpr int RW = 9;
            const int c0 = lane * 8;
            float cw0[8], cw1[8], cw2[8], gn[8];
#pragma unroll
            for (int j = 0; j < 8; ++j) { cw0[j] = conv_w[c0 + j]; cw1[j] = conv_w[MIX + c0 + j]; cw2[j] = conv_w[2 * MIX + c0 + j]; gn[j] = norm_conv[c0 + j]; }
            const int r0 = gw * RW, r1 = (r0 + RW < MT) ? r0 + RW : MT;
            float p1[8], p2[8];
#pragma unroll
            for (int j = 0; j < 8; ++j) { p1[j] = 0.f; p2[j] = 0.f; }
            auto load_p = [&](int rr, float (&pp)[8]) { const bf16_t* zr = Z + (size_t)rr * NZ; const u32x4 xi = *(const u32x4*)(zr + MIX + c0), cgv = *(const u32x4*)(zr + 3 * MIX + c0);
                pp[0] = bf_lo(xi.x) * bf_lo(cgv.x); pp[1] = bf_hi(xi.x) * bf_hi(cgv.x); pp[2] = bf_lo(xi.y) * bf_lo(cgv.y); pp[3] = bf_hi(xi.y) * bf_hi(cgv.y);
                pp[4] = bf_lo(xi.z) * bf_lo(cgv.z); pp[5] = bf_hi(xi.z) * bf_hi(cgv.z); pp[6] = bf_lo(xi.w) * bf_lo(cgv.w); pp[7] = bf_hi(xi.w) * bf_hi(cgv.w); };
            if (r0 < MT) { if (r0 >= 1) load_p(r0 - 1, p1); if (r0 >= 2) load_p(r0 - 2, p2); }
            for (int r = r0; r < r1; ++r) {
                int b, t; const float* prev; float* cout; int T;
                if (r < NP) { b = r / TP; t = r % TP; prev = nullptr; cout = out + O_CP + (size_t)b * 2 * MIX; T = TP; }
                else { const int rs = r - NP; b = rs / TS; t = rs % TS; prev = st_conv + (size_t)b * 2 * MIX; cout = out + O_CS + (size_t)b * 2 * MIX; T = TS; }
                float p0[8]; load_p(r, p0);
                const u32x4 bgv = *(const u32x4*)(Z + (size_t)r * NZ + 2 * MIX + c0);
                const float bg[8] = {bf_lo(bgv.x), bf_hi(bgv.x), bf_lo(bgv.y), bf_hi(bgv.y), bf_lo(bgv.z), bf_hi(bgv.z), bf_lo(bgv.w), bf_hi(bgv.w)};
                float q1[8], q2[8];
                if (t < 2 && prev) { const float* pa = prev + (size_t)MIX + c0; const float* pb = prev + c0;
                    const f32x4 a0 = *(const f32x4*)pa, a1 = *(const f32x4*)(pa + 4), b0 = *(const f32x4*)pb, b1 = *(const f32x4*)(pb + 4);
#pragma unroll
                    for (int j = 0; j < 8; ++j) { const float s1 = j < 4 ? a0[j & 3] : a1[j & 3], s0 = j < 4 ? b0[j & 3] : b1[j & 3];
                        q1[j] = t >= 1 ? p1[j] : s1; q2[j] = t == 0 ? s0 : s1; } }
                else {
#pragma unroll
                    for (int j = 0; j < 8; ++j) { q1[j] = t >= 1 ? p1[j] : 0.f; q2[j] = t >= 2 ? p2[j] : 0.f; } }
                float y[8]; float ss = 0.f;
#pragma unroll
                for (int j = 0; j < 8; ++j) { y[j] = bg[j] * (cw0[j] * q2[j] + cw1[j] * q1[j] + cw2[j] * p0[j]); ss += y[j] * y[j]; }
                const float rstd = 1.0f / sqrtf(wave_sum(ss) * (1.0f / MIX) + EPS);
                u32x4 w; w.x = cvt_pk_bf16(y[0] * rstd * gn[0], y[1] * rstd * gn[1]); w.y = cvt_pk_bf16(y[2] * rstd * gn[2], y[3] * rstd * gn[3]);
                w.z = cvt_pk_bf16(y[4] * rstd * gn[4], y[5] * rstd * gn[5]); w.w = cvt_pk_bf16(y[6] * rstd * gn[6], y[7] * rstd * gn[7]);
                *(u32x4*)(MIXN + (size_t)r * D + MIX + c0) = w;
                if (t >= T - 2) { float* co = cout + (size_t)(t - (T - 2)) * MIX + c0; *(f32x4*)co = (f32x4){p0[0], p0[1], p0[2], p0[3]}; *(f32x4*)(co + 4) = (f32x4){p0[4], p0[5], p0[6], p0[7]}; }
#pragma unroll
                for (int j = 0; j < 8; ++j) { p2[j] = p1[j]; p1[j] = p0[j]; }
            }
        }
    }
    GSYNC();

    if (PH(4)) {
        const float* C_re = IN(16); const float* C_im = IN(17); const float* Dssm = IN(18);
        SsmTab T; int gcur = -1; float aLr = 0.f, aLi = 0.f;
        for (int task = gw; task < BP * SG * NCH; task += NGW) {
            const int c = task % NCH, g = (task / NCH) % SG, b = task / (NCH * SG);
            if (g != gcur) { ssm_load_tab(T, g, BTR, BTI, CT, AT, Dssm, lane, true); gcur = g; const f32x4 at = *(const f32x4*)(AT + (size_t)(g * SN + lane) * 4); aLr = at[2]; aLi = at[3]; }
            float sr = 0.f, si = 0.f;
            { const float* e = SE + ((size_t)(b * SG + g) * NCH) * 128;
              for (int cc = 0; cc < c; ++cc) { const float er = e[cc * 128 + lane], ei = e[cc * 128 + 64 + lane]; const float nr = aLr * sr - aLi * si + er, ni = aLr * si + aLi * sr + ei; sr = nr; si = ni; } }
#ifdef OLD_PASS2
            ssm_tile<true>(Z + (size_t)(b * TP + c * LCH) * NZ + g * SP, LCH, sr, si, BB, AT, C_re, C_im, Dssm, g, YG + (size_t)(b * TP + c * LCH) * MIX, lane);
#else
            ssm_chunk<true>(lds + wave * 16384, Z + (size_t)(b * TP + c * LCH) * NZ + g * SP, sr, si, T, YG + (size_t)(b * TP + c * LCH) * MIX + g * SP, lane);
            if (c == NCH - 1) { out[O_SRP + (size_t)(b * SG + g) * SN + lane] = sr; out[O_SIP + (size_t)(b * SG + g) * SN + lane] = si; }
#endif
        }
    }
    GSYNC();

    if (PH(5)) {
        const float* b_glu = IN(20);
        Sched2 S{G, bx, MT / 256, MIX / 256, 8, 0, 0, 4, 1, 0, (const char*)YG, (const char*)WGLU, nullptr, nullptr, (size_t)256 * MIX * 2, (size_t)256 * MIX * 2};
        EpiGlu E{YG, b_glu, YS};
        pg8::gemm_phase(lds, MIX, MIX, S, E);
    }
    GSYNC();

    if (PH(6)) {
        const float* norm_ssm = IN(22);
        for (int r = gw; r < MT; r += NGW) {
            const f32x4* yr = (const f32x4*)(YS + (size_t)r * MIX) + lane; const f32x4 a = yr[0], b = yr[64];
            const float ss = (a[0] * a[0] + a[1] * a[1]) + (a[2] * a[2] + a[3] * a[3]) + (b[0] * b[0] + b[1] * b[1]) + (b[2] * b[2] + b[3] * b[3]);
            const float rstd = 1.0f / sqrtf(wave_sum(ss) * (1.0f / MIX) + EPS);
            const f32x4 ga = ((const f32x4*)norm_ssm)[lane], gb = ((const f32x4*)norm_ssm)[lane + 64];
            u32x2 w0, w1; w0.x = cvt_pk_bf16(a[0] * rstd * ga[0], a[1] * rstd * ga[1]); w0.y = cvt_pk_bf16(a[2] * rstd * ga[2], a[3] * rstd * ga[3]);
            w1.x = cvt_pk_bf16(b[0] * rstd * gb[0], b[1] * rstd * gb[1]); w1.y = cvt_pk_bf16(b[2] * rstd * gb[2], b[3] * rstd * gb[3]);
            u32x2* o8 = (u32x2*)(MIXN + (size_t)r * D) + lane; o8[0] = w0; o8[64] = w1;
        }
    }
    GSYNC();

    if (PH(7)) {
        const float* x_prompt = IN(0);
        Sched2 S{G, bx, NP / 256, D / 256, 16, NS / 256, D / 256, 4, 4, NP / 256, (const char*)MIXN, (const char*)WOUT, (const char*)MIXN, (const char*)WOUT, (size_t)256 * D * 2, (size_t)256 * D * 2};
        EpiRes E{x_prompt, X, PART, 1, H, IN(25), SSQ};
        pg8::gemm_phase(lds, D, D, S, E);
    }
    GSYNC();

    if (PH(8)) for (int m = NP + gw; m < MT; m += NGW) { add_parts(X + (size_t)m * D, PART + (size_t)(m - NP) * D, 4, (size_t)NS * D, lane); rms_row_bf16(X + (size_t)m * D, IN(25), H + (size_t)m * D, lane); }
    GSYNC();

    if (PH(9)) {
        Sched2 S{G, bx, NP / 256, D / 256, 16, NS / 256, D / 256, 4, 4, NP / 256, (const char*)H, (const char*)WQ, (const char*)H, (const char*)WQ, (size_t)256 * D * 2, (size_t)256 * D * 2};
        EpiQ E{Q, PART, SSQ};
        pg8::gemm_phase(lds, D, D, S, E);
    }
    GSYNC();

    if (PH(10)) {
        const float* cache_k = IN(3); const float* cache_v = IN(4);
        struct SchedQK { int G, c; const char* Q; const char* KB;
            __device__ __forceinline__ bool next(int i, Unit& u) const { const int L = i * G + c; if (L >= 64 * NH) return false; pg8::order_map(L, 64, NH, u.pm, u.pn); u.kind = 0; u.nt = 4; u.ks = 0;
                u.A = Q + ((size_t)u.pm * 256 * D + (size_t)u.pn * HD) * 2; u.B = KB + ((size_t)(u.pm >> 3) * NMEM * D + (size_t)u.pn * HD) * 2; return true; } };
        SchedQK S{G, bx, (const char*)Q, (const char*)KB};
        EpiSoftmax E{PR, lds};
#ifndef NO_QK
        pg8::gemm_phase(lds, D, D, S, E);
#endif

        {
        struct SchedPV { int G, c; const char* PR; const char* VT;
            __device__ __forceinline__ bool next(int i, Unit& u) const { const int L = i * G + c; if (L >= 64 * NH) return false; pg8::order_map(L, 64, NH, u.pm, u.pn); u.kind = 0; u.nt = 4; u.ks = 0;
                u.A = PR + (size_t)(u.pm * NH + u.pn) * 256 * 256 * 2; u.B = VT + (size_t)((u.pm >> 3) * NH + u.pn) * HD * NMEM * 2; return true; } };
        SchedPV S{G, bx, (const char*)PR, (const char*)VT};
        EpiBf E{O, D, 1.0f, nullptr};
        pg8::gemm_phase(lds, NMEM, NMEM, S, E);
        }
#ifndef NO_SATT
        LAS float* sc = (LAS float*)lds;
        LAS float* pr = (LAS float*)(lds + 4096);
        LAS float* po = (LAS float*)(lds + 8192);
        for (int unit = bx; unit < BS * NH; unit += G) {
            const int b = unit / NH, h = unit % NH;
            float q[4][4];
#pragma unroll
            for (int qi = 0; qi < 4; ++qi) { const float* qp = PART + (size_t)(b * TS + qi) * D + h * HD + 4 * lane; const f32x4 w = (*(const f32x4*)qp + *(const f32x4*)(qp + (size_t)NS * D)) + (*(const f32x4*)(qp + (size_t)2 * NS * D) + *(const f32x4*)(qp + (size_t)3 * NS * D)); q[qi][0] = w[0]; q[qi][1] = w[1]; q[qi][2] = w[2]; q[qi][3] = w[3]; }
            const float* kbase = cache_k + ((size_t)(b * NMEM) * NH + h) * HD + 4 * lane;
            const float* vbase = cache_v + ((size_t)(b * NMEM) * NH + h) * HD + 4 * lane;
#pragma unroll 1
            for (int blk = 0; blk < 2; ++blk) {
                const int key0 = wave * 32 + blk * 16;
                float v[64];
#pragma unroll
                for (int k = 0; k < 16; ++k) { const f32x4 kv = *(const f32x4*)(kbase + (size_t)(key0 + k) * NH * HD);
#pragma unroll
                    for (int qi = 0; qi < 4; ++qi) v[k * 4 + qi] = (kv[0] * q[qi][0] + kv[1] * q[qi][1]) + (kv[2] * q[qi][2] + kv[3] * q[qi][3]); }
                const float s = treduce64(v, lane);
                sc[(lane & 3) * 256 + key0 + (lane >> 2)] = s;
            }
            __syncthreads();
            {
                const int qi = lane & 3, kb = lane >> 2; float sv[16]; float mx = -3.0e38f;
#pragma unroll
                for (int j = 0; j < 16; ++j) { sv[j] = sc[qi * 256 + kb + 16 * j]; mx = fmaxf(mx, sv[j]); }
                mx = fmaxf(mx, __shfl_xor(mx, 4)); mx = fmaxf(mx, __shfl_xor(mx, 8)); mx = fmaxf(mx, __shfl_xor(mx, 16)); mx = fmaxf(mx, __shfl_xor(mx, 32));
                float sum = 0.f;
#pragma unroll
                for (int j = 0; j < 16; ++j) { sv[j] = fast_exp(sv[j] - mx); sum += sv[j]; }
                sum += __shfl_xor(sum, 4); sum += __shfl_xor(sum, 8); sum += __shfl_xor(sum, 16); sum += __shfl_xor(sum, 32);
                const float inv = 1.0f / sum;
                if (wave == 0) {
#pragma unroll
                    for (int j = 0; j < 16; ++j) pr[qi * 256 + kb + 16 * j] = sv[j] * inv; }
            }
            __syncthreads();
            {
                float o[4][4];
#pragma unroll
                for (int qi = 0; qi < 4; ++qi) { o[qi][0] = 0.f; o[qi][1] = 0.f; o[qi][2] = 0.f; o[qi][3] = 0.f; }
#pragma unroll 8
                for (int k = 0; k < 32; ++k) { const int key = wave * 32 + k; const f32x4 vv = *(const f32x4*)(vbase + (size_t)key * NH * HD);
#pragma unroll
                    for (int qi = 0; qi < 4; ++qi) { const float pp = pr[qi * 256 + key]; o[qi][0] = fmaf(pp, vv[0], o[qi][0]); o[qi][1] = fmaf(pp, vv[1], o[qi][1]); o[qi][2] = fmaf(pp, vv[2], o[qi][2]); o[qi][3] = fmaf(pp, vv[3], o[qi][3]); } }
#pragma unroll
                for (int qi = 0; qi < 4; ++qi) *(LAS f32x4*)(po + (wave * 4 + qi) * 256 + 4 * lane) = (f32x4){o[qi][0], o[qi][1], o[qi][2], o[qi][3]};
            }
            __syncthreads();
            {
                const int idx = tid * 2, qi = idx >> 8, d = idx & 255; float a0 = 0.f, a1 = 0.f;
#pragma unroll
                for (int w = 0; w < 8; ++w) { const f32x2 t2 = *(LAS f32x2*)(po + (w * 4 + qi) * 256 + d); a0 += t2[0]; a1 += t2[1]; }
                *(unsigned*)(O + (size_t)(NP + b * TS + qi) * D + h * HD + d) = cvt_pk_bf16(a0, a1);
            }
        }
#endif
    }
    GSYNC();

    if (PH(12)) {
        Sched2 S{G, bx, NP / 256, D / 256, 16, NS / 256, D / 256, 4, 4, NP / 256, (const char*)O, (const char*)WXO, (const char*)O, (const char*)WXO, (size_t)256 * D * 2, (size_t)256 * D * 2};
        EpiRes E{nullptr, X, PART, 0, H, IN(31), SSQ + NP};
        pg8::gemm_phase(lds, D, D, S, E);
    }
    GSYNC();

    if (PH(13)) for (int m = NP + gw; m < MT; m += NGW) { add_parts(X + (size_t)m * D, PART + (size_t)(m - NP) * D, 4, (size_t)NS * D, lane); rms_row_bf16(X + (size_t)m * D, IN(31), H + (size_t)m * D, lane); }
    GSYNC();

    if (PH(14)) {
        Sched2 S{G, bx, MT / 256, NUG / 256, 16, 0, 0, 4, 1, 0, (const char*)H, (const char*)WUG, nullptr, nullptr, (size_t)256 * D * 2, (size_t)256 * D * 2};
        EpiFfn E{ACT, H, WUG, IN(34), IN(8), out + O_FP, out + O_FS, SSQ + NP, lds};
        pg8::gemm_phase(lds, D, D, S, E);
    }
    GSYNC();

    if (PH(16)) {
        Sched2 S{G, bx, NP / 256, D / 256, DFF / 64, NS / 256, D / 256, 4, DFF / 256, NP / 256, (const char*)ACT, (const char*)WDN, (const char*)ACT, (const char*)WDN, (size_t)256 * DFF * 2, (size_t)256 * DFF * 2};
        EpiRes E{nullptr, X, PART, 0, nullptr, nullptr, nullptr};
        pg8::gemm_phase(lds, DFF, DFF, S, E);
    }
    GSYNC();

    if (PH(17)) for (int m = gw; m < MT; m += NGW) { if (m >= NP) add_parts(X + (size_t)m * D, PART + (size_t)(m - NP) * D, DFF / 256, (size_t)NS * D, lane); rms_row_f32(X + (size_t)m * D, IN(36), out + (size_t)m * D, lane); }
}

extern "C" void kernel_launch(void* const* d_in, const int* in_sizes, int n_in, void* d_out, int out_size, void* d_ws, size_t ws_size, hipStream_t stream) {
    static int grid = 0;
    if (grid == 0) {
        if (n_in != 37 || (size_t)out_size != O_END || ws_size < WS_END) { fprintf(stderr, "kernel_launch: unexpected sizes n_in %d out %d ws %zu\n", n_in, out_size, ws_size); grid = -1; return; }
        int dev = 0, cus = 0, per_cu = 0;
        (void)hipGetDevice(&dev); (void)hipDeviceGetAttribute(&cus, hipDeviceAttributeMultiprocessorCount, dev);
        (void)hipFuncSetAttribute((const void*)hymba_fwd, hipFuncAttributeMaxDynamicSharedMemorySize, LDS_BYTES);
        (void)hipOccupancyMaxActiveBlocksPerMultiprocessor(&per_cu, (const void*)hymba_fwd, NTHREADS, LDS_BYTES);
        if (per_cu < 1) { fprintf(stderr, "kernel_launch: occupancy query reports %d blocks per CU\n", per_cu); per_cu = 1; }
        (void)hipGetLastError();
        grid = cus;
        if (grid % 8) grid -= grid % 8;
    }
    if (grid < 0) return;
    Args a{};
    for (int i = 0; i < 37; ++i) a.in[i] = (const float*)d_in[i];
    a.out = (float*)d_out; a.ws = (unsigned char*)d_ws;
    void* kargs[] = {&a};
    hipError_t e = hipLaunchCooperativeKernel((const void*)hymba_fwd, dim3(grid), dim3(NTHREADS), kargs, LDS_BYTES, stream);
    if (e != hipSuccess) fprintf(stderr, "cooperative launch failed: %s (grid %d)\n", hipGetErrorString(e), grid);
}
```

```cpp
#include <hip/hip_runtime.h>
#include <hip/hip_cooperative_groups.h>
#include <cstdio>
#include <cstdint>
namespace cg = cooperative_groups;

#define LAS __attribute__((address_space(3)))
typedef unsigned short bf16_t;
typedef short bf16x8 __attribute__((ext_vector_type(8)));
typedef float f32x4 __attribute__((ext_vector_type(4)));
typedef float f32x2 __attribute__((ext_vector_type(2)));
typedef unsigned u32x4 __attribute__((ext_vector_type(4)));
typedef unsigned u32x2 __attribute__((ext_vector_type(2)));

constexpr int D = 1024, NP = 16384, NS = 512, MT = NP + NS;
constexpr int TP = 2048, TS = 4, BP = 8, BS = 128;
constexpr int NZ = 2048, MIX = 512, DFF = 2816, NUG = 2 * DFF;
constexpr int SG = 32, SP = 16, SN = 64, LCH = 64, NCH = TP / LCH;
constexpr int NMEM = 256, NH = 4, HD = 256;
constexpr float EPS = 1e-6f;
constexpr int NWAVES = 8, NTHREADS = 512;

constexpr size_t MiB = 1u << 20;
constexpr size_t WS_WIN = 0;
constexpr size_t WS_WKV = WS_WIN + 4 * MiB;
constexpr size_t WS_WGLU = WS_WKV + 4 * MiB;
constexpr size_t WS_WOUT = WS_WGLU + 1 * MiB;
constexpr size_t WS_WQ = WS_WOUT + 2 * MiB;
constexpr size_t WS_WXO = WS_WQ + 2 * MiB;
constexpr size_t WS_WUG = WS_WXO + 2 * MiB;
constexpr size_t WS_WDN = WS_WUG + 11 * MiB;
constexpr size_t WS_H = WS_WDN + 6 * MiB;
constexpr size_t WS_X = WS_H + 33 * MiB;
constexpr size_t WS_OV = WS_X + 66 * MiB;
constexpr size_t WS_Z = WS_OV;
constexpr size_t WS_YG = WS_Z + 66 * MiB;
constexpr size_t WS_YS = WS_YG + 17 * MiB;
constexpr size_t WS_MIXN = WS_YS + 33 * MiB;
constexpr size_t WS_Q = WS_MIXN + 33 * MiB;
constexpr size_t WS_PR = WS_Q + 33 * MiB;
constexpr size_t WS_O = WS_PR + 32 * MiB;
constexpr size_t WS_MN = WS_O + 33 * MiB;
constexpr size_t WS_KB = WS_MN + 4 * MiB;
constexpr size_t WS_VT = WS_KB + 4 * MiB;
constexpr size_t WS_SE = WS_VT + 4 * MiB;
constexpr size_t WS_SI = WS_SE + 4 * MiB;
constexpr size_t WS_BB = WS_SI + 4 * MiB;
constexpr size_t WS_AT = WS_BB + 1 * MiB;
constexpr size_t WS_BTR = WS_AT + 1 * MiB;
constexpr size_t WS_BTI = WS_BTR + 65536;
constexpr size_t WS_CT = WS_BTI + 65536;
constexpr size_t WS_OV_END1 = WS_CT + 131072;
constexpr size_t WS_UG = WS_OV;
constexpr size_t WS_ACT = WS_UG + 182 * MiB;
constexpr size_t WS_CTL = WS_ACT + 91 * MiB;
constexpr size_t WS_PART = WS_CTL + 1 * MiB;
constexpr size_t WS_SSQ = WS_PART + 22 * MiB;
constexpr size_t WS_END = WS_SSQ + 1 * MiB;
static_assert(WS_OV_END1 <= WS_CTL, "overlay");
static_assert(WS_END <= 512 * MiB, "workspace");

constexpr size_t O_YP = 0;
constexpr size_t O_YS = O_YP + (size_t)NP * D;
constexpr size_t O_MK = O_YS + (size_t)NS * D;
constexpr size_t O_MV = O_MK + (size_t)BP * NMEM * D;
constexpr size_t O_SRP = O_MV + (size_t)BP * NMEM * D;
constexpr size_t O_SIP = O_SRP + (size_t)BP * SG * SN;
constexpr size_t O_CP = O_SIP + (size_t)BP * SG * SN;
constexpr size_t O_FP = O_CP + (size_t)BP * 2 * MIX;
constexpr size_t O_SRS = O_FP + (size_t)BP * 2 * DFF;
constexpr size_t O_SIS = O_SRS + (size_t)BS * SG * SN;
constexpr size_t O_CS = O_SIS + (size_t)BS * SG * SN;
constexpr size_t O_FS = O_CS + (size_t)BS * 2 * MIX;
constexpr size_t O_END = O_FS + (size_t)BS * 2 * DFF;

constexpr int RING_BYTES = 131072, XCH_OFF = RING_BYTES, LDS_BYTES = 147456;

typedef __bf16 bf16x2_t __attribute__((ext_vector_type(2)));
__device__ __forceinline__ unsigned cvt_pk_bf16(float lo, float hi) { const f32x2 v = {lo, hi}; const bf16x2_t b = __builtin_convertvector(v, bf16x2_t); return __builtin_bit_cast(unsigned, b); }
__device__ __forceinline__ float bf_lo(unsigned w) { return __uint_as_float(w << 16); }
__device__ __forceinline__ float bf_hi(unsigned w) { return __uint_as_float(w & 0xffff0000u); }
__device__ __forceinline__ float wave_sum(float v) {
#pragma unroll
    for (int o = 1; o < 64; o <<= 1) v += __shfl_xor(v, o);
    return v;
}
__device__ __forceinline__ float fast_exp(float x) { return __builtin_amdgcn_exp2f(x * 1.4426950408889634f); }
__device__ __forceinline__ float gelu_tanh(float x) {
    const float z = 0.7978845608028654f * (x + 0.044715f * x * x * x);
    return x * __builtin_amdgcn_rcpf(1.0f + fast_exp(-2.0f * z));
}
__device__ __forceinline__ float sigmoidf(float a) { return __builtin_amdgcn_rcpf(1.0f + fast_exp(-a)); }

namespace pg8 {
constexpr int BM = 256, BK = 64, HALF = 128, HTB = HALF * BK * 2;
__host__ __device__ __forceinline__ int lds_byte(int r, int c) { const int st = (r >> 4) * 2 + (c >> 5), rr = r & 15, cc = c & 31, ob = rr * 64 + cc * 2; return st * 1024 + (ob ^ (((ob >> 9) & 1) << 5)); }
__host__ __device__ __forceinline__ void stage_rc(int b, int& R, int& C) { const int st = b / 1024, sb = b % 1024, swz = sb ^ (((sb >> 9) & 1) << 5); R = (st >> 1) * 16 + swz / 64; C = (st & 1) * 32 + (swz % 64) / 2; }
__host__ __device__ __forceinline__ int perm32(int rho) { const int n = rho >> 4, i = rho & 15; return 8 * (i >> 2) + 4 * n + (i & 3); }

struct Unit { int pm, pn, kind, nt, ks; const char* A; const char* B; };

__device__ __forceinline__ void order_map(int L, int nM, int nN, int& pm, int& pn) {
    const int nwg = nM * nN; int wgid = L;
    { const int q = nwg / 8, r = nwg % 8, xcd = wgid % 8, off = wgid / 8; wgid = (xcd < r ? xcd * (q + 1) : r * (q + 1) + (xcd - r) * q) + off; }
    const int nig = 8 * nN, gid = wgid / nig, fm = gid * 8, gsz = (nM - fm) < 8 ? (nM - fm) : 8;
    pm = fm + ((wgid % nig) % gsz); pn = (wgid % nig) / gsz;
}

template <class Epi, class Sched>
__device__ __forceinline__ void gemm_phase(LAS unsigned char* lds, const int lda, const int ldb, const Sched& S, Epi& E) {
    int tid_l = threadIdx.x; asm volatile("" : "+v"(tid_l));
    const int tid = tid_l, wid = __builtin_amdgcn_readfirstlane(tid >> 6), lane = tid & 63, wr = wid >> 2, wc = wid & 3, fr = lane & 15, fq = lane >> 4;
    unsigned voffA[2], voffB[2];
#pragma unroll
    for (int i = 0; i < 2; ++i) { int R, C; stage_rc(tid * 16 + i * 8192, R, C); const int Rb = (R & ~31) + perm32(R & 31);
        voffA[i] = (unsigned)(R * lda + C) * 2u; voffB[i] = (unsigned)(Rb * ldb + C) * 2u; }
    const size_t kstep = (size_t)(BK * 2);
    const size_t hstepA = (size_t)HALF * lda * 2, hstepB = (size_t)HALF * ldb * 2;
    const unsigned ldsw = (unsigned)wid * 1024u;
    const int aoff = lds_byte(wr * 64 + fr, fq * 8), boff = lds_byte(wc * 32 + fr, fq * 8);
#define PG8_SA(b, h) (((b) * 2 + (h)) * HTB)
#define PG8_SB(b, h) ((4 + (b) * 2 + (h)) * HTB)
#define PG8_STAGE(bufoff, gbase, voff) do { _Pragma("unroll") for (int _i = 0; _i < 2; ++_i) \
        __builtin_amdgcn_global_load_lds((const unsigned*)((const char*)(gbase) + (voff)[_i]), (LAS unsigned*)(lds + (bufoff) + ldsw + _i * 8192), 16, 0, 0); } while (0)
#define PG8_LDA(dst, b, h) do { _Pragma("unroll") for (int m = 0; m < 4; ++m) _Pragma("unroll") for (int k = 0; k < 2; ++k) dst[m][k] = *(const LAS bf16x8*)(lds + PG8_SA(b, h) + aoff + m * 2048 + k * 1024); } while (0)
#define PG8_LDB(dst, b, h) do { _Pragma("unroll") for (int n = 0; n < 2; ++n) _Pragma("unroll") for (int k = 0; k < 2; ++k) dst[n][k] = *(const LAS bf16x8*)(lds + PG8_SB(b, h) + boff + n * 2048 + k * 1024); } while (0)
#define PG8_MMA(ai, bj, At, Bt) do { __builtin_amdgcn_s_setprio(1); _Pragma("unroll") for (int m = 0; m < 4; ++m) _Pragma("unroll") for (int n = 0; n < 2; ++n) _Pragma("unroll") for (int k = 0; k < 2; ++k) \
        acc[ai][bj][m][n] = __builtin_amdgcn_mfma_f32_16x16x32_bf16(Bt[n][k], At[m][k], acc[ai][bj][m][n], 0, 0, 0); __builtin_amdgcn_s_setprio(0); } while (0)
#define PG8_WAIT_V(n) asm volatile("s_waitcnt vmcnt(" #n ")" ::: "memory")
#define PG8_WAIT_L(n) asm volatile("s_waitcnt lgkmcnt(" #n ")" ::: "memory")
#define PG8_BAR __builtin_amdgcn_s_barrier()
#define PG8_SCHED __builtin_amdgcn_sched_barrier(0)
    Unit cur, nxt; int ui = 0;
    if (!S.next(0, cur)) return;
    f32x4 acc[2][2][4][2];
#pragma unroll
    for (int a = 0; a < 2; ++a)
#pragma unroll
        for (int b = 0; b < 2; ++b)
#pragma unroll
            for (int m = 0; m < 4; ++m)
#pragma unroll
                for (int n = 0; n < 2; ++n) acc[a][b][m][n] = (f32x4){0.f, 0.f, 0.f, 0.f};
    bf16x8 At[4][2], B0[2][2], B1[2][2];
    const char* cA = cur.A; const char* cB = cur.B;
    PG8_STAGE(PG8_SB(0, 0), cB, voffB); PG8_STAGE(PG8_SB(0, 1), cB + hstepB, voffB); PG8_STAGE(PG8_SA(0, 0), cA, voffA); PG8_STAGE(PG8_SA(0, 1), cA + hstepA, voffA);
    if (wr == 1) PG8_BAR;
    PG8_WAIT_V(2); PG8_BAR;
    PG8_STAGE(PG8_SB(1, 0), cB + kstep, voffB); PG8_STAGE(PG8_SA(1, 0), cA + kstep, voffA); PG8_STAGE(PG8_SB(1, 1), cB + hstepB + kstep, voffB);
    PG8_WAIT_V(6); PG8_BAR;
    for (;;) {
        const bool has_next = S.next(ui + 1, nxt);
        const char* nA = has_next ? nxt.A : cA; const char* nB = has_next ? nxt.B : cB;
        const int nt = cur.nt;
        int t = 0;
#pragma unroll 1
        for (int pass = 0; pass < (Epi::HAS_MID ? 2 : 1); ++pass) {
        const bool do_mid = Epi::HAS_MID && pass == 0 && cur.kind == 0;
        const int te = do_mid ? 8 : nt;
#pragma unroll 1
        for (; t < te; t += 2) {
            const bool last = (t == nt - 2);
            const char* a1 = cA + (size_t)(t + 1) * kstep;
            const char* a2 = last ? nA : cA + (size_t)(t + 2) * kstep; const char* b2 = last ? nB : cB + (size_t)(t + 2) * kstep;
            const char* a3 = a2 + kstep; const char* b3 = b2 + kstep;
            PG8_LDB(B0, 0, 0); PG8_LDB(B1, 0, 1); PG8_SCHED; PG8_LDA(At, 0, 0); PG8_STAGE(PG8_SA(1, 1), a1 + hstepA, voffA);
            PG8_WAIT_V(8); PG8_WAIT_L(0); PG8_BAR; PG8_MMA(0, 0, At, B0); PG8_MMA(0, 1, At, B1); PG8_BAR; PG8_SCHED;
            PG8_LDA(At, 0, 1); PG8_STAGE(PG8_SB(0, 0), b2, voffB); PG8_STAGE(PG8_SB(0, 1), b2 + hstepB, voffB); PG8_STAGE(PG8_SA(0, 0), a2, voffA);
            PG8_WAIT_V(8); PG8_WAIT_L(0); PG8_BAR; PG8_MMA(1, 0, At, B0); PG8_MMA(1, 1, At, B1); PG8_BAR; PG8_SCHED;
            PG8_LDB(B0, 1, 0); PG8_LDB(B1, 1, 1); PG8_SCHED; PG8_LDA(At, 1, 0); PG8_STAGE(PG8_SA(0, 1), a2 + hstepA, voffA);
            PG8_WAIT_V(8); PG8_WAIT_L(0); PG8_BAR; PG8_MMA(0, 0, At, B0); PG8_MMA(0, 1, At, B1); PG8_BAR; PG8_SCHED;
            PG8_LDA(At, 1, 1); PG8_STAGE(PG8_SB(1, 0), b3, voffB); PG8_STAGE(PG8_SB(1, 1), b3 + hstepB, voffB); PG8_STAGE(PG8_SA(1, 0), a3, voffA);
            PG8_WAIT_V(8); PG8_WAIT_L(0); PG8_BAR; PG8_MMA(1, 0, At, B0); PG8_MMA(1, 1, At, B1); PG8_BAR; PG8_SCHED;
        }
        if constexpr (Epi::HAS_MID) { if (do_mid) E.mid(acc, cur, wr, fr); }
        }
        if (wr == 0) PG8_BAR;
        E(acc, cur, wr, wc, fr, fq);
        if (!has_next) break;
#pragma unroll
        for (int a = 0; a < 2; ++a)
#pragma unroll
            for (int b = 0; b < 2; ++b)
#pragma unroll
                for (int m = 0; m < 4; ++m)
#pragma unroll
                    for (int n = 0; n < 2; ++n) acc[a][b][m][n] = (f32x4){0.f, 0.f, 0.f, 0.f};
        cur = nxt; cA = nA; cB = nB; ++ui;
        if (wr == 1) PG8_BAR;
    }
    PG8_WAIT_V(0);
    PG8_BAR;
#undef PG8_SA
#undef PG8_SB
#undef PG8_STAGE
#undef PG8_LDA
#undef PG8_LDB
#undef PG8_MMA
#undef PG8_WAIT_V
#undef PG8_WAIT_L
#undef PG8_BAR
#undef PG8_SCHED
}
}
using pg8::Unit;
typedef f32x4 Acc[2][2][4][2];

struct Sched2 {
    int G, c; int nM0, nN0, nt0, nM1, nN1, nt1, ks1, pm1;
    const char* A0; const char* B0; const char* A1; const char* B1; size_t a_pm, b_pn;
    __device__ __forceinline__ bool next(int i, Unit& u) const {
        const int L = i * G + c, n0 = nM0 * nN0, n1 = nM1 * nN1 * ks1;
        if (L >= n0 + n1) return false;
        if (L < n0) { pg8::order_map(L, nM0, nN0, u.pm, u.pn); u.kind = 0; u.nt = nt0; u.ks = 0; u.A = A0 + (size_t)u.pm * a_pm; u.B = B0 + (size_t)u.pn * b_pn; }
        else { const int j = L - n0, ks = j % ks1, t = j / ks1; u.pm = pm1 + t % nM1; u.pn = t / nM1; u.kind = 1; u.nt = nt1; u.ks = ks;
               u.A = A1 + (size_t)u.pm * a_pm + (size_t)ks * nt1 * 128; u.B = B1 + (size_t)u.pn * b_pn + (size_t)ks * nt1 * 128; }
        return true;
    }
};

#define EPI_ROWS(...) _Pragma("unroll") for (int ai = 0; ai < 2; ++ai) _Pragma("unroll") for (int m = 0; m < 4; ++m) { const int row = u.pm * 256 + ai * 128 + wr * 64 + m * 16 + fr; \
    _Pragma("unroll") for (int bj = 0; bj < 2; ++bj) { const int col = u.pn * 256 + bj * 128 + wc * 32 + fq * 8; const f32x4 v0 = acc[ai][bj][m][0], v1 = acc[ai][bj][m][1]; __VA_ARGS__ } }

__device__ __forceinline__ u32x4 pack8(f32x4 v0, f32x4 v1) { u32x4 w; w.x = cvt_pk_bf16(v0[0], v0[1]); w.y = cvt_pk_bf16(v0[2], v0[3]); w.z = cvt_pk_bf16(v1[0], v1[1]); w.w = cvt_pk_bf16(v1[2], v1[3]); return w; }

struct EpiP1 {
    static constexpr bool HAS_MID = false;
    bf16_t* Z; float* outK; float* outV; bf16_t* KB; bf16_t* VT;
    __device__ __forceinline__ void operator()(Acc& acc, const Unit& u, int wr, int wc, int fr, int fq) const {
        if (u.kind == 0) {
            EPI_ROWS( *(u32x4*)(Z + (size_t)row * NZ + col) = pack8(v0, v1); )
        } else if (u.pn < 4) {
            EPI_ROWS( float* o = outK + (size_t)row * D + col; *(f32x4*)o = v0; *(f32x4*)(o + 4) = v1; *(u32x4*)(KB + (size_t)row * D + col) = pack8(v0, v1); )
        } else {
            EPI_ROWS( const int vc = col - 1024; float* o = outV + (size_t)row * D + vc; *(f32x4*)o = v0; *(f32x4*)(o + 4) = v1;
                      const int h = vc >> 8, d0 = vc & 255, key = row & 255; bf16_t* vt = VT + ((size_t)(u.pm * NH + h) * HD + d0) * NMEM + key;
                      const u32x4 w = pack8(v0, v1);
                      vt[0 * NMEM] = (bf16_t)(w.x & 0xffff); vt[1 * NMEM] = (bf16_t)(w.x >> 16); vt[2 * NMEM] = (bf16_t)(w.y & 0xffff); vt[3 * NMEM] = (bf16_t)(w.y >> 16);
                      vt[4 * NMEM] = (bf16_t)(w.z & 0xffff); vt[5 * NMEM] = (bf16_t)(w.z >> 16); vt[6 * NMEM] = (bf16_t)(w.w & 0xffff); vt[7 * NMEM] = (bf16_t)(w.w >> 16); )
        }
    }
};
struct EpiGlu {
    static constexpr bool HAS_MID = false;
    const bf16_t* YG; const float* bias; const float* g; bf16_t* MIXN; float* ssq;
    __device__ __forceinline__ void operator()(Acc& acc, const Unit& u, int wr, int wc, int fr, int fq) const {
        f32x4 bv[2][2], gv[2][2];
#pragma unroll
        for (int bj = 0; bj < 2; ++bj) { const int col = u.pn * 256 + bj * 128 + wc * 32 + fq * 8; bv[bj][0] = *(const f32x4*)(bias + col); bv[bj][1] = *(const f32x4*)(bias + col + 4); gv[bj][0] = *(const f32x4*)(g + col); gv[bj][1] = *(const f32x4*)(g + col + 4); }
#pragma unroll
        for (int ai = 0; ai < 2; ++ai)
#pragma unroll
            for (int m = 0; m < 4; ++m) { const int row = u.pm * 256 + ai * 128 + wr * 64 + m * 16 + fr; float ss = 0.f;
#pragma unroll
                for (int bj = 0; bj < 2; ++bj) { const int col = u.pn * 256 + bj * 128 + wc * 32 + fq * 8;
                    const u32x4 yw = *(const u32x4*)(YG + (size_t)row * MIX + col); const f32x4 v0 = acc[ai][bj][m][0] + bv[bj][0], v1 = acc[ai][bj][m][1] + bv[bj][1];
                    f32x4 o0, o1;
                    o0[0] = bf_lo(yw.x) * sigmoidf(v0[0]); o0[1] = bf_hi(yw.x) * sigmoidf(v0[1]); o0[2] = bf_lo(yw.y) * sigmoidf(v0[2]); o0[3] = bf_hi(yw.y) * sigmoidf(v0[3]);
                    o1[0] = bf_lo(yw.z) * sigmoidf(v1[0]); o1[1] = bf_hi(yw.z) * sigmoidf(v1[1]); o1[2] = bf_lo(yw.w) * sigmoidf(v1[2]); o1[3] = bf_hi(yw.w) * sigmoidf(v1[3]);
                    ss += (o0[0] * o0[0] + o0[1] * o0[1]) + (o0[2] * o0[2] + o0[3] * o0[3]) + (o1[0] * o1[0] + o1[1] * o1[1]) + (o1[2] * o1[2] + o1[3] * o1[3]);
                    *(u32x4*)(MIXN + (size_t)row * D + col) = pack8(o0 * gv[bj][0], o1 * gv[bj][1]); }
                ss += __shfl_xor(ss, 16); ss += __shfl_xor(ss, 32); if (fq == 0) unsafeAtomicAdd(ssq + row, ss);
                asm volatile("" ::: "memory"); }
    }
};
template <bool MID> struct EpiRes {
    static constexpr bool HAS_MID = MID;
    const float* xp; float* X; float* PART; int first; bf16_t* Hn; const float* g; float* ssq; const float* ssqg;
    __device__ __forceinline__ void mid(Acc& acc, const Unit& u, int wr, int fr) const {
#pragma unroll
        for (int ai = 0; ai < 2; ++ai)
#pragma unroll
            for (int m = 0; m < 4; ++m) { const int row = u.pm * 256 + ai * 128 + wr * 64 + m * 16 + fr; const float rs = 1.0f / sqrtf(ssqg[row] * (1.0f / MIX) + EPS);
#pragma unroll
                for (int bj = 0; bj < 2; ++bj) { acc[ai][bj][m][0] *= rs; acc[ai][bj][m][1] *= rs; }
                asm volatile("" ::: "memory"); }
    }
    __device__ __forceinline__ void operator()(Acc& acc, const Unit& u, int wr, int wc, int fr, int fq) const {
        if (u.kind == 0) {
#pragma unroll
            for (int ai = 0; ai < 2; ++ai)
#pragma unroll
                for (int m = 0; m < 4; ++m) { const int row = u.pm * 256 + ai * 128 + wr * 64 + m * 16 + fr; float ss = 0.f;
#pragma unroll
                    for (int bj = 0; bj < 2; ++bj) { const int col = u.pn * 256 + bj * 128 + wc * 32 + fq * 8;
                        const float* b = first ? xp + (size_t)row * D : (const float*)(X + (size_t)row * D);
                        const f32x4 r0 = *(const f32x4*)(b + col) + acc[ai][bj][m][0], r1 = *(const f32x4*)(b + col + 4) + acc[ai][bj][m][1];
                        float* o = X + (size_t)row * D + col; *(f32x4*)o = r0; *(f32x4*)(o + 4) = r1;
                        if (Hn) { const f32x4 g0 = *(const f32x4*)(g + col), g1 = *(const f32x4*)(g + col + 4); *(u32x4*)(Hn + (size_t)row * D + col) = pack8(r0 * g0, r1 * g1);
                            ss += (r0[0] * r0[0] + r0[1] * r0[1]) + (r0[2] * r0[2] + r0[3] * r0[3]) + (r1[0] * r1[0] + r1[1] * r1[1]) + (r1[2] * r1[2] + r1[3] * r1[3]); } }
                    if (Hn) { ss += __shfl_xor(ss, 16); ss += __shfl_xor(ss, 32); if (fq == 0) unsafeAtomicAdd(ssq + row, ss); }
                    asm volatile("" ::: "memory"); }
        } else {
#pragma unroll
            for (int ai = 0; ai < 2; ++ai)
#pragma unroll
                for (int m = 0; m < 4; ++m) { const int row = u.pm * 256 + ai * 128 + wr * 64 + m * 16 + fr;
                    float rs = 1.0f; if (MID) { if (u.ks < 2) rs = 1.0f / sqrtf(ssqg[row] * (1.0f / MIX) + EPS); }
#pragma unroll
                    for (int bj = 0; bj < 2; ++bj) { const int col = u.pn * 256 + bj * 128 + wc * 32 + fq * 8;
                        float* o = PART + ((size_t)u.ks * NS + (row - NP)) * D + col; *(f32x4*)o = acc[ai][bj][m][0] * rs; *(f32x4*)(o + 4) = acc[ai][bj][m][1] * rs; } }
        }
    }
};
struct EpiQ {
    static constexpr bool HAS_MID = false;
    bf16_t* Q; float* PART; const float* ssq;
    __device__ __forceinline__ void operator()(Acc& acc, const Unit& u, int wr, int wc, int fr, int fq) const {
        if (u.kind == 0) {
#pragma unroll
            for (int ai = 0; ai < 2; ++ai)
#pragma unroll
                for (int m = 0; m < 4; ++m) { const int row = u.pm * 256 + ai * 128 + wr * 64 + m * 16 + fr; const float sc = 0.0625f / sqrtf(ssq[row] * (1.0f / D) + EPS);
#pragma unroll
                    for (int bj = 0; bj < 2; ++bj) { const int col = u.pn * 256 + bj * 128 + wc * 32 + fq * 8; *(u32x4*)(Q + (size_t)row * D + col) = pack8(acc[ai][bj][m][0] * sc, acc[ai][bj][m][1] * sc); } }
        } else {
            EPI_ROWS( float* o = PART + ((size_t)u.ks * NS + (row - NP)) * D + col; *(f32x4*)o = v0 * 0.0625f; *(f32x4*)(o + 4) = v1 * 0.0625f; )
        }
    }
};
struct EpiBf {
    static constexpr bool HAS_MID = false;
    bf16_t* O; int ld; float scale; const float* ssq;
    __device__ __forceinline__ void operator()(Acc& acc, const Unit& u, int wr, int wc, int fr, int fq) const {
#pragma unroll
        for (int ai = 0; ai < 2; ++ai)
#pragma unroll
            for (int m = 0; m < 4; ++m) { const int row = u.pm * 256 + ai * 128 + wr * 64 + m * 16 + fr;
                const float sc = (ssq && row < NP) ? scale / sqrtf(ssq[row] * (1.0f / D) + EPS) : scale;
#pragma unroll
                for (int bj = 0; bj < 2; ++bj) { const int col = u.pn * 256 + bj * 128 + wc * 32 + fq * 8; *(u32x4*)(O + (size_t)row * ld + col) = pack8(acc[ai][bj][m][0] * sc, acc[ai][bj][m][1] * sc); } }
    }
};
struct EpiSoftmax {
    static constexpr bool HAS_MID = false;
    bf16_t* PR; LAS unsigned char* lds;
    __device__ __forceinline__ void operator()(Acc& acc, const Unit& u, int wr, int wc, int fr, int fq) const {
        LAS f32x2* X = (LAS f32x2*)(lds + XCH_OFF);
#pragma unroll
        for (int ai = 0; ai < 2; ++ai)
#pragma unroll
            for (int m = 0; m < 4; ++m) {
                float mx = -3.0e38f;
#pragma unroll
                for (int bj = 0; bj < 2; ++bj)
#pragma unroll
                    for (int n = 0; n < 2; ++n) { const f32x4 x = acc[ai][bj][m][n]; mx = fmaxf(mx, fmaxf(fmaxf(x[0], x[1]), fmaxf(x[2], x[3]))); }
                mx = fmaxf(mx, __shfl_xor(mx, 16)); mx = fmaxf(mx, __shfl_xor(mx, 32));
                float s = 0.f;
#pragma unroll
                for (int bj = 0; bj < 2; ++bj)
#pragma unroll
                    for (int n = 0; n < 2; ++n) { f32x4 x = acc[ai][bj][m][n];
                        x[0] = fast_exp(x[0] - mx); x[1] = fast_exp(x[1] - mx); x[2] = fast_exp(x[2] - mx); x[3] = fast_exp(x[3] - mx);
                        s += (x[0] + x[1]) + (x[2] + x[3]); acc[ai][bj][m][n] = x; }
                s += __shfl_xor(s, 16); s += __shfl_xor(s, 32);
                if (fq == 0) X[(ai * 128 + wr * 64 + m * 16 + fr) * 4 + wc] = (f32x2){mx, s};
            }
        asm volatile("s_waitcnt lgkmcnt(0)" ::: "memory"); __builtin_amdgcn_s_barrier(); asm volatile("" ::: "memory");
#pragma unroll
        for (int ai = 0; ai < 2; ++ai)
#pragma unroll
            for (int m = 0; m < 4; ++m) {
                const int rl = ai * 128 + wr * 64 + m * 16 + fr;
                const f32x2 a = X[rl * 4 + 0], b = X[rl * 4 + 1], c = X[rl * 4 + 2], d = X[rl * 4 + 3];
                const float M = fmaxf(fmaxf(a.x, b.x), fmaxf(c.x, d.x));
                const float tot = a.y * fast_exp(a.x - M) + b.y * fast_exp(b.x - M) + c.y * fast_exp(c.x - M) + d.y * fast_exp(d.x - M);
                const float own = wc == 0 ? a.x : (wc == 1 ? b.x : (wc == 2 ? c.x : d.x));
                const float f = fast_exp(own - M) / tot;
                bf16_t* prow = PR + ((size_t)(u.pm * NH + u.pn) * 256 + rl) * 256;
#pragma unroll
                for (int bj = 0; bj < 2; ++bj) { const int col = bj * 128 + wc * 32 + fq * 8; *(u32x4*)(prow + col) = pack8(acc[ai][bj][m][0] * f, acc[ai][bj][m][1] * f); }
                asm volatile("" ::: "memory");
            }
    }
};


template <int CTRL> __device__ __forceinline__ float dppf(float v) { return __builtin_bit_cast(float, __builtin_amdgcn_update_dpp(0, __builtin_bit_cast(int, v), CTRL, 0xF, 0xF, true)); }
template <int CTRL> __device__ __forceinline__ float dppf_old(float old, float v) { return __builtin_bit_cast(float, __builtin_amdgcn_update_dpp(__builtin_bit_cast(int, old), __builtin_bit_cast(int, v), CTRL, 0xF, 0xF, false)); }
__device__ __forceinline__ float prev_row1(float cur, float pf) { float o = dppf<0x10F>(pf); asm volatile("" : "+v"(o)); float r = dppf_old<0x111>(o, cur); asm volatile("" : "+v"(r)); return r; }
__device__ __forceinline__ float prev_row2(float cur, float pf) { float o = dppf<0x10E>(pf); asm volatile("" : "+v"(o)); float r = dppf_old<0x112>(o, cur); asm volatile("" : "+v"(r)); return r; }
struct EpiFfn {
    static constexpr bool HAS_MID = false;
    bf16_t* ACT; const bf16_t* H; const bf16_t* WUG; const float* cw; const float* st_ffn; float* outFP; float* outFS; const float* ssq; LAS unsigned char* lds;
    __device__ __forceinline__ void operator()(Acc& acc, const Unit& u, int wr, int wc, int fr, int fq) const {
        const int lane = fq * 16 + fr, wid = wr * 4 + wc;
        LAS float* HB = (LAS float*)(lds + XCH_OFF);
        const bool sample = u.pm >= NP / 256;
        const int cl0 = wc * 32 + fq * 8, ch0 = u.pn * 128 + cl0;
        if (!sample) {
#pragma unroll
            for (int ai = 0; ai < 2; ++ai)
#pragma unroll
                for (int m = 0; m < 4; ++m) { const int row = u.pm * 256 + ai * 128 + wr * 64 + m * 16 + fr; const float rs = 1.0f / sqrtf(ssq[row] * (1.0f / D) + EPS);
#pragma unroll
                    for (int bj = 0; bj < 2; ++bj) { acc[ai][bj][m][0] *= rs; acc[ai][bj][m][1] *= rs; } }
            if ((u.pm & 7) != 0) {
                f32x4 hacc = (f32x4){0.f, 0.f, 0.f, 0.f};
                const bf16_t* ap = H + (size_t)(u.pm * 256 - 2 + (fr < 2 ? fr : 0)) * D + fq * 8;
                const bf16_t* bp = WUG + (size_t)(u.pn * 256 + wid * 16 + fr) * D + fq * 8;
#pragma unroll 8
                for (int kb = 0; kb < 32; ++kb) { const bf16x8 a = *(const bf16x8*)(ap + kb * 32), b = *(const bf16x8*)(bp + kb * 32); hacc = __builtin_amdgcn_mfma_f32_16x16x32_bf16(a, b, hacc, 0, 0, 0); }
                if (fq == 0) { const int r0 = u.pm * 256 - 2; const float s0 = 1.0f / sqrtf(ssq[r0] * (1.0f / D) + EPS), s1 = 1.0f / sqrtf(ssq[r0 + 1] * (1.0f / D) + EPS);
                    HB[0 * 128 + wid * 16 + fr] = hacc[0] * s0; HB[1 * 128 + wid * 16 + fr] = hacc[1] * s1; }
            } else if (wid < 4) HB[wid * 64 + lane] = 0.f;
            if (fr >= 14) {
#pragma unroll
                for (int ai = 0; ai < 2; ++ai) { LAS float* d = HB + ((1 + ai * 2 + wr) * 2 + (fr - 14)) * 128 + cl0; *(LAS f32x4*)d = acc[ai][0][3][0]; *(LAS f32x4*)(d + 4) = acc[ai][0][3][1]; }
            }
        }
        asm volatile("s_waitcnt lgkmcnt(0)" ::: "memory"); __builtin_amdgcn_s_barrier(); asm volatile("" ::: "memory");
        const f32x4 w0a = *(const f32x4*)(cw + ch0), w0b = *(const f32x4*)(cw + ch0 + 4), w1a = *(const f32x4*)(cw + DFF + ch0), w1b = *(const f32x4*)(cw + DFF + ch0 + 4),
                    w2a = *(const f32x4*)(cw + 2 * DFF + ch0), w2b = *(const f32x4*)(cw + 2 * DFF + ch0 + 4);
#pragma unroll
        for (int ai = 0; ai < 2; ++ai) {
            f32x4 pva = (f32x4){0.f, 0.f, 0.f, 0.f}, pvb = pva;
            if (!sample) { const int slot = ai == 0 ? (wr == 0 ? 0 : 1) : (wr == 0 ? 2 : 3);
                const LAS float* hp = HB + (slot * 2 + (fr >= 14 ? fr - 14 : 0)) * 128 + cl0; pva = *(const LAS f32x4*)hp; pvb = *(const LAS f32x4*)(hp + 4); }
#pragma unroll
            for (int m = 0; m < 4; ++m) {
                const int row = u.pm * 256 + ai * 128 + wr * 64 + m * 16 + fr;
                const f32x4 ca = acc[ai][0][m][0], cb = acc[ai][0][m][1];
                const f32x4 fa = m ? acc[ai][0][m ? m - 1 : 0][0] : pva, fb = m ? acc[ai][0][m ? m - 1 : 0][1] : pvb;
                f32x4 p1a, p1b, p2a, p2b;
                if (!sample) {
#pragma unroll
                    for (int e = 0; e < 4; ++e) {
                        p1a[e] = prev_row1(ca[e], fa[e]); p1b[e] = prev_row1(cb[e], fb[e]);
                        p2a[e] = prev_row2(ca[e], fa[e]); p2b[e] = prev_row2(cb[e], fb[e]); }
                } else {
                    const int t = fr & 3; const float* sp = st_ffn + (size_t)((row - NP) >> 2) * 2 * DFF + ch0;
                    const f32x4 s0a = *(const f32x4*)sp, s0b = *(const f32x4*)(sp + 4), s1a = *(const f32x4*)(sp + DFF), s1b = *(const f32x4*)(sp + DFF + 4);
#pragma unroll
                    for (int e = 0; e < 4; ++e) {
                        float r1a = dppf<0x111>(ca[e]), r1b = dppf<0x111>(cb[e]), r2a = dppf<0x112>(ca[e]), r2b = dppf<0x112>(cb[e]);
                        asm volatile("" : "+v"(r1a), "+v"(r1b), "+v"(r2a), "+v"(r2b));
                        p1a[e] = t >= 1 ? r1a : s1a[e]; p1b[e] = t >= 1 ? r1b : s1b[e];
                        p2a[e] = t >= 2 ? r2a : (t == 0 ? s0a[e] : s1a[e]); p2b[e] = t >= 2 ? r2b : (t == 0 ? s0b[e] : s1b[e]); }
                }
                const f32x4 ga = acc[ai][1][m][0], gb = acc[ai][1][m][1];
                f32x4 oa, ob;
#pragma unroll
                for (int e = 0; e < 4; ++e) { oa[e] = gelu_tanh(w0a[e] * p2a[e] + w1a[e] * p1a[e] + w2a[e] * ca[e]) * ga[e]; ob[e] = gelu_tanh(w0b[e] * p2b[e] + w1b[e] * p1b[e] + w2b[e] * cb[e]) * gb[e]; }
                *(u32x4*)(ACT + (size_t)row * DFF + ch0) = pack8(oa, ob);
                if (!sample) {
                    if ((u.pm & 7) == 7 && ai == 1 && wr == 1 && m == 3 && fr >= 14) { float* o = outFP + ((size_t)(u.pm >> 3) * 2 + (fr - 14)) * DFF + ch0; *(f32x4*)o = ca; *(f32x4*)(o + 4) = cb; }
                } else if ((fr & 3) >= 2) { float* o = outFS + ((size_t)((row - NP) >> 2) * 2 + ((fr & 3) - 2)) * DFF + ch0; *(f32x4*)o = ca; *(f32x4*)(o + 4) = cb; }
            }
        }
    }
};

#ifndef ONLY
#define ONLY -1
#endif
#define PH(k) (ONLY < 0 || ONLY == (k))
#define GSYNC() xcd_barrier(xb)
struct Args { const float* in[37]; float* out; unsigned char* ws; };

__device__ __forceinline__ void transpose_item(const float* W, int K, int N, bf16_t* WT, int row_off, LAS float* scr, int item, int lane, int remap = 0) {
    const int nblk = N / 32, kb = item / nblk, nb = item % nblk, k0 = 64 * kb, n0 = 32 * nb;
    if (remap) row_off = (n0 >> 7) * 256 + (n0 & 127) + (remap == 2 ? 128 : 0) - n0;
#pragma unroll 8
    for (int i = 0; i < 32; ++i) { const int kk = 2 * i + (lane >> 5); scr[kk * 33 + (lane & 31)] = W[(size_t)(k0 + kk) * N + n0 + (lane & 31)]; }
    asm volatile("s_waitcnt lgkmcnt(0)" ::: "memory");
    const int c = lane & 7;
#pragma unroll
    for (int j = 0; j < 4; ++j) { const int n = (lane >> 3) + 8 * j; const LAS float* s = scr + (8 * c) * 33 + n;
        u32x4 o; o.x = cvt_pk_bf16(s[0 * 33], s[1 * 33]); o.y = cvt_pk_bf16(s[2 * 33], s[3 * 33]); o.z = cvt_pk_bf16(s[4 * 33], s[5 * 33]); o.w = cvt_pk_bf16(s[6 * 33], s[7 * 33]);
        *(u32x4*)(WT + (size_t)(row_off + n0 + n) * K + k0 + 8 * c) = o; }
    asm volatile("s_waitcnt lgkmcnt(0)" ::: "memory");
}


__device__ __forceinline__ void transpose_item2(const float* W, int K, int N, bf16_t* WT, int row_off, int item, int lane, int remap) {
    const int nblk = N / 256, kb = item / nblk, nb = item % nblk, k0 = 32 * kb, n = 256 * nb + 4 * lane;
    const int rowb = remap ? ((n >> 7) * 256 + (n & 127) + (remap == 2 ? 128 : 0)) : (row_off + n);
    const float* src = W + (size_t)k0 * N + n;
    bf16_t* dst = WT + (size_t)rowb * K + k0;
#pragma unroll
    for (int sblk = 0; sblk < 4; ++sblk) {
        f32x4 v[8];
#pragma unroll
        for (int i = 0; i < 8; ++i) v[i] = *(const f32x4*)(src + (size_t)(8 * sblk + i) * N);
#pragma unroll
        for (int j = 0; j < 4; ++j) { u32x4 o; o.x = cvt_pk_bf16(v[0][j], v[1][j]); o.y = cvt_pk_bf16(v[2][j], v[3][j]); o.z = cvt_pk_bf16(v[4][j], v[5][j]); o.w = cvt_pk_bf16(v[6][j], v[7][j]);
            *(u32x4*)(dst + (size_t)j * K + 8 * sblk) = o; }
    }
}
__device__ __forceinline__ void rms_row2_bf16(const float* xa, const float* xb, const float* g, bf16_t* oa, bf16_t* ob, int lane) {
    const f32x4* pa = (const f32x4*)xa + lane; const f32x4* pb = (const f32x4*)xb + lane; f32x4 va[4], vb[4]; float sa = 0.f, sb = 0.f;
#pragma unroll
    for (int j = 0; j < 4; ++j) { va[j] = pa[64 * j]; vb[j] = pb[64 * j]; }
#pragma unroll
    for (int j = 0; j < 4; ++j) { sa += (va[j][0] * va[j][0] + va[j][1] * va[j][1]) + (va[j][2] * va[j][2] + va[j][3] * va[j][3]); sb += (vb[j][0] * vb[j][0] + vb[j][1] * vb[j][1]) + (vb[j][2] * vb[j][2] + vb[j][3] * vb[j][3]); }
#pragma unroll
    for (int o = 1; o < 64; o <<= 1) { sa += __shfl_xor(sa, o); sb += __shfl_xor(sb, o); }
    const float ra = 1.0f / sqrtf(sa * (1.0f / D) + EPS), rb = 1.0f / sqrtf(sb * (1.0f / D) + EPS);
    u32x2* qa = (u32x2*)oa + lane; u32x2* qb = (u32x2*)ob + lane;
#pragma unroll
    for (int j = 0; j < 4; ++j) { const f32x4 gg = ((const f32x4*)g)[lane + 64 * j]; u32x2 w;
        w.x = cvt_pk_bf16(va[j][0] * ra * gg[0], va[j][1] * ra * gg[1]); w.y = cvt_pk_bf16(va[j][2] * ra * gg[2], va[j][3] * ra * gg[3]); qa[64 * j] = w;
        w.x = cvt_pk_bf16(vb[j][0] * rb * gg[0], vb[j][1] * rb * gg[1]); w.y = cvt_pk_bf16(vb[j][2] * rb * gg[2], vb[j][3] * rb * gg[3]); qb[64 * j] = w; }
}

__device__ __forceinline__ void add_parts(float* xrow, const float* part, int nparts, size_t pstride, int lane) {
    f32x4* xr = (f32x4*)xrow + lane; f32x4 v[4];
#pragma unroll
    for (int j = 0; j < 4; ++j) v[j] = xr[64 * j];
    for (int k = 0; k < nparts; ++k) { const f32x4* pr = (const f32x4*)(part + (size_t)k * pstride) + lane;
#pragma unroll
        for (int j = 0; j < 4; ++j) v[j] += pr[64 * j]; }
#pragma unroll
    for (int j = 0; j < 4; ++j) xr[64 * j] = v[j];
}
__device__ __forceinline__ void rms_row_bf16(const float* xrow, const float* g, bf16_t* orow, int lane) {
    const f32x4* xr = (const f32x4*)xrow + lane; f32x4 v[4]; float s = 0.f;
#pragma unroll
    for (int j = 0; j < 4; ++j) { v[j] = xr[64 * j]; s += (v[j][0] * v[j][0] + v[j][1] * v[j][1]) + (v[j][2] * v[j][2] + v[j][3] * v[j][3]); }
    const float rstd = 1.0f / sqrtf(wave_sum(s) * (1.0f / D) + EPS);
    u32x2* o8 = (u32x2*)orow + lane;
#pragma unroll
    for (int j = 0; j < 4; ++j) { const f32x4 gg = ((const f32x4*)g)[lane + 64 * j]; u32x2 w; w.x = cvt_pk_bf16(v[j][0] * rstd * gg[0], v[j][1] * rstd * gg[1]); w.y = cvt_pk_bf16(v[j][2] * rstd * gg[2], v[j][3] * rstd * gg[3]); o8[64 * j] = w; }
}
__device__ __forceinline__ void rms_row_f32(const float* xrow, const float* g, float* orow, int lane) {
    const f32x4* xr = (const f32x4*)xrow + lane; f32x4 v[4]; float s = 0.f;
#pragma unroll
    for (int j = 0; j < 4; ++j) { v[j] = xr[64 * j]; s += (v[j][0] * v[j][0] + v[j][1] * v[j][1]) + (v[j][2] * v[j][2] + v[j][3] * v[j][3]); }
    const float rstd = 1.0f / sqrtf(wave_sum(s) * (1.0f / D) + EPS);
#pragma unroll
    for (int j = 0; j < 4; ++j) { const f32x4 gg = ((const f32x4*)g)[lane + 64 * j]; ((f32x4*)orow)[lane + 64 * j] = v[j] * rstd * gg; }
}

__device__ __forceinline__ float treduce16(float (&v)[16], int lane) {
    { const bool hi = lane & 32;
#pragma unroll
      for (int i = 0; i < 8; ++i) { const float send = hi ? v[i] : v[i + 8], keep = hi ? v[i + 8] : v[i]; v[i] = keep + __shfl_xor(send, 32); } }
    { const bool hi = lane & 16;
#pragma unroll
      for (int i = 0; i < 4; ++i) { const float send = hi ? v[i] : v[i + 4], keep = hi ? v[i + 4] : v[i]; v[i] = keep + __shfl_xor(send, 16); } }
    { const bool hi = lane & 8;
#pragma unroll
      for (int i = 0; i < 2; ++i) { const float send = hi ? v[i] : v[i + 2], keep = hi ? v[i + 2] : v[i]; v[i] = keep + __shfl_xor(send, 8); } }
    { const bool hi = lane & 4; const float send = hi ? v[0] : v[1], keep = hi ? v[1] : v[0]; v[0] = keep + __shfl_xor(send, 4); }
    v[0] += __shfl_xor(v[0], 2); v[0] += __shfl_xor(v[0], 1);
    return v[0];
}
template <int W> __device__ __forceinline__ void tr_step(float (&v)[64], int lane) {
    const bool hi = lane & W;
#pragma unroll
    for (int i = 0; i < W; ++i) { const float send = hi ? v[i] : v[i + W], keep = hi ? v[i + W] : v[i]; v[i] = keep + __shfl_xor(send, W); }
}
__device__ __forceinline__ float treduce64(float (&v)[64], int lane) {
    tr_step<32>(v, lane); tr_step<16>(v, lane); tr_step<8>(v, lane); tr_step<4>(v, lane); tr_step<2>(v, lane); tr_step<1>(v, lane);
    return v[0];
}

template <bool WITH_Y>
__device__ __forceinline__ void ssm_tile(const bf16_t* zu, int nsteps, float& sr, float& si, const float* BB, const float* AT, const float* Cre, const float* Cim, const float* Dv,
                                         int g, bf16_t* yg, int lane) {
    float Br[16], Bi[16];
    { const f32x4* bp = (const f32x4*)(BB + (size_t)(g * SN + lane) * 32);
#pragma unroll
      for (int j = 0; j < 4; ++j) { const f32x4 a = bp[j], b = bp[4 + j]; Br[4 * j] = a[0]; Br[4 * j + 1] = a[1]; Br[4 * j + 2] = a[2]; Br[4 * j + 3] = a[3]; Bi[4 * j] = b[0]; Bi[4 * j + 1] = b[1]; Bi[4 * j + 2] = b[2]; Bi[4 * j + 3] = b[3]; } }
    const f32x4 at = *(const f32x4*)(AT + (size_t)(g * SN + lane) * 4); const float ar = at[0], ai = at[1];
    float Cr[16], Ci[16], Dm[16];
    if (WITH_Y) {
#pragma unroll
        for (int p = 0; p < 16; ++p) { Cr[p] = Cre[(size_t)(g * SP + p) * SN + lane]; Ci[p] = Cim[(size_t)(g * SP + p) * SN + lane]; Dm[p] = (lane == 0) ? Dv[g * SP + p] : 0.f; }
    }
    u32x4 u0 = (u32x4){0, 0, 0, 0}, u1 = (u32x4){0, 0, 0, 0};
    if (lane < nsteps) { const u32x4* up = (const u32x4*)(zu + (size_t)lane * NZ); u0 = up[0]; u1 = up[1]; }
    const int p_own = ((lane >> 5) & 1) * 8 + ((lane >> 4) & 1) * 4 + ((lane >> 3) & 1) * 2 + ((lane >> 2) & 1);
    for (int t = 0; t < nsteps; ++t) {
        float uu[16];
        { unsigned w;
          w = __builtin_amdgcn_readlane(u0.x, t); uu[0] = bf_lo(w); uu[1] = bf_hi(w);
          w = __builtin_amdgcn_readlane(u0.y, t); uu[2] = bf_lo(w); uu[3] = bf_hi(w);
          w = __builtin_amdgcn_readlane(u0.z, t); uu[4] = bf_lo(w); uu[5] = bf_hi(w);
          w = __builtin_amdgcn_readlane(u0.w, t); uu[6] = bf_lo(w); uu[7] = bf_hi(w);
          w = __builtin_amdgcn_readlane(u1.x, t); uu[8] = bf_lo(w); uu[9] = bf_hi(w);
          w = __builtin_amdgcn_readlane(u1.y, t); uu[10] = bf_lo(w); uu[11] = bf_hi(w);
          w = __builtin_amdgcn_readlane(u1.z, t); uu[12] = bf_lo(w); uu[13] = bf_hi(w);
          w = __builtin_amdgcn_readlane(u1.w, t); uu[14] = bf_lo(w); uu[15] = bf_hi(w); }
        float br = 0.f, bi = 0.f;
#pragma unroll
        for (int p = 0; p < 16; ++p) { br = fmaf(Br[p], uu[p], br); bi = fmaf(Bi[p], uu[p], bi); }
        const float nr = ar * sr - ai * si + br, ni = ar * si + ai * sr + bi;
        sr = nr; si = ni;
        if (WITH_Y) {
            float v[16];
#pragma unroll
            for (int p = 0; p < 16; ++p) v[p] = fmaf(Dm[p], uu[p], Cr[p] * sr - Ci[p] * si);
            const float y = treduce16(v, lane);
            const float gy = gelu_tanh(y);
            if ((lane & 3) == 0) yg[(size_t)t * MIX + g * SP + p_own] = (bf16_t)(cvt_pk_bf16(gy, 0.f) & 0xffff);
        }
    }
}


typedef short bf16x4 __attribute__((ext_vector_type(4)));
struct SsmTab { bf16x4 Bre[4], Bim[4]; bf16x8 Ct[4]; float dp; float ar, ai; };
__device__ __forceinline__ void ssm_load_tab(SsmTab& T, int g, const bf16_t* BTR, const bf16_t* BTI, const bf16_t* CT, const float* AT, const float* Dv, int lane, bool with_y) {
    const int li = lane & 15, lq = lane >> 4;
#pragma unroll
    for (int nt = 0; nt < 4; ++nt) { T.Bre[nt] = *(const bf16x4*)(BTR + ((size_t)(g * SN + 16 * nt + li)) * 16 + 4 * lq); T.Bim[nt] = *(const bf16x4*)(BTI + ((size_t)(g * SN + 16 * nt + li)) * 16 + 4 * lq); }
    const f32x4 at = *(const f32x4*)(AT + (size_t)(g * SN + lane) * 4); T.ar = at[0]; T.ai = at[1];
    if (with_y) {
#pragma unroll
        for (int kb = 0; kb < 4; ++kb) T.Ct[kb] = *(const bf16x8*)(CT + ((size_t)(g * SP + li)) * 128 + kb * 32 + 8 * lq);
        T.dp = Dv[g * SP + li];
    }
}
template <bool WITH_Y>
__device__ __forceinline__ void ssm_chunk(LAS unsigned char* wl, const bf16_t* zu, float& sr, float& si, const SsmTab& T, bf16_t* yg, int lane) {
    const int li = lane & 15, lq = lane >> 4;
    bf16x4 U[4];
#pragma unroll
    for (int mt = 0; mt < 4; ++mt) U[mt] = *(const bf16x4*)(zu + (size_t)(16 * mt + li) * NZ + 4 * lq);
    {
        int rofs[4], nofs[4];
#pragma unroll
        for (int r = 0; r < 4; ++r) { rofs[r] = lq * 1024 + (li & 3) * 4 + r * 256 + (((li >> 2) ^ r) << 4); nofs[r] = ((r ^ lq) << 6); }
#pragma unroll 1
        for (int mt = 0; mt < 4; ++mt) {
            LAS unsigned char* pm = wl + mt * 4096;
            const bf16x4 um = mt == 0 ? U[0] : (mt == 1 ? U[1] : (mt == 2 ? U[2] : U[3]));
#pragma unroll
            for (int nt = 0; nt < 4; ++nt) {
                const f32x4 dre = __builtin_amdgcn_mfma_f32_16x16x16bf16_1k(um, T.Bre[nt], (f32x4){0.f, 0.f, 0.f, 0.f}, 0, 0, 0);
                const f32x4 dim = __builtin_amdgcn_mfma_f32_16x16x16bf16_1k(um, T.Bim[nt], (f32x4){0.f, 0.f, 0.f, 0.f}, 0, 0, 0);
#pragma unroll
                for (int r = 0; r < 4; ++r) *(LAS unsigned*)(pm + rofs[r] + nofs[nt]) = cvt_pk_bf16(dre[r], dim[r]);
            }
        }
    }
    asm volatile("s_waitcnt lgkmcnt(0)" ::: "memory");
    {
        const float ar = T.ar, ai = T.ai;
        int xj[16];
#pragma unroll
        for (int j = 0; j < 16; ++j) xj[j] = (((lane >> 2) ^ j) << 4) + (lane & 3) * 4 + j * 256;
#pragma unroll 1
        for (int tb = 0; tb < 4; ++tb) {
            LAS unsigned char* pb = wl + tb * 4096;
            unsigned w[16];
#pragma unroll
            for (int j = 0; j < 16; ++j) w[j] = *(const LAS unsigned*)(pb + xj[j]);
#pragma unroll
            for (int j = 0; j < 16; ++j) {
                const float nr = ar * sr - ai * si + bf_lo(w[j]), ni = ar * si + ai * sr + bf_hi(w[j]);
                sr = nr; si = ni;
                if (WITH_Y) *(LAS unsigned*)(pb + xj[j]) = cvt_pk_bf16(sr, si);
            }
        }
    }
    if (WITH_Y) {
        asm volatile("s_waitcnt lgkmcnt(0)" ::: "memory");
        int kofs[4];
#pragma unroll
        for (int kb = 0; kb < 4; ++kb) kofs[kb] = li * 256 + ((((kb * 4 + lq) ^ li)) << 4);
#pragma unroll 1
        for (int mt = 0; mt < 4; ++mt) {
            const LAS unsigned char* pm = wl + mt * 4096;
            f32x4 acc = (f32x4){0.f, 0.f, 0.f, 0.f};
#pragma unroll
            for (int kb = 0; kb < 4; ++kb) { const bf16x8 a = *(const LAS bf16x8*)(pm + kofs[kb]); acc = __builtin_amdgcn_mfma_f32_16x16x32_bf16(a, T.Ct[kb], acc, 0, 0, 0); }
            bf16_t* yp = yg + (size_t)(16 * mt + 4 * lq) * MIX + li;
            const bf16_t* up = zu + (size_t)(16 * mt + 4 * lq) * NZ + li;
#pragma unroll
            for (int r = 0; r < 4; ++r) { const float uv = __uint_as_float(((unsigned)up[(size_t)r * NZ]) << 16);
                yp[(size_t)r * MIX] = (bf16_t)(cvt_pk_bf16(gelu_tanh(fmaf(T.dp, uv, acc[r])), 0.f) & 0xffff); }
        }
        asm volatile("s_waitcnt lgkmcnt(0)" ::: "memory");
    }
}

#define XB_TMO      128
#define XB_XCNT(j)  (256  + 64 * (j))
#define XB_XSUB(j)  (1280 + 64 * (j))
#define XB_XGEN(j)  (2304 + 64 * (j))
#define XB_TOP      3328
#define XB_TOPGEN   3392
#define XCD_BAR_WORDS 3456
#define XB_SPIN_CAP (1u << 18)
__device__ __forceinline__ unsigned xb_ld(unsigned* p)              { return __hip_atomic_load(p, __ATOMIC_RELAXED, __HIP_MEMORY_SCOPE_AGENT); }
__device__ __forceinline__ unsigned xb_add(unsigned* p, unsigned v) { return __hip_atomic_fetch_add(p, v, __ATOMIC_RELAXED, __HIP_MEMORY_SCOPE_AGENT); }
__device__ __forceinline__ unsigned xb_xcc_id() { return (unsigned)__builtin_amdgcn_s_getreg((3 << 11) | 20) & 0xFu; }
#define XB_SPIN(cond, bar) do { unsigned _sp = 0; while (cond) { __builtin_amdgcn_s_sleep(1); \
    if ((++_sp & 255u) == 0u) { if (xb_ld(&(bar)[XB_TMO])) break; if (_sp > XB_SPIN_CAP) { atomicAdd(&(bar)[XB_TMO], 1u); break; } } } } while (0)
struct XcdBarrier { unsigned* bar; unsigned x; volatile LAS unsigned* st; };
__device__ __forceinline__ XcdBarrier xcd_barrier_post(unsigned* bar, volatile LAS unsigned* st) {
    XcdBarrier b; b.bar = bar; b.x = xb_xcc_id(); b.st = st;
    if (threadIdx.x == 0) (void)xb_add(&bar[XB_XCNT(b.x)], 1u);
    return b;
}
__device__ __forceinline__ void xcd_barrier_complete(unsigned* bar, unsigned x, unsigned& nloc, unsigned& nx) {
    const unsigned G = gridDim.x * gridDim.y * gridDim.z;
    unsigned sum, cnt, mine, sp = 0u;
    for (;;) {
        sum = 0u; cnt = 0u; mine = 0u;
#pragma unroll
        for (unsigned j = 0; j < 16; ++j) { const unsigned c = xb_ld(&bar[XB_XCNT(j)]); sum += c; cnt += (c > 0u) ? 1u : 0u; mine = (j == x) ? c : mine; }
        if (sum == G) break;
        __builtin_amdgcn_s_sleep(1);
        if ((++sp & 255u) == 0u) { if (xb_ld(&bar[XB_TMO])) break; if (sp > XB_SPIN_CAP) { atomicAdd(&bar[XB_TMO], 1u); break; } }
    }
    nloc = mine > 0u ? mine : 1u; nx = cnt > 0u ? cnt : 1u;
}
__device__ __forceinline__ void xcd_barrier(const XcdBarrier& b) {
    asm volatile("s_waitcnt vmcnt(0)" ::: "memory");
    __syncthreads();
    if (threadIdx.x == 0) {
        unsigned* bar = b.bar;
        __builtin_amdgcn_s_waitcnt(0);
        unsigned nloc = b.st[0], nx = b.st[1];
        if (nloc == 0u) { xcd_barrier_complete(bar, b.x, nloc, nx); b.st[0] = nloc; b.st[1] = nx; }
        const unsigned old = xb_add(&bar[XB_XSUB(b.x)], 1u);
        const unsigned gen = old / nloc;
        if (old + 1u == (gen + 1u) * nloc) {
            __builtin_amdgcn_fence(__ATOMIC_RELEASE, "agent");
            asm volatile("s_waitcnt vmcnt(0)" ::: "memory");
            const unsigned og = xb_add(&bar[XB_TOP], 1u);
            const unsigned tg = og / nx;
            if (og + 1u == (tg + 1u) * nx) xb_add(&bar[XB_TOPGEN], 1u);
            else XB_SPIN(xb_ld(&bar[XB_TOPGEN]) == tg, bar);
            __builtin_amdgcn_fence(__ATOMIC_ACQUIRE, "agent");
            xb_add(&bar[XB_XGEN(b.x)], 1u);
            asm volatile("s_waitcnt vmcnt(0)" ::: "memory");
        } else {
            XB_SPIN(xb_ld(&bar[XB_XGEN(b.x)]) == gen, bar);
            __builtin_amdgcn_fence(__ATOMIC_ACQUIRE, "agent");
            asm volatile("s_waitcnt vmcnt(0)" ::: "memory");
        }
    }
    __syncthreads();
}

__device__ __forceinline__ const float* ld_in(int k) {
    const __attribute__((address_space(4))) unsigned long long* t = (const __attribute__((address_space(4))) unsigned long long*)__builtin_amdgcn_kernarg_segment_ptr();
    asm volatile("" : "+s"(t));
    return (const float*)t[k];
}
__global__ void __launch_bounds__(NTHREADS, 2) hymba_fwd(Args args) {
    extern __shared__ __attribute__((aligned(16))) unsigned char lds_raw[];
    LAS unsigned char* lds = (LAS unsigned char*)lds_raw;
    cg::grid_group grid = cg::this_grid();
    const int tid = threadIdx.x, lane = tid & 63, wave = __builtin_amdgcn_readfirstlane(tid >> 6);
    const int G = gridDim.x, bx = blockIdx.x;
    const int gw = bx * NWAVES + wave, NGW = G * NWAVES;
#define IN(k) ld_in(k)
#define ws ((unsigned char*)ld_in(38))
#define out ((float*)ld_in(37))
#define barw ((unsigned*)(ws + WS_CTL))
#define WIN ((bf16_t*)(ws + WS_WIN))
#define WKV ((bf16_t*)(ws + WS_WKV))
#define WGLU ((bf16_t*)(ws + WS_WGLU))
#define WOUT ((bf16_t*)(ws + WS_WOUT))
#define WQ ((bf16_t*)(ws + WS_WQ))
#define WXO ((bf16_t*)(ws + WS_WXO))
#define WUG ((bf16_t*)(ws + WS_WUG))
#define WDN ((bf16_t*)(ws + WS_WDN))
#define H ((bf16_t*)(ws + WS_H))
#define X ((float*)(ws + WS_X))
#define Z ((bf16_t*)(ws + WS_Z))
#define YG ((bf16_t*)(ws + WS_YG))
#define YS ((float*)(ws + WS_YS))
#define MIXN ((bf16_t*)(ws + WS_MIXN))
#define Q ((bf16_t*)(ws + WS_Q))
#define PR ((bf16_t*)(ws + WS_PR))
#define O ((bf16_t*)(ws + WS_O))
#define MN ((bf16_t*)(ws + WS_MN))
#define KB ((bf16_t*)(ws + WS_KB))
#define VT ((bf16_t*)(ws + WS_VT))
#define SE ((float*)(ws + WS_SE))
#define SI ((float*)(ws + WS_SI))
#define BB ((float*)(ws + WS_BB))
#define AT ((float*)(ws + WS_AT))
#define PART ((float*)(ws + WS_PART))
#define SSQ ((float*)(ws + WS_SSQ))
#define BTR ((bf16_t*)(ws + WS_BTR))
#define BTI ((bf16_t*)(ws + WS_BTI))
#define CT ((bf16_t*)(ws + WS_CT))
#define UG ((bf16_t*)(ws + WS_UG))
#define ACT ((bf16_t*)(ws + WS_ACT))
    volatile LAS unsigned* bst = (volatile LAS unsigned*)(lds + XCH_OFF + 8192);
    if (bx == 0) for (int i = tid; i < XCD_BAR_WORDS; i += NTHREADS) barw[i] = 0u;
    if (tid < 2) bst[tid] = 0u;

    if (PH(0)) {
        const float* x_prompt = IN(0); const float* x_sample = IN(1); const float* mem_prompt = IN(2); const float* norm_mix = IN(9); const float* w_in = IN(10);
        const float* C_re = IN(16); const float* C_im = IN(17);
        const float* A_re = IN(11); const float* A_im = IN(12); const float* log_dt = IN(13); const float* B_re = IN(14); const float* B_im = IN(15);
        const float* w_glu = IN(19); const float* w_out = IN(24); const float* norm_mem = IN(26); const float* w_q = IN(27); const float* w_k = IN(28); const float* w_v = IN(29); const float* w_xo = IN(30);
        const float* w_up = IN(32); const float* w_gate = IN(33); const float* w_down = IN(35);
        constexpr int J_IN = 32 * 8, J_D = 32 * 4, J_GLU = 16 * 2, J_UP = 32 * 11, J_DN = 88 * 4;
        constexpr int NITEMS = J_IN + 5 * J_D + J_GLU + 2 * J_UP + J_DN;
        for (int it = gw; it < NITEMS; it += NGW) {
            int r = it;
            if (r < J_UP) { transpose_item2(w_up, D, DFF, WUG, 0, r, lane, 1); continue; } r -= J_UP;
            if (r < J_UP) { transpose_item2(w_gate, D, DFF, WUG, 0, r, lane, 2); continue; } r -= J_UP;
            if (r < J_DN) { transpose_item2(w_down, DFF, D, WDN, 0, r, lane, 0); continue; } r -= J_DN;
            if (r < J_IN) { transpose_item2(w_in, D, NZ, WIN, 0, r, lane, 0); continue; } r -= J_IN;
            if (r < J_D) { transpose_item2(w_k, D, D, WKV, 0, r, lane, 0); continue; } r -= J_D;
            if (r < J_D) { transpose_item2(w_v, D, D, WKV, D, r, lane, 0); continue; } r -= J_D;
            if (r < J_D) { transpose_item2(w_out, D, D, WOUT, 0, r, lane, 0); continue; } r -= J_D;
            if (r < J_D) { transpose_item2(w_q, D, D, WQ, 0, r, lane, 0); continue; } r -= J_D;
            if (r < J_D) { transpose_item2(w_xo, D, D, WXO, 0, r, lane, 0); continue; } r -= J_D;
            transpose_item2(w_glu, MIX, MIX, WGLU, 0, r, lane, 0);
        }
        for (int m = 2 * gw; m < MT; m += 2 * NGW) {
            const float* xa = m < NP ? x_prompt + (size_t)m * D : x_sample + (size_t)(m - NP) * D;
            rms_row2_bf16(xa, xa + D, norm_mix, H + (size_t)m * D, H + (size_t)(m + 1) * D, lane);
        }
        for (int m = 2 * gw; m < BP * NMEM; m += 2 * NGW) rms_row2_bf16(mem_prompt + (size_t)m * D, mem_prompt + (size_t)(m + 1) * D, norm_mem, MN + (size_t)m * D, MN + (size_t)(m + 1) * D, lane);
        for (int i = bx * NTHREADS + tid; i < NS * D / 4; i += G * NTHREADS) { ((f32x4*)(X + (size_t)NP * D))[i] = ((const f32x4*)x_sample)[i]; }
        for (int i = bx * NTHREADS + tid; i < 2 * NP + MT; i += G * NTHREADS) SSQ[i] = 0.f;
        const int gt = bx * NTHREADS + tid;
        if (gt < SG * SN) {
            const int g = gt / SN;
            const float dt = expf(log_dt[g]), lr = A_re[gt], li = A_im[gt];
            const float mag = expf(dt * lr), ph = dt * li;
            double th = (double)ph * (1.0 / 1024.0), t2 = th * th;
            double c = 1.0 - t2 * (0.5 - t2 * (1.0 / 24.0 - t2 * (1.0 / 720.0)));
            double s = th * (1.0 - t2 * (1.0 / 6.0 - t2 * (1.0 / 120.0 - t2 * (1.0 / 5040.0))));
#pragma unroll 1
            for (int k = 0; k < 10; ++k) { const double c2 = c * c - s * s, s2 = 2.0 * c * s; c = c2; s = s2; }
            const float ar = mag * (float)c, ai = mag * (float)s;
            const float den = lr * lr + li * li;
            const float cr = ((ar - 1.0f) * lr + ai * li) / den, ci = (ai * lr - (ar - 1.0f) * li) / den;
#pragma unroll
            for (int p = 0; p < 16; ++p) { const float br = B_re[(size_t)gt * SP + p], bi = B_im[(size_t)gt * SP + p];
                const float bbr = cr * br - ci * bi, bbi = cr * bi + ci * br;
                BB[(size_t)gt * 32 + p] = bbr; BB[(size_t)gt * 32 + 16 + p] = bbi;
                BTR[(size_t)gt * 16 + p] = (bf16_t)(cvt_pk_bf16(bbr, 0.f) & 0xffff); BTI[(size_t)gt * 16 + p] = (bf16_t)(cvt_pk_bf16(bbi, 0.f) & 0xffff); }
            float pr = ar, pi = ai;
#pragma unroll 1
            for (int k = 0; k < 6; ++k) { const float r2 = pr * pr - pi * pi, i2 = 2.0f * pr * pi; pr = r2; pi = i2; }
            *(f32x4*)(AT + (size_t)gt * 4) = (f32x4){ar, ai, pr, pi};
        }
        if (gt < SG * SP * SN) {
            const float cre = C_re[gt], cim = C_im[gt];
            ((unsigned*)CT)[gt] = cvt_pk_bf16(cre, -cim);
        }
    }
    grid.sync();
    const XcdBarrier xb = xcd_barrier_post(barw, bst);

    if (PH(1)) {
        Sched2 S{G, bx, MT / 256, NZ / 256, 16, BP, 8, 16, 1, 0, (const char*)H, (const char*)WIN, (const char*)MN, (const char*)WKV, (size_t)256 * D * 2, (size_t)256 * D * 2};
        EpiP1 E{Z, out + O_MK, out + O_MV, KB, VT};
        pg8::gemm_phase(lds, D, D, S, E);
    }
    GSYNC();

    if (PH(2)) {
        const float* st_re = IN(5); const float* st_im = IN(6); const float* st_conv = IN(7); const float* C_re = IN(16); const float* C_im = IN(17); const float* Dssm = IN(18); const float* conv_w = IN(21); const float* norm_conv = IN(23);
        {
            SsmTab T; int gcur = -1;
            for (int task = gw; task < BP * SG * NCH; task += NGW) {
                const int c = task % NCH, g = (task / NCH) % SG, b = task / (NCH * SG);
                if (g != gcur) { ssm_load_tab(T, g, BTR, BTI, CT, AT, Dssm, lane, false); gcur = g; }
                float sr = 0.f, si = 0.f;
#ifdef OLD_PASS1
                ssm_tile<false>(Z + (size_t)(b * TP + c * LCH) * NZ + g * SP, LCH, sr, si, BB, AT, C_re, C_im, Dssm, g, nullptr, lane);
#else
                ssm_chunk<false>(lds + wave * 16384, Z + (size_t)(b * TP + c * LCH) * NZ + g * SP, sr, si, T, nullptr, lane);
#endif
                float* e = SE + ((size_t)(b * SG + g) * NCH + c) * 128; e[lane] = sr; e[64 + lane] = si;
            }
        }
        for (int task = gw; task < BS * SG; task += NGW) {
            const int b = task % BS, g = task / BS;
            float sr = st_re[(size_t)(b * SG + g) * SN + lane], si = st_im[(size_t)(b * SG + g) * SN + lane];
            ssm_tile<true>(Z + (size_t)(NP + b * TS) * NZ + g * SP, TS, sr, si, BB, AT, C_re, C_im, Dssm, g, YG + (size_t)(NP + b * TS) * MIX, lane);
            out[O_SRS + (size_t)(b * SG + g) * SN + lane] = sr; out[O_SIS + (size_t)(b * SG + g) * SN + lane] = si;
        }
        {
            constexpr int RW = 9;
            const int c0 = lane * 8;
            float cw0[8], cw1[8], cw2[8], gn[8];
#pragma unroll
            for (int j = 0; j < 8; ++j) { cw0[j] = conv_w[c0 + j]; cw1[j] = conv_w[MIX + c0 + j]; cw2[j] = conv_w[2 * MIX + c0 + j]; gn[j] = norm_conv[c0 + j]; }
            const int r0 = gw * RW, r1 = (r0 + RW < MT) ? r0 + RW : MT;
            float p1[8], p2[8];
#pragma unroll
            for (int j = 0; j < 8; ++j) { p1[j] = 0.f; p2[j] = 0.f; }
            auto load_p = [&](int rr, float (&pp)[8]) { const bf16_t* zr = Z + (size_t)rr * NZ; const u32x4 xi = *(const u32x4*)(zr + MIX + c0), cgv = *(const u32x4*)(zr + 3 * MIX + c0);
                pp[0] = bf_lo(xi.x) * bf_lo(cgv.x); pp[1] = bf_hi(xi.x) * bf_hi(cgv.x); pp[2] = bf_lo(xi.y) * bf_lo(cgv.y); pp[3] = bf_hi(xi.y) * bf_hi(cgv.y);
                pp[4] = bf_lo(xi.z) * bf_lo(cgv.z); pp[5] = bf_hi(xi.z) * bf_hi(cgv.z); pp[6] = bf_lo(xi.w) * bf_lo(cgv.w); pp[7] = bf_hi(xi.w) * bf_hi(cgv.w); };
            if (r0 < MT) { if (r0 >= 1) load_p(r0 - 1, p1); if (r0 >= 2) load_p(r0 - 2, p2); }
            for (int r = r0; r < r1; ++r) {
                int b, t; const float* prev; float* cout; int T;
                if (r < NP) { b = r / TP; t = r % TP; prev = nullptr; cout = out + O_CP + (size_t)b * 2 * MIX; T = TP; }
                else { const int rs = r - NP; b = rs / TS; t = rs % TS; prev = st_conv + (size_t)b * 2 * MIX; cout = out + O_CS + (size_t)b * 2 * MIX; T = TS; }
                float p0[8]; load_p(r, p0);
                const u32x4 bgv = *(const u32x4*)(Z + (size_t)r * NZ + 2 * MIX + c0);
                const float bg[8] = {bf_lo(bgv.x), bf_hi(bgv.x), bf_lo(bgv.y), bf_hi(bgv.y), bf_lo(bgv.z), bf_hi(bgv.z), bf_lo(bgv.w), bf_hi(bgv.w)};
                float q1[8], q2[8];
                if (t < 2 && prev) { const float* pa = prev + (size_t)MIX + c0; const float* pb = prev + c0;
                    const f32x4 a0 = *(const f32x4*)pa, a1 = *(const f32x4*)(pa + 4), b0 = *(const f32x4*)pb, b1 = *(const f32x4*)(pb + 4);
#pragma unroll
                    for (int j = 0; j < 8; ++j) { const float s1 = j < 4 ? a0[j & 3] : a1[j & 3], s0 = j < 4 ? b0[j & 3] : b1[j & 3];
                        q1[j] = t >= 1 ? p1[j] : s1; q2[j] = t == 0 ? s0 : s1; } }
                else {
#pragma unroll
                    for (int j = 0; j < 8; ++j) { q1[j] = t >= 1 ? p1[j] : 0.f; q2[j] = t >= 2 ? p2[j] : 0.f; } }
                float y[8]; float ss = 0.f;
#pragma unroll
                for (int j = 0; j < 8; ++j) { y[j] = bg[j] * (cw0[j] * q2[j] + cw1[j] * q1[j] + cw2[j] * p0[j]); ss += y[j] * y[j]; }
                const float rstd = 1.0f / sqrtf(wave_sum(ss) * (1.0f / MIX) + EPS);
                u32x4 w; w.x = cvt_pk_bf16(y[0] * rstd * gn[0], y[1] * rstd * gn[1]); w.y = cvt_pk_bf16(y[2] * rstd * gn[2], y[3] * rstd * gn[3]);
                w.z = cvt_pk_bf16(y[4] * rstd * gn[4], y[5] * rstd * gn[5]); w.w = cvt_pk_bf16(y[6] * rstd * gn[6], y[7] * rstd * gn[7]);
                *(u32x4*)(MIXN + (size_t)r * D + MIX + c0) = w;
                if (t >= T - 2) { float* co = cout + (size_t)(t - (T - 2)) * MIX + c0; *(f32x4*)co = (f32x4){p0[0], p0[1], p0[2], p0[3]}; *(f32x4*)(co + 4) = (f32x4){p0[4], p0[5], p0[6], p0[7]}; }
#pragma unroll
                for (int j = 0; j < 8; ++j) { p2[j] = p1[j]; p1[j] = p0[j]; }
            }
        }
    }
    GSYNC();

    if (PH(4)) {
        const float* C_re = IN(16); const float* C_im = IN(17); const float* Dssm = IN(18);
        SsmTab T; int gcur = -1; float aLr = 0.f, aLi = 0.f;
        for (int task = gw; task < BP * SG * NCH; task += NGW) {
            const int c = task % NCH, g = (task / NCH) % SG, b = task / (NCH * SG);
            if (g != gcur) { ssm_load_tab(T, g, BTR, BTI, CT, AT, Dssm, lane, true); gcur = g; const f32x4 at = *(const f32x4*)(AT + (size_t)(g * SN + lane) * 4); aLr = at[2]; aLi = at[3]; }
            float sr = 0.f, si = 0.f;
            { const float* e = SE + ((size_t)(b * SG + g) * NCH) * 128;
              for (int cc = 0; cc < c; ++cc) { const float er = e[cc * 128 + lane], ei = e[cc * 128 + 64 + lane]; const float nr = aLr * sr - aLi * si + er, ni = aLr * si + aLi * sr + ei; sr = nr; si = ni; } }
#ifdef OLD_PASS2
            ssm_tile<true>(Z + (size_t)(b * TP + c * LCH) * NZ + g * SP, LCH, sr, si, BB, AT, C_re, C_im, Dssm, g, YG + (size_t)(b * TP + c * LCH) * MIX, lane);
#else
            ssm_chunk<true>(lds + wave * 16384, Z + (size_t)(b * TP + c * LCH) * NZ + g * SP, sr, si, T, YG + (size_t)(b * TP + c * LCH) * MIX + g * SP, lane);
            if (c == NCH - 1) { out[O_SRP + (size_t)(b * SG + g) * SN + lane] = sr; out[O_SIP + (size_t)(b * SG + g) * SN + lane] = si; }
#endif
        }
    }
    GSYNC();

    if (PH(5)) {
        const float* b_glu = IN(20);
        Sched2 S{G, bx, MT / 256, MIX / 256, 8, 0, 0, 4, 1, 0, (const char*)YG, (const char*)WGLU, nullptr, nullptr, (size_t)256 * MIX * 2, (size_t)256 * MIX * 2};
        EpiGlu E{YG, b_glu, IN(22), MIXN, SSQ + 2 * NP};
        pg8::gemm_phase(lds, MIX, MIX, S, E);
    }
    GSYNC();

    if (PH(7)) {
        const float* x_prompt = IN(0);
        Sched2 S{G, bx, NP / 256, D / 256, 16, NS / 256, D / 256, 4, 4, NP / 256, (const char*)MIXN, (const char*)WOUT, (const char*)MIXN, (const char*)WOUT, (size_t)256 * D * 2, (size_t)256 * D * 2};
        EpiRes<true> E{x_prompt, X, PART, 1, H, IN(25), SSQ, SSQ + 2 * NP};
        pg8::gemm_phase(lds, D, D, S, E);
    }
    GSYNC();

    if (PH(8)) for (int m = NP + gw; m < MT; m += NGW) { add_parts(X + (size_t)m * D, PART + (size_t)(m - NP) * D, 4, (size_t)NS * D, lane); rms_row_bf16(X + (size_t)m * D, IN(25), H + (size_t)m * D, lane); }
    GSYNC();

    if (PH(9)) {
        Sched2 S{G, bx, NP / 256, D / 256, 16, NS / 256, D / 256, 4, 4, NP / 256, (const char*)H, (const char*)WQ, (const char*)H, (const char*)WQ, (size_t)256 * D * 2, (size_t)256 * D * 2};
        EpiQ E{Q, PART, SSQ};
        pg8::gemm_phase(lds, D, D, S, E);
    }
    GSYNC();

    if (PH(10)) {
        const float* cache_k = IN(3); const float* cache_v = IN(4);
        struct SchedQK { int G, c; const char* q_; const char* kb_;
            __device__ __forceinline__ bool next(int i, Unit& u) const { const int L = i * G + c; if (L >= 64 * NH) return false; pg8::order_map(L, 64, NH, u.pm, u.pn); u.kind = 0; u.nt = 4; u.ks = 0;
                u.A = q_ + ((size_t)u.pm * 256 * D + (size_t)u.pn * HD) * 2; u.B = kb_ + ((size_t)(u.pm >> 3) * NMEM * D + (size_t)u.pn * HD) * 2; return true; } };
        SchedQK S{G, bx, (const char*)Q, (const char*)KB};
        EpiSoftmax E{PR, lds};
#ifndef NO_QK
        pg8::gemm_phase(lds, D, D, S, E);
#endif

        {
        struct SchedPV { int G, c; const char* pr_; const char* vt_;
            __device__ __forceinline__ bool next(int i, Unit& u) const { const int L = i * G + c; if (L >= 64 * NH) return false; pg8::order_map(L, 64, NH, u.pm, u.pn); u.kind = 0; u.nt = 4; u.ks = 0;
                u.A = pr_ + (size_t)(u.pm * NH + u.pn) * 256 * 256 * 2; u.B = vt_ + (size_t)((u.pm >> 3) * NH + u.pn) * HD * NMEM * 2; return true; } };
        SchedPV S{G, bx, (const char*)PR, (const char*)VT};
        EpiBf E{O, D, 1.0f, nullptr};
        pg8::gemm_phase(lds, NMEM, NMEM, S, E);
        }
#ifndef NO_SATT
        LAS float* sc = (LAS float*)lds;
        LAS float* pr = (LAS float*)(lds + 4096);
        LAS float* po = (LAS float*)(lds + 8192);
        for (int unit = bx; unit < BS * NH; unit += G) {
            const int b = unit / NH, h = unit % NH;
            float q[4][4];
#pragma unroll
            for (int qi = 0; qi < 4; ++qi) { const float* qp = PART + (size_t)(b * TS + qi) * D + h * HD + 4 * lane; const f32x4 w = (*(const f32x4*)qp + *(const f32x4*)(qp + (size_t)NS * D)) + (*(const f32x4*)(qp + (size_t)2 * NS * D) + *(const f32x4*)(qp + (size_t)3 * NS * D)); q[qi][0] = w[0]; q[qi][1] = w[1]; q[qi][2] = w[2]; q[qi][3] = w[3]; }
            const float* kbase = cache_k + ((size_t)(b * NMEM) * NH + h) * HD + 4 * lane;
            const float* vbase = cache_v + ((size_t)(b * NMEM) * NH + h) * HD + 4 * lane;
#pragma unroll 1
            for (int blk = 0; blk < 2; ++blk) {
                const int key0 = wave * 32 + blk * 16;
                float v[64];
#pragma unroll
                for (int k = 0; k < 16; ++k) { const f32x4 kv = *(const f32x4*)(kbase + (size_t)(key0 + k) * NH * HD);
#pragma unroll
                    for (int qi = 0; qi < 4; ++qi) v[k * 4 + qi] = (kv[0] * q[qi][0] + kv[1] * q[qi][1]) + (kv[2] * q[qi][2] + kv[3] * q[qi][3]); }
                const float s = treduce64(v, lane);
                sc[(lane & 3) * 256 + key0 + (lane >> 2)] = s;
            }
            __syncthreads();
            {
                const int qi = lane & 3, kb = lane >> 2; float sv[16]; float mx = -3.0e38f;
#pragma unroll
                for (int j = 0; j < 16; ++j) { sv[j] = sc[qi * 256 + kb + 16 * j]; mx = fmaxf(mx, sv[j]); }
                mx = fmaxf(mx, __shfl_xor(mx, 4)); mx = fmaxf(mx, __shfl_xor(mx, 8)); mx = fmaxf(mx, __shfl_xor(mx, 16)); mx = fmaxf(mx, __shfl_xor(mx, 32));
                float sum = 0.f;
#pragma unroll
                for (int j = 0; j < 16; ++j) { sv[j] = fast_exp(sv[j] - mx); sum += sv[j]; }
                sum += __shfl_xor(sum, 4); sum += __shfl_xor(sum, 8); sum += __shfl_xor(sum, 16); sum += __shfl_xor(sum, 32);
                const float inv = 1.0f / sum;
                if (wave == 0) {
#pragma unroll
                    for (int j = 0; j < 16; ++j) pr[qi * 256 + kb + 16 * j] = sv[j] * inv; }
            }
            __syncthreads();
            {
                float o[4][4];
#pragma unroll
                for (int qi = 0; qi < 4; ++qi) { o[qi][0] = 0.f; o[qi][1] = 0.f; o[qi][2] = 0.f; o[qi][3] = 0.f; }
#pragma unroll 8
                for (int k = 0; k < 32; ++k) { const int key = wave * 32 + k; const f32x4 vv = *(const f32x4*)(vbase + (size_t)key * NH * HD);
#pragma unroll
                    for (int qi = 0; qi < 4; ++qi) { const float pp = pr[qi * 256 + key]; o[qi][0] = fmaf(pp, vv[0], o[qi][0]); o[qi][1] = fmaf(pp, vv[1], o[qi][1]); o[qi][2] = fmaf(pp, vv[2], o[qi][2]); o[qi][3] = fmaf(pp, vv[3], o[qi][3]); } }
#pragma unroll
                for (int qi = 0; qi < 4; ++qi) *(LAS f32x4*)(po + (wave * 4 + qi) * 256 + 4 * lane) = (f32x4){o[qi][0], o[qi][1], o[qi][2], o[qi][3]};
            }
            __syncthreads();
            {
                const int idx = tid * 2, qi = idx >> 8, d = idx & 255; float a0 = 0.f, a1 = 0.f;
#pragma unroll
                for (int w = 0; w < 8; ++w) { const f32x2 t2 = *(LAS f32x2*)(po + (w * 4 + qi) * 256 + d); a0 += t2[0]; a1 += t2[1]; }
                *(unsigned*)(O + (size_t)(NP + b * TS + qi) * D + h * HD + d) = cvt_pk_bf16(a0, a1);
            }
        }
#endif
    }
    GSYNC();

    if (PH(12)) {
        Sched2 S{G, bx, NP / 256, D / 256, 16, NS / 256, D / 256, 4, 4, NP / 256, (const char*)O, (const char*)WXO, (const char*)O, (const char*)WXO, (size_t)256 * D * 2, (size_t)256 * D * 2};
        EpiRes<false> E{nullptr, X, PART, 0, H, IN(31), SSQ + NP, nullptr};
        pg8::gemm_phase(lds, D, D, S, E);
    }
    GSYNC();

    if (PH(13)) for (int m = NP + gw; m < MT; m += NGW) { add_parts(X + (size_t)m * D, PART + (size_t)(m - NP) * D, 4, (size_t)NS * D, lane); rms_row_bf16(X + (size_t)m * D, IN(31), H + (size_t)m * D, lane); }
    GSYNC();

    if (PH(14)) {
        Sched2 S{G, bx, MT / 256, NUG / 256, 16, 0, 0, 4, 1, 0, (const char*)H, (const char*)WUG, nullptr, nullptr, (size_t)256 * D * 2, (size_t)256 * D * 2};
        EpiFfn E{ACT, H, WUG, IN(34), IN(8), out + O_FP, out + O_FS, SSQ + NP, lds};
        pg8::gemm_phase(lds, D, D, S, E);
    }
    GSYNC();

    if (PH(16)) {
        Sched2 S{G, bx, NP / 256, D / 256, DFF / 64, NS / 256, D / 256, 4, DFF / 256, NP / 256, (const char*)ACT, (const char*)WDN, (const char*)ACT, (const char*)WDN, (size_t)256 * DFF * 2, (size_t)256 * DFF * 2};
        EpiRes<false> E{nullptr, X, PART, 0, nullptr, nullptr, nullptr, nullptr};
        pg8::gemm_phase(lds, DFF, DFF, S, E);
    }
    GSYNC();

    if (PH(17)) for (int m = gw; m < MT; m += NGW) { if (m >= NP) add_parts(X + (size_t)m * D, PART + (size_t)(m - NP) * D, DFF / 256, (size_t)NS * D, lane); rms_row_f32(X + (size_t)m * D, IN(36), out + (size_t)m * D, lane); }
}

#undef barw
#undef WIN
#undef WKV
#undef WGLU
#undef WOUT
#undef WQ
#undef WXO
#undef WUG
#undef WDN
#undef H
#undef X
#undef Z
#undef YG
#undef YS
#undef MIXN
#undef Q
#undef PR
#undef O
#undef MN
#undef KB
#undef VT
#undef SE
#undef SI
#undef BB
#undef AT
#undef PART
#undef SSQ
#undef BTR
#undef BTI
#undef CT
#undef UG
#undef ACT
#undef ws
#undef out
#undef IN
extern "C" void kernel_launch(void* const* d_in, const int* in_sizes, int n_in, void* d_out, int out_size, void* d_ws, size_t ws_size, hipStream_t stream) {
    static int grid = 0;
    if (grid == 0) {
        if (n_in != 37 || (size_t)out_size != O_END || ws_size < WS_END) { fprintf(stderr, "kernel_launch: unexpected sizes n_in %d out %d ws %zu\n", n_in, out_size, ws_size); grid = -1; return; }
        int dev = 0, cus = 0, per_cu = 0;
        (void)hipGetDevice(&dev); (void)hipDeviceGetAttribute(&cus, hipDeviceAttributeMultiprocessorCount, dev);
        (void)hipFuncSetAttribute((const void*)hymba_fwd, hipFuncAttributeMaxDynamicSharedMemorySize, LDS_BYTES);
        (void)hipOccupancyMaxActiveBlocksPerMultiprocessor(&per_cu, (const void*)hymba_fwd, NTHREADS, LDS_BYTES);
        if (per_cu < 1) { fprintf(stderr, "kernel_launch: occupancy query reports %d blocks per CU\n", per_cu); per_cu = 1; }
        (void)hipGetLastError();
        grid = cus;
        if (grid % 8) grid -= grid % 8;
    }
    if (grid < 0) return;
    Args a{};
    for (int i = 0; i < 37; ++i) a.in[i] = (const float*)d_in[i];
    a.out = (float*)d_out; a.ws = (unsigned char*)d_ws;
    void* kargs[] = {&a};
    hipError_t e = hipLaunchCooperativeKernel((const void*)hymba_fwd, dim3(grid), dim3(NTHREADS), kargs, LDS_BYTES, stream);
    if (e != hipSuccess) fprintf(stderr, "cooperative launch failed: %s (grid %d)\n", hipGetErrorString(e), grid);
}
```
